# Optimizing an MI355X kernel written in HIP

```python
import math
import jax, jax.numpy as jnp
from jax import lax
import numpy as np

D_MODEL = 1024
BATCH = 2
SEQ = 8192
DEPTH = 1

D_MIX = D_MODEL
HG_HEADS = 4
HG_DK = 128
HG_DV = 128
HG_WIDTH = HG_HEADS * HG_DV
HG_CHUNK = 64
AT_HEADS = 8
AT_HEAD_DIM = 64
AT_WIDTH = AT_HEADS * AT_HEAD_DIM
DILATED_PATTERNS = ((128, 1), (512, 4), (2048, 16))
ATT_BLOCK = 128
ROPE_THETA = 10000.0
NORM_EPS = 1e-6
IN_SPLITS = (HG_HEADS * HG_DK, HG_HEADS * HG_DK, HG_WIDTH, HG_WIDTH,
             AT_WIDTH, AT_WIDTH, AT_WIDTH, AT_WIDTH)
IN_COLS = sum(IN_SPLITS)

kernel_name = "hgrn2_dilated_attn_parallel_hybrid"


def rms_norm(x, w):
    xf = x.astype(jnp.float32)
    y = xf * lax.rsqrt(jnp.mean(xf * xf, axis=-1, keepdims=True) + NORM_EPS)
    return y * w.astype(jnp.float32)


def rope(x, positions):
    half = x.shape[-1] // 2
    inv_freq = 1.0 / (ROPE_THETA ** (jnp.arange(half, dtype=jnp.float32) / half))
    ang = positions.astype(jnp.float32)[:, None] * inv_freq[None, :]
    cos = jnp.cos(ang)[:, None, :]
    sin = jnp.sin(ang)[:, None, :]
    x1, x2 = x[..., :half], x[..., half:]
    return jnp.concatenate([x1 * cos - x2 * sin, x2 * cos + x1 * sin], axis=-1)


def hgrn2_mixer(q, f_logit, i, lb):
    B, S, H, DK = q.shape
    DV = i.shape[-1]
    C = HG_CHUNK
    nC = S // C
    log_f = jnp.logaddexp(jnp.log(lb), jnp.log1p(-lb) + jax.nn.log_sigmoid(f_logit))
    k = -jnp.expm1(log_f)
    q = jax.nn.silu(q)

    def chunks(t):
        return t.reshape(B, nC, C, H, t.shape[-1]).transpose(1, 0, 3, 2, 4)

    causal = (jnp.arange(C)[:, None] >= jnp.arange(C)[None, :])[:, :, None]

    def step(state, inp):
        qc, kc, vc, gc = inp
        b = jnp.cumsum(gc, axis=2)
        o_inter = jnp.einsum('bhck,bhkv->bhcv', qc * jnp.exp(b), state)
        diff = b[:, :, :, None, :] - b[:, :, None, :, :]
        decay = jnp.exp(jnp.where(causal, diff, -jnp.inf))
        scores = jnp.einsum('bhtk,bhtsk,bhsk->bhts', qc, decay, kc)
        o_intra = jnp.einsum('bhts,bhsv->bhtv', scores, vc)
        b_last = b[:, :, -1:, :]
        k_dec = kc * jnp.exp(b_last - b)
        new_state = jnp.exp(b_last[:, :, 0, :])[..., None] * state + \
            jnp.einsum('bhsk,bhsv->bhkv', k_dec, vc)
        return new_state, o_inter + o_intra

    state0 = jnp.zeros((B, H, DK, DV), jnp.float32)
    _, out = lax.scan(step, state0, (chunks(q), chunks(k), chunks(i), chunks(log_f)))
    return out.transpose(1, 0, 3, 2, 4).reshape(B, S, H, DV)


def dilated_window_attention(q, k, v, window, dilation):
    B, S, H, Dh = q.shape
    span = window // dilation
    assert span <= ATT_BLOCK
    BLK = ATT_BLOCK
    L = S // dilation
    nb = -(-L // BLK)
    Lp = nb * BLK

    def to_sub(t):
        t = t.reshape(B, L, dilation, H, Dh).transpose(0, 2, 3, 1, 4)
        return jnp.pad(t, ((0, 0), (0, 0), (0, 0), (0, Lp - L), (0, 0)))

    def band(t):
        tp = jnp.pad(t, ((0, 0), (0, 0), (0, 0), (BLK, 0), (0, 0)))
        tp = tp.reshape(B, dilation, H, nb + 1, BLK, Dh)
        return jnp.concatenate([tp[:, :, :, :-1], tp[:, :, :, 1:]], axis=-2)

    qb = to_sub(q).reshape(B, dilation, H, nb, BLK, Dh)
    kb = band(to_sub(k))
    vb = band(to_sub(v))
    s = jnp.einsum('bdhnqc,bdhnkc->bdhnqk', qb, kb) * (Dh ** -0.5)
    qi = jnp.arange(BLK)[:, None]
    kj = jnp.arange(2 * BLK)[None, :]
    dist = qi + BLK - kj
    key_idx = jnp.arange(nb)[:, None, None] * BLK + kj[None] - BLK
    valid = (dist >= 0)[None] & (dist <= span)[None] & (key_idx >= 0)
    s = jnp.where(valid, s, -jnp.inf)
    m = jnp.max(s, axis=-1, keepdims=True)
    p = jnp.exp(s - m)
    l = jnp.sum(p, axis=-1, keepdims=True)
    o = jnp.einsum('bdhnqk,bdhnkc->bdhnqc', p, vb) / l
    lse = (m + jnp.log(l))[..., 0]
    o = o.reshape(B, dilation, H, Lp, Dh)[:, :, :, :L].transpose(0, 3, 1, 2, 4).reshape(B, S, H, Dh)
    lse = lse.reshape(B, dilation, H, Lp)[..., :L].transpose(0, 3, 1, 2).reshape(B, S, H)
    return o, lse


def setup_inputs(seed: int = 0) -> dict:
    key = jax.random.key(seed)
    ks = jax.random.split(key, 8)
    x = jax.random.normal(ks[0], (BATCH, SEQ, D_MODEL), jnp.float32)
    norm_w = 1.0 + 0.02 * jax.random.normal(ks[1], (DEPTH, D_MODEL), jnp.float32)
    w_in = jax.random.normal(ks[2], (DEPTH, D_MODEL, IN_COLS), jnp.float32) * D_MODEL ** -0.5
    hgrn_lb_logits = 0.5 * jax.random.normal(ks[3], (DEPTH + 1, HG_HEADS * HG_DK), jnp.float32)
    hg_norm_w = 1.0 + 0.02 * jax.random.normal(ks[4], (DEPTH, HG_HEADS * HG_DV), jnp.float32)
    w_out = jax.random.normal(ks[5], (DEPTH, D_MIX, D_MODEL), jnp.float32) * D_MIX ** -0.5
    final_norm_w = 1.0 + 0.02 * jax.random.normal(ks[6], (D_MODEL,), jnp.float32)
    return {"x": x, "norm_w": norm_w, "w_in": w_in, "hgrn_lb_logits": hgrn_lb_logits,
            "hg_norm_w": hg_norm_w, "w_out": w_out, "final_norm_w": final_norm_w}


def reference(x, norm_w, w_in, hgrn_lb_logits, hg_norm_w, w_out, final_norm_w):
    B, S, _ = x.shape
    positions = jnp.arange(S, dtype=jnp.int32)
    lb_table = jnp.cumsum(jax.nn.softmax(hgrn_lb_logits.astype(jnp.float32), axis=0), axis=0)
    split_points = list(np.cumsum(IN_SPLITS)[:-1])
    h = x
    for layer in range(DEPTH):
        u = rms_norm(h, norm_w[layer])
        proj = jnp.einsum('bsd,dc->bsc', u, w_in[layer].astype(jnp.float32))
        hg_q, hg_f, hg_i, hg_z, at_q, at_k, at_v, at_z = jnp.split(proj, split_points, axis=-1)

        lb = jnp.clip(lb_table[layer], 1e-6, 1.0 - 1e-6).reshape(HG_HEADS, HG_DK)
        o_hg = hgrn2_mixer(hg_q.reshape(B, S, HG_HEADS, HG_DK),
                           hg_f.reshape(B, S, HG_HEADS, HG_DK),
                           hg_i.reshape(B, S, HG_HEADS, HG_DV), lb)
        g = hg_norm_w[layer].astype(jnp.float32).reshape(HG_HEADS, HG_DV)
        o_hg = o_hg * lax.rsqrt(jnp.mean(o_hg * o_hg, axis=-1, keepdims=True) + NORM_EPS) * g
        o_hg = o_hg.reshape(B, S, HG_WIDTH) * jax.nn.silu(hg_z)

        q = rope(at_q.reshape(B, S, AT_HEADS, AT_HEAD_DIM), positions)
        k = rope(at_k.reshape(B, S, AT_HEADS, AT_HEAD_DIM), positions)
        v = at_v.reshape(B, S, AT_HEADS, AT_HEAD_DIM)
        outs, lses = [], []
        for window, dilation in DILATED_PATTERNS:
            o_i, lse_i = dilated_window_attention(q, k, v, window, dilation)
            outs.append(o_i)
            lses.append(lse_i)
        mix_w = jax.nn.softmax(jnp.stack(lses, axis=0), axis=0)[..., None]
        o_at = jnp.sum(mix_w * jnp.stack(outs, axis=0), axis=0)
        o_at = o_at.reshape(B, S, AT_WIDTH) * jax.nn.silu(at_z)

        mixed = jnp.concatenate([o_hg, o_at], axis=-1)
        y = jnp.einsum('bsc,cd->bsd', mixed, w_out[layer].astype(jnp.float32))
        h = h + y.astype(h.dtype)
    return rms_norm(h, final_norm_w).astype(x.dtype)
```

```cpp
#include <hip/hip_runtime.h>
#include <hip/hip_cooperative_groups.h>
#include <cstdio>
namespace cg = cooperative_groups;

typedef short bf16x8 __attribute__((ext_vector_type(8)));
typedef float f32x16 __attribute__((ext_vector_type(16)));
typedef __bf16 bf2_t __attribute__((ext_vector_type(2)));
typedef float f2_t __attribute__((ext_vector_type(2)));
typedef unsigned u32x4 __attribute__((ext_vector_type(4)));
typedef unsigned short u16;

#define DI __device__ __forceinline__
#define MFMA32(a, b, c) __builtin_amdgcn_mfma_f32_32x32x16_bf16((a), (b), (c), 0, 0, 0)

constexpr int NTOK = 16384, DM = 1024, SEQ = 8192;
constexpr float EPS = 1e-6f;
constexpr float LOG2E = 1.4426950408889634f;

constexpr size_t MB = 1024 * 1024;
constexpr size_t OFF_XB = 0;
constexpr size_t OFF_RS = OFF_XB + 32 * MB;
constexpr size_t OFF_WINT = OFF_RS + 65536;
constexpr size_t OFF_WOUTT = OFF_WINT + 8 * MB;
constexpr size_t OFF_ROPE = OFF_WOUTT + 2 * MB;
constexpr size_t OFF_HQ = OFF_ROPE + 2 * MB;
constexpr size_t OFF_LF = OFF_HQ + 16 * MB;
constexpr size_t OFF_VIT = OFF_LF + 32 * MB;
constexpr size_t OFF_HZ = OFF_VIT + 16 * MB;
constexpr size_t OFF_AQ = OFF_HZ + 16 * MB;
constexpr size_t OFF_AK = OFF_AQ + 16 * MB;
constexpr size_t OFF_AV = OFF_AK + 16 * MB;
constexpr size_t OFF_AZ = OFF_AV + 16 * MB;
constexpr size_t OFF_ST = OFF_AZ + 16 * MB;
constexpr size_t OFF_DEC = OFF_ST + 32 * MB;
constexpr size_t OFF_AO2 = OFF_DEC + 512 * 1024;
constexpr size_t OFF_LSE = OFF_AO2 + 16 * MB;
constexpr size_t OFF_END = OFF_LSE + 3 * 16384 * 8 * 4;

struct P {
    const float* x; const float* norm_w; const float* w_in; const float* lbl; const float* hgw; const float* w_out; const float* fw;
    float* out;
    u16* xb; float* rs; u16* winT; u16* woutT; float* rope;
    u16* hq; float* lf; u16* viT; u16* hz; u16* aq; u16* ak; u16* av; u16* az;
    u16* ST; float* dec; u16* ao0; u16* ao1; u16* ao2; float* lse; u16* mixhg;
    int phase_lo, phase_hi;
};

DI unsigned pack2(float a, float b) { f2_t v = {a, b}; return __builtin_bit_cast(unsigned, __builtin_convertvector(v, bf2_t)); }
DI u16 f2bf(float x) { return (u16)(pack2(x, 0.f) & 0xffffu); }
DI float bf2f(u16 v) { return __uint_as_float(((unsigned)v) << 16); }
DI float bflo(unsigned v) { return __uint_as_float(v << 16); }
DI float bfhi(unsigned v) { return __uint_as_float(v & 0xffff0000u); }
DI int crow(int reg, int h) { return (reg & 3) + 8 * (reg >> 2) + 4 * h; }
DI float silu(float v) { return v / (1.f + __expf(-v)); }
DI bf16x8 packB(const f32x16& x, int s) {
    u32x4 pk;
    pk[0] = pack2(x[8 * s + 0], x[8 * s + 1]); pk[1] = pack2(x[8 * s + 2], x[8 * s + 3]);
    pk[2] = pack2(x[8 * s + 4], x[8 * s + 5]); pk[3] = pack2(x[8 * s + 6], x[8 * s + 7]);
    return __builtin_bit_cast(bf16x8, pk);
}
DI float kfromlf(float v) { return (v > -0.02f) ? -v * (1.f + v * (0.5f + v * (1.f / 6.f))) : 1.f - __expf(v); }

DI void phase0(const P& p, char* smem) {
    const int tid = threadIdx.x, lane = tid & 63, wid = tid >> 6;
    for (int row = blockIdx.x * 4 + wid; row < NTOK; row += gridDim.x * 4) {
        const float4* xr = (const float4*)(p.x + (size_t)row * DM);
        float4 v[4]; float ss = 0.f;
#pragma unroll
        for (int i = 0; i < 4; ++i) { v[i] = xr[lane + 64 * i]; ss += v[i].x * v[i].x + v[i].y * v[i].y + v[i].z * v[i].z + v[i].w * v[i].w; }
#pragma unroll
        for (int o = 32; o >= 1; o >>= 1) ss += __shfl_xor(ss, o);
        uint2* xo = (uint2*)(p.xb + (size_t)row * DM);
#pragma unroll
        for (int i = 0; i < 4; ++i) xo[lane + 64 * i] = make_uint2(pack2(v[i].x, v[i].y), pack2(v[i].z, v[i].w));
        if (lane == 0) p.rs[row] = rsqrtf(ss * (1.f / 1024.f) + EPS);
    }
    float* tile = (float*)smem;
    for (int t = blockIdx.x; t < 1024 + 256; t += gridDim.x) {
        const float* src; u16* dst; int ncols, td, tc; bool scale;
        if (t < 1024) { src = p.w_in; dst = p.winT; ncols = 4096; td = t >> 6; tc = t & 63; scale = true; }
        else { const int t2 = t - 1024; src = p.w_out; dst = p.woutT; ncols = 1024; td = t2 >> 4; tc = t2 & 15; scale = false; }
#pragma unroll
        for (int i = 0; i < 4; ++i) {
            const int r = (tid >> 4) + 16 * i, c4 = (tid & 15) * 4;
            float4 v = *(const float4*)(src + (size_t)(td * 64 + r) * ncols + tc * 64 + c4);
            const float s = scale ? p.norm_w[td * 64 + r] : 1.f;
            tile[r * 65 + c4 + 0] = v.x * s; tile[r * 65 + c4 + 1] = v.y * s; tile[r * 65 + c4 + 2] = v.z * s; tile[r * 65 + c4 + 3] = v.w * s;
        }
        __syncthreads();
#pragma unroll
        for (int u = 0; u < 2; ++u) {
            const int g = (tid & 3) + 4 * u, c = tid >> 2;
            float e[8];
#pragma unroll
            for (int j = 0; j < 8; ++j) e[j] = tile[(g * 8 + j) * 65 + c];
            u32x4 pk; pk[0] = pack2(e[0], e[1]); pk[1] = pack2(e[2], e[3]); pk[2] = pack2(e[4], e[5]); pk[3] = pack2(e[6], e[7]);
            *(u32x4*)(dst + (size_t)(tc * 64 + c) * 1024 + td * 64 + g * 8) = pk;
        }
        __syncthreads();
    }
    for (int idx = blockIdx.x * 256 + tid; idx < SEQ * 32; idx += gridDim.x * 256) {
        const int pos = idx >> 5, j = idx & 31;
        const float inv = (float)(1.0 / exp2((double)j * (13.287712379549449 / 32.0)));
        const float ang = (float)pos * inv;
        const double rev = (double)ang * 0.15915494309189535;
        const float fr = (float)(rev - floor(rev));
        p.rope[idx] = __builtin_amdgcn_cosf(fr);
        p.rope[SEQ * 32 + idx] = __builtin_amdgcn_sinf(fr);
    }
}

template <int GRP, int G4> DI void epi_unit(const P& p, const f32x16& a0, const f32x16& a1, int cl, int rb0, int l31, float oml0, float oml1) {
    const float4 rsv = *(const float4*)(p.rs + rb0);
    float v0[4], v1[4];
    v0[0] = a0[G4 * 4 + 0] * rsv.x; v0[1] = a0[G4 * 4 + 1] * rsv.y; v0[2] = a0[G4 * 4 + 2] * rsv.z; v0[3] = a0[G4 * 4 + 3] * rsv.w;
    v1[0] = a1[G4 * 4 + 0] * rsv.x; v1[1] = a1[G4 * 4 + 1] * rsv.y; v1[2] = a1[G4 * 4 + 2] * rsv.z; v1[3] = a1[G4 * 4 + 3] * rsv.w;
    const size_t o0 = (size_t)rb0 * 512 + cl + l31;
    if (GRP == 0 || GRP == 3 || GRP == 7) {
        u16* dst = ((GRP == 0) ? p.hq : (GRP == 3 ? p.hz : p.az)) + o0;
#pragma unroll
        for (int j = 0; j < 4; ++j) { dst[j * 512] = f2bf(silu(v0[j])); dst[j * 512 + 32] = f2bf(silu(v1[j])); }
    } else if (GRP == 1) {
        float* dst = p.lf + o0;
#pragma unroll
        for (int j = 0; j < 4; ++j) {
            const float u0 = oml0 / (1.f + __expf(v0[j])), u1 = oml1 / (1.f + __expf(v1[j]));
            dst[j * 512] = log1pf(-u0); dst[j * 512 + 32] = log1pf(-u1);
        }
    } else if (GRP == 2) {
        const int b = rb0 >> 13, t = rb0 & 8191;
        *(uint2*)(p.viT + ((size_t)(b * 512 + cl + l31)) * 8192 + t) = make_uint2(pack2(v0[0], v0[1]), pack2(v0[2], v0[3]));
        *(uint2*)(p.viT + ((size_t)(b * 512 + cl + 32 + l31)) * 8192 + t) = make_uint2(pack2(v1[0], v1[1]), pack2(v1[2], v1[3]));
    } else if (GRP == 6) {
        u16* dst = p.av + o0;
#pragma unroll
        for (int j = 0; j < 4; ++j) { dst[j * 512] = f2bf(v0[j]); dst[j * 512 + 32] = f2bf(v1[j]); }
    } else {
        u16* dst = ((GRP == 4) ? p.aq : p.ak) + o0;
        const float sc = (GRP == 4) ? 0.125f : 1.f;
        const float* rp = p.rope + (rb0 & 8191) * 32 + l31;
#pragma unroll
        for (int j = 0; j < 4; ++j) {
            const float cs = rp[j * 32] * sc, sn = rp[SEQ * 32 + j * 32] * sc;
            dst[j * 512] = f2bf(v0[j] * cs - v1[j] * sn);
            dst[j * 512 + 32] = f2bf(v1[j] * cs + v0[j] * sn);
        }
    }
}
template <int GRP> DI void epi1(const P& p, const f32x16 (&acc)[4][2], int cl, int rowb, int l31, int lh) {
    float oml0 = 0.f, oml1 = 0.f;
    if (GRP == 1) {
        const float a0 = p.lbl[cl + l31], a1 = p.lbl[512 + cl + l31];
        const float b0 = p.lbl[cl + 32 + l31], b1 = p.lbl[512 + cl + 32 + l31];
        float lb0 = 1.f / (1.f + __expf(a1 - a0)), lb1 = 1.f / (1.f + __expf(b1 - b0));
        lb0 = fminf(fmaxf(lb0, 1e-6f), 1.f - 1e-6f); lb1 = fminf(fmaxf(lb1, 1e-6f), 1.f - 1e-6f);
        oml0 = 1.f - lb0; oml1 = 1.f - lb1;
    }
    const int rbl = rowb + lh * 4;
#define EPI_U(MT, G4) epi_unit<GRP, G4>(p, acc[MT][0], acc[MT][1], cl, rbl + MT * 32 + G4 * 8, l31, oml0, oml1);
#define EPI_M(MT) EPI_U(MT, 0) EPI_U(MT, 1) EPI_U(MT, 2) EPI_U(MT, 3)
    EPI_M(0) EPI_M(1) EPI_M(2) EPI_M(3)
#undef EPI_M
#undef EPI_U
}

DI void phase1(const P& p, char* smem) {
    const int tid = threadIdx.x, lane = tid & 63, wid = tid >> 6, wr = wid >> 1, wc = wid & 1;
    const int l31 = lane & 31, lh = lane >> 5;
    char* As = smem;
    char* Bs = smem + 256 * 144;
    const int c8 = tid & 7, r0 = tid >> 3;
    for (int tile = blockIdx.x; tile < 2048; tile += gridDim.x) {
        const int xcd = tile & 7, idx = (tile >> 3) & 63, rnd = tile >> 9;
        const int sid = rnd * 8 + xcd;
        const int pm = (sid & 7) * 8 + (idx & 7), pn = (sid >> 3) * 8 + (idx >> 3);
        const u16* Ag = p.xb + (size_t)pm * 256 * 1024 + (size_t)r0 * 1024 + c8 * 8;
        const u16* Bg = p.winT + (size_t)pn * 128 * 1024 + (size_t)r0 * 1024 + c8 * 8;
        f32x16 acc[4][2];
#pragma unroll
        for (int m = 0; m < 4; ++m)
#pragma unroll
            for (int n = 0; n < 2; ++n)
#pragma unroll
                for (int r = 0; r < 16; ++r) acc[m][n][r] = 0.f;
        u32x4 ra[8], rb[4];
#pragma unroll
        for (int i = 0; i < 8; ++i) ra[i] = *(const u32x4*)(Ag + (size_t)(32 * i) * 1024);
#pragma unroll
        for (int i = 0; i < 4; ++i) rb[i] = *(const u32x4*)(Bg + (size_t)(32 * i) * 1024);
        __syncthreads();
#pragma unroll
        for (int i = 0; i < 8; ++i) *(u32x4*)(As + (r0 + 32 * i) * 144 + c8 * 16) = ra[i];
#pragma unroll
        for (int i = 0; i < 4; ++i) *(u32x4*)(Bs + (r0 + 32 * i) * 144 + c8 * 16) = rb[i];
        __syncthreads();
        for (int kt = 0; kt < 16; ++kt) {
            if (kt < 15) {
#pragma unroll
                for (int i = 0; i < 8; ++i) ra[i] = *(const u32x4*)(Ag + (size_t)(32 * i) * 1024 + (kt + 1) * 64);
#pragma unroll
                for (int i = 0; i < 4; ++i) rb[i] = *(const u32x4*)(Bg + (size_t)(32 * i) * 1024 + (kt + 1) * 64);
            }
#pragma unroll
            for (int ks = 0; ks < 4; ++ks) {
                bf16x8 af[4], bfr[2];
#pragma unroll
                for (int m = 0; m < 4; ++m) af[m] = *(const bf16x8*)(As + (wr * 128 + m * 32 + l31) * 144 + (ks * 16 + lh * 8) * 2);
#pragma unroll
                for (int n = 0; n < 2; ++n) bfr[n] = *(const bf16x8*)(Bs + (wc * 64 + n * 32 + l31) * 144 + (ks * 16 + lh * 8) * 2);
#pragma unroll
                for (int m = 0; m < 4; ++m)
#pragma unroll
                    for (int n = 0; n < 2; ++n) acc[m][n] = MFMA32(af[m], bfr[n], acc[m][n]);
            }
            __syncthreads();
            if (kt < 15) {
#pragma unroll
                for (int i = 0; i < 8; ++i) *(u32x4*)(As + (r0 + 32 * i) * 144 + c8 * 16) = ra[i];
#pragma unroll
                for (int i = 0; i < 4; ++i) *(u32x4*)(Bs + (r0 + 32 * i) * 144 + c8 * 16) = rb[i];
                __syncthreads();
            }
        }
        const int grp = pn >> 2;
        const int cl = ((pn & 3) * 128) + wc * 64;
        const int rowb = pm * 256 + wr * 128;
        switch (grp) {
            case 0: epi1<0>(p, acc, cl, rowb, l31, lh); break;
            case 1: epi1<1>(p, acc, cl, rowb, l31, lh); break;
            case 2: epi1<2>(p, acc, cl, rowb, l31, lh); break;
            case 3: epi1<3>(p, acc, cl, rowb, l31, lh); break;
            case 4: epi1<4>(p, acc, cl, rowb, l31, lh); break;
            case 5: epi1<5>(p, acc, cl, rowb, l31, lh); break;
            case 6: epi1<6>(p, acc, cl, rowb, l31, lh); break;
            default: epi1<7>(p, acc, cl, rowb, l31, lh); break;
        }
    }
}

DI void pass1(const P& p, char* smem, int item) {
    const int tid = threadIdx.x, lane = tid & 63, wid = tid >> 6, l31 = lane & 31, lh = lane >> 5;
    const int bh = item >> 7, c = item & 127, b = bh >> 2, h = bh & 3;
    const size_t m0 = (size_t)b * 8192 + c * 64;
    float* tot = (float*)smem;
    char* kdT = smem + 1024;
    const int k = tid & 127, half = tid >> 7;
    const float* lfp = p.lf + (m0 + half * 32) * 512 + h * 128 + k;
    float v[32]; float T = 0.f;
#pragma unroll
    for (int i = 0; i < 32; ++i) { v[i] = lfp[(size_t)i * 512]; T += v[i]; }
    tot[half * 128 + k] = T;
    __syncthreads();
    const float other = tot[(half ^ 1) * 128 + k];
    float suf = (half == 0) ? other : 0.f;
    float kd[32];
#pragma unroll
    for (int i = 31; i >= 0; --i) { kd[i] = kfromlf(v[i]) * __expf(suf); suf += v[i]; }
#pragma unroll
    for (int q = 0; q < 4; ++q) {
        u32x4 pk;
        pk[0] = pack2(kd[8 * q + 0], kd[8 * q + 1]); pk[1] = pack2(kd[8 * q + 2], kd[8 * q + 3]);
        pk[2] = pack2(kd[8 * q + 4], kd[8 * q + 5]); pk[3] = pack2(kd[8 * q + 6], kd[8 * q + 7]);
        *(u32x4*)(kdT + k * 144 + half * 64 + q * 16) = pk;
    }
    if (half == 0) p.dec[(size_t)item * 128 + k] = __expf(T + other);
    __syncthreads();
    const u16* vrow = p.viT + ((size_t)(b * 512 + h * 128 + wid * 32 + l31)) * 8192 + c * 64;
    f32x16 acc[4];
#pragma unroll
    for (int n = 0; n < 4; ++n)
#pragma unroll
        for (int r = 0; r < 16; ++r) acc[n][r] = 0.f;
#pragma unroll
    for (int ks = 0; ks < 4; ++ks) {
        const bf16x8 a = *(const bf16x8*)(vrow + ks * 16 + lh * 8);
#pragma unroll
        for (int nt = 0; nt < 4; ++nt) {
            const bf16x8 bb = *(const bf16x8*)(kdT + (nt * 32 + l31) * 144 + (ks * 16 + lh * 8) * 2);
            acc[nt] = MFMA32(a, bb, acc[nt]);
        }
    }
    u16* so = p.ST + (size_t)item * 16384;
#pragma unroll
    for (int nt = 0; nt < 4; ++nt)
#pragma unroll
        for (int r = 0; r < 16; ++r) so[(wid * 32 + crow(r, lh)) * 128 + nt * 32 + l31] = f2bf(acc[nt][r]);
    __syncthreads();
}

DI void pass2(const P& p) {
    for (int e = blockIdx.x * 256 + threadIdx.x; e < 65536; e += gridDim.x * 256) {
        const int bh = e >> 13, rem = e & 8191, k2 = (rem & 63) * 2;
        unsigned* st = (unsigned*)p.ST + (size_t)bh * 128 * 8192 + rem;
        const float2* dc = (const float2*)(p.dec + (size_t)bh * 128 * 128 + k2);
        float r0 = 0.f, r1 = 0.f;
        for (int c0 = 0; c0 < 128; c0 += 8) {
            unsigned s[8]; float2 d[8];
#pragma unroll
            for (int j = 0; j < 8; ++j) { s[j] = st[(size_t)(c0 + j) * 8192]; d[j] = dc[(c0 + j) * 64]; }
#pragma unroll
            for (int j = 0; j < 8; ++j) {
                st[(size_t)(c0 + j) * 8192] = pack2(r0, r1);
                r0 = d[j].x * r0 + bflo(s[j]); r1 = d[j].y * r1 + bfhi(s[j]);
            }
        }
    }
}

DI void attn_item(const P& p, char* smem, int item) {
    const int tid = threadIdx.x, lane = tid & 63, wid = tid >> 6, l31 = lane & 31, lh = lane >> 5;
    const int pat = item >> 10, idx = item & 1023;
    const int dl = pat * 2, d = 1 << dl, nblk = 64 >> dl;
    const int nb = idx & (nblk - 1);
    int rest = idx >> (6 - dl);
    const int r = rest & (d - 1); rest >>= dl;
    const int hh = rest & 7, b = rest >> 3;
    char* Ks = smem;
    char* VT = smem + 256 * 144;
    const size_t tokbase = (size_t)b * 8192;
    {
        const int c8 = tid & 7, kr = tid >> 3;
#pragma unroll
        for (int i = 0; i < 8; ++i) {
            const int key = kr + 32 * i;
            const int j = nb * 128 - 128 + key;
            if (j >= 0) {
                const size_t off = (tokbase + (size_t)j * d + r) * 512 + hh * 64 + c8 * 8;
                const u32x4 kv = *(const u32x4*)(p.ak + off);
                const u32x4 vv = *(const u32x4*)(p.av + off);
                *(u32x4*)(Ks + key * 144 + c8 * 16) = kv;
#pragma unroll
                for (int e = 0; e < 4; ++e) {
                    *(u16*)(VT + (c8 * 8 + 2 * e) * 520 + key * 2) = (u16)(vv[e] & 0xffffu);
                    *(u16*)(VT + (c8 * 8 + 2 * e + 1) * 520 + key * 2) = (u16)(vv[e] >> 16);
                }
            }
        }
    }
    const int jq = nb * 128 + wid * 32 + l31;
    const size_t mq = tokbase + (size_t)jq * d + r;
    bf16x8 qf[4];
#pragma unroll
    for (int ks = 0; ks < 4; ++ks) qf[ks] = *(const bf16x8*)(p.aq + mq * 512 + hh * 64 + ks * 16 + lh * 8);
    __syncthreads();
    const int kt_lo = (nb == 0) ? 4 : 0;
    f32x16 st[5];
    float mx = -INFINITY;
#pragma unroll
    for (int i = 0; i < 5; ++i) {
        const int kt = wid + i;
        if (kt >= kt_lo) {
#pragma unroll
            for (int rr = 0; rr < 16; ++rr) st[i][rr] = 0.f;
#pragma unroll
            for (int ks = 0; ks < 4; ++ks) {
                const bf16x8 a = *(const bf16x8*)(Ks + (kt * 32 + l31) * 144 + (ks * 16 + lh * 8) * 2);
                st[i] = MFMA32(a, qf[ks], st[i]);
            }
#pragma unroll
            for (int rr = 0; rr < 16; ++rr) {
                const int dist = wid * 32 + l31 + 128 - (kt * 32 + crow(rr, lh));
                if (dist < 0 || dist > 128) st[i][rr] = -INFINITY;
                mx = fmaxf(mx, st[i][rr]);
            }
        } else {
#pragma unroll
            for (int rr = 0; rr < 16; ++rr) st[i][rr] = -INFINITY;
        }
    }
    mx = fmaxf(mx, __shfl_xor(mx, 32));
    float l = 0.f;
    const float mxs = mx * LOG2E;
#pragma unroll
    for (int i = 0; i < 5; ++i)
#pragma unroll
        for (int rr = 0; rr < 16; ++rr) { const float e = exp2f(st[i][rr] * LOG2E - mxs); st[i][rr] = e; l += e; }
    l += __shfl_xor(l, 32);
    f32x16 o[2];
#pragma unroll
    for (int dt = 0; dt < 2; ++dt)
#pragma unroll
        for (int rr = 0; rr < 16; ++rr) o[dt][rr] = 0.f;
#pragma unroll
    for (int i = 0; i < 5; ++i) {
        const int kt = wid + i;
        if (kt >= kt_lo) {
#pragma unroll
            for (int ks2 = 0; ks2 < 2; ++ks2) {
                const bf16x8 bq = packB(st[i], ks2);
#pragma unroll
                for (int dt = 0; dt < 2; ++dt) {
                    const char* ad = VT + (dt * 32 + l31) * 520 + (kt * 32 + ks2 * 16 + lh * 4) * 2;
                    const uint2 lo = *(const uint2*)ad, hi = *(const uint2*)(ad + 16);
                    u32x4 av4; av4[0] = lo.x; av4[1] = lo.y; av4[2] = hi.x; av4[3] = hi.y;
                    o[dt] = MFMA32(__builtin_bit_cast(bf16x8, av4), bq, o[dt]);
                }
            }
        }
    }
    const float inv = 1.f / l;
    u16* op = (pat == 0 ? p.ao0 : (pat == 1 ? p.ao1 : p.ao2)) + mq * 512 + hh * 64;
#pragma unroll
    for (int dt = 0; dt < 2; ++dt)
#pragma unroll
        for (int g4 = 0; g4 < 4; ++g4)
            *(uint2*)(op + dt * 32 + g4 * 8 + lh * 4) = make_uint2(pack2(o[dt][g4 * 4] * inv, o[dt][g4 * 4 + 1] * inv), pack2(o[dt][g4 * 4 + 2] * inv, o[dt][g4 * 4 + 3] * inv));
    if (lh == 0) p.lse[((size_t)pat * NTOK + mq) * 8 + hh] = mx + __logf(l);
    __syncthreads();
}

DI void pass3(const P& p, char* smem, int item) {
    const int tid = threadIdx.x, lane = tid & 63, wid = tid >> 6, l31 = lane & 31, lh = lane >> 5;
    const int bh = item >> 7, c = item & 127, b = bh >> 2, h = bh & 3;
    const size_t m0 = (size_t)b * 8192 + c * 64;
    float* tot = (float*)smem;
    float* red = (float*)(smem + 1024);
    char* Qp = smem + 2048;
    char* Qpp = Qp + 64 * 272;
    char* Kp = Qpp + 64 * 272;
    {
        const int k = tid & 127, half = tid >> 7;
        const float* lfp = p.lf + (m0 + half * 32) * 512 + h * 128 + k;
        const u16* qp = p.hq + (m0 + half * 32) * 512 + h * 128 + k;
        float v[32]; float T = 0.f;
#pragma unroll
        for (int i = 0; i < 32; ++i) { v[i] = lfp[(size_t)i * 512]; T += v[i]; }
        tot[half * 128 + k] = T;
        __syncthreads();
        const float other = tot[(half ^ 1) * 128 + k];
        const float bref = (half == 0) ? T : other;
        const float ebref = __expf(bref);
        const float sub = (half == 0) ? T : 0.f;
        float pre = 0.f;
#pragma unroll
        for (int i = 0; i < 32; ++i) {
            pre += v[i];
            const float xx = pre - sub;
            const float E1 = __expf(xx), Ei = __expf(-xx);
            const float q = bf2f(qp[(size_t)i * 512]);
            const float kk = kfromlf(v[i]);
            const int row = half * 32 + i;
            *(u16*)(Qp + row * 272 + k * 2) = f2bf(q * E1);
            *(u16*)(Qpp + row * 272 + k * 2) = f2bf(q * E1 * ebref);
            *(u16*)(Kp + row * 272 + k * 2) = f2bf(kk * Ei);
        }
    }
    __syncthreads();
    const int tt = wid & 1, vh = wid >> 1;
    f32x16 at[2];
#pragma unroll
    for (int st = 0; st < 2; ++st) {
#pragma unroll
        for (int rr = 0; rr < 16; ++rr) at[st][rr] = 0.f;
        if (st <= tt) {
#pragma unroll
            for (int ks = 0; ks < 8; ++ks) {
                const bf16x8 a = *(const bf16x8*)(Kp + (st * 32 + l31) * 272 + (ks * 16 + lh * 8) * 2);
                const bf16x8 bq = *(const bf16x8*)(Qp + (tt * 32 + l31) * 272 + (ks * 16 + lh * 8) * 2);
                at[st] = MFMA32(a, bq, at[st]);
            }
            if (st == tt) {
#pragma unroll
                for (int rr = 0; rr < 16; ++rr) if (crow(rr, lh) > l31) at[st][rr] = 0.f;
            }
        }
    }
    f32x16 o[2];
#pragma unroll
    for (int vt = 0; vt < 2; ++vt) {
#pragma unroll
        for (int rr = 0; rr < 16; ++rr) o[vt][rr] = 0.f;
        const int vrow = 64 * vh + 32 * vt + l31;
        const u16* srow = p.ST + (size_t)item * 16384 + vrow * 128;
#pragma unroll
        for (int ks = 0; ks < 8; ++ks) {
            const bf16x8 a = *(const bf16x8*)(srow + ks * 16 + lh * 8);
            const bf16x8 bq = *(const bf16x8*)(Qpp + (tt * 32 + l31) * 272 + (ks * 16 + lh * 8) * 2);
            o[vt] = MFMA32(a, bq, o[vt]);
        }
        const u16* vr = p.viT + ((size_t)(b * 512 + h * 128 + vrow)) * 8192 + c * 64;
#pragma unroll
        for (int st = 0; st < 2; ++st) {
            if (st <= tt) {
#pragma unroll
                for (int ks2 = 0; ks2 < 2; ++ks2) {
                    const uint2 lo = *(const uint2*)(vr + st * 32 + ks2 * 16 + lh * 4);
                    const uint2 hi = *(const uint2*)(vr + st * 32 + ks2 * 16 + 8 + lh * 4);
                    u32x4 av4; av4[0] = lo.x; av4[1] = lo.y; av4[2] = hi.x; av4[3] = hi.y;
                    o[vt] = MFMA32(__builtin_bit_cast(bf16x8, av4), packB(at[st], ks2), o[vt]);
                }
            }
        }
    }
    float ss = 0.f;
#pragma unroll
    for (int vt = 0; vt < 2; ++vt)
#pragma unroll
        for (int rr = 0; rr < 16; ++rr) ss += o[vt][rr] * o[vt][rr];
    ss += __shfl_xor(ss, 32);
    if (lh == 0) red[vh * 64 + tt * 32 + l31] = ss;
    __syncthreads();
    const float tot2 = red[tt * 32 + l31] + red[64 + tt * 32 + l31];
    const float rinv = rsqrtf(tot2 * (1.f / 128.f) + EPS);
    const size_t m = m0 + tt * 32 + l31;
#pragma unroll
    for (int vt = 0; vt < 2; ++vt)
#pragma unroll
        for (int g4 = 0; g4 < 4; ++g4) {
            const int vb = 64 * vh + 32 * vt + 8 * g4 + 4 * lh;
            const float4 gw = *(const float4*)(p.hgw + h * 128 + vb);
            const uint2 zz = *(const uint2*)(p.hz + m * 512 + h * 128 + vb);
            const float y0 = o[vt][g4 * 4 + 0] * rinv * gw.x * bflo(zz.x);
            const float y1 = o[vt][g4 * 4 + 1] * rinv * gw.y * bfhi(zz.x);
            const float y2 = o[vt][g4 * 4 + 2] * rinv * gw.z * bflo(zz.y);
            const float y3 = o[vt][g4 * 4 + 3] * rinv * gw.w * bfhi(zz.y);
            *(uint2*)(p.mixhg + m * 512 + h * 128 + vb) = make_uint2(pack2(y0, y1), pack2(y2, y3));
        }
    __syncthreads();
}

DI void phase5(const P& p, char* smem, int tile) {
    int tid = threadIdx.x;
    asm volatile("" : "+v"(tid));
    const int lane = tid & 63, wid = tid >> 6, l31 = lane & 31, lh = lane >> 5;
    const size_t m0 = (size_t)tile * 32;
    char* Am = smem;
    float* red = (float*)(smem + 32 * 2064);
#pragma unroll 1
    for (int i = 0; i < 8; ++i) {
        const int idx = tid + 256 * i, r = idx >> 6, ch = idx & 63;
        const size_t m = m0 + r;
        *(u32x4*)(Am + r * 2064 + ch * 16) = *(const u32x4*)(p.mixhg + m * 512 + ch * 8);
        const int hh = ch >> 3;
        const float l0 = p.lse[(size_t)m * 8 + hh], l1 = p.lse[((size_t)NTOK + m) * 8 + hh], l2 = p.lse[((size_t)2 * NTOK + m) * 8 + hh];
        const float mx = fmaxf(l0, fmaxf(l1, l2));
        float w0 = __expf(l0 - mx), w1 = __expf(l1 - mx), w2 = __expf(l2 - mx);
        const float inv = 1.f / (w0 + w1 + w2);
        w0 *= inv; w1 *= inv; w2 *= inv;
        const u32x4 a0 = *(const u32x4*)(p.ao0 + m * 512 + ch * 8), a1 = *(const u32x4*)(p.ao1 + m * 512 + ch * 8), a2 = *(const u32x4*)(p.ao2 + m * 512 + ch * 8);
        const u32x4 zz = *(const u32x4*)(p.az + m * 512 + ch * 8);
        u32x4 pk;
#pragma unroll
        for (int e = 0; e < 4; ++e) {
            const float y0 = (w0 * bflo(a0[e]) + w1 * bflo(a1[e]) + w2 * bflo(a2[e])) * bflo(zz[e]);
            const float y1 = (w0 * bfhi(a0[e]) + w1 * bfhi(a1[e]) + w2 * bfhi(a2[e])) * bfhi(zz[e]);
            pk[e] = pack2(y0, y1);
        }
        *(u32x4*)(Am + r * 2064 + 1024 + ch * 16) = pk;
    }
    __syncthreads();
    f32x16 acc[8];
#pragma unroll
    for (int mt = 0; mt < 8; ++mt)
#pragma unroll
        for (int rr = 0; rr < 16; ++rr) acc[mt][rr] = 0.f;
    const int widu = __builtin_amdgcn_readfirstlane(wid);
    const u16* wbu = p.woutT + (size_t)widu * 256 * 1024;
    const int loff = l31 * 1024 + lh * 8;
#pragma unroll
    for (int hf = 0; hf < 2; ++hf) {
        const u16* wh = wbu + hf * 4 * 32 * 1024;
        bf16x8 wa[4];
#pragma unroll
        for (int j = 0; j < 4; ++j) wa[j] = *(const bf16x8*)(wh + j * 32 * 1024 + loff);
#pragma unroll 2
        for (int ks = 0; ks < 64; ++ks) {
            bf16x8 wn[4];
            const int kn = (ks + 1 < 64) ? ks + 1 : ks;
            const u16* wk = wh + kn * 16;
#pragma unroll
            for (int j = 0; j < 4; ++j) wn[j] = *(const bf16x8*)(wk + j * 32 * 1024 + loff);
            const bf16x8 bq = *(const bf16x8*)(Am + l31 * 2064 + (ks * 16 + lh * 8) * 2);
#pragma unroll
            for (int j = 0; j < 4; ++j) acc[hf * 4 + j] = MFMA32(wa[j], bq, acc[hf * 4 + j]);
#pragma unroll
            for (int j = 0; j < 4; ++j) wa[j] = wn[j];
        }
    }
    const size_t m = m0 + l31;
    float ss = 0.f;
#pragma unroll
    for (int mt = 0; mt < 8; ++mt) {
        __builtin_amdgcn_sched_barrier(0);
#pragma unroll
        for (int g4 = 0; g4 < 4; ++g4) {
            const int n = 256 * wid + 32 * mt + 8 * g4 + 4 * lh;
            const float4 xv = *(const float4*)(p.x + m * 1024 + n);
            acc[mt][g4 * 4 + 0] += xv.x; acc[mt][g4 * 4 + 1] += xv.y; acc[mt][g4 * 4 + 2] += xv.z; acc[mt][g4 * 4 + 3] += xv.w;
#pragma unroll
            for (int j = 0; j < 4; ++j) ss = fmaf(acc[mt][g4 * 4 + j], acc[mt][g4 * 4 + j], ss);
        }
    }
    ss += __shfl_xor(ss, 32);
    if (lh == 0) red[wid * 32 + l31] = ss;
    __syncthreads();
    const float tot = red[l31] + red[32 + l31] + red[64 + l31] + red[96 + l31];
    const float rinv = rsqrtf(tot * (1.f / 1024.f) + EPS);
#pragma unroll
    for (int mt = 0; mt < 8; ++mt) {
        __builtin_amdgcn_sched_barrier(0);
#pragma unroll
        for (int g4 = 0; g4 < 4; ++g4) {
            const int n = 256 * wid + 32 * mt + 8 * g4 + 4 * lh;
            const float4 fwv = *(const float4*)(p.fw + n);
            float4 ov;
            ov.x = acc[mt][g4 * 4 + 0] * rinv * fwv.x; ov.y = acc[mt][g4 * 4 + 1] * rinv * fwv.y;
            ov.z = acc[mt][g4 * 4 + 2] * rinv * fwv.z; ov.w = acc[mt][g4 * 4 + 3] * rinv * fwv.w;
            *(float4*)(p.out + m * 1024 + n) = ov;
        }
    }
    __syncthreads();
}

constexpr int SMEM_BYTES = 256 * 144 + 64 * 520;

__global__ void __launch_bounds__(256, 2) fwd_kernel(P p) {
    __shared__ __attribute__((aligned(16))) char smem[SMEM_BYTES];
    cg::grid_group grid = cg::this_grid();
    const bool coop = (p.phase_lo == 0 && p.phase_hi == 5);
    if (p.phase_lo <= 0 && p.phase_hi >= 0) phase0(p, smem);
    if (coop) grid.sync();
    if (p.phase_lo <= 1 && p.phase_hi >= 1) phase1(p, smem);
    if (coop) grid.sync();
    if (p.phase_lo <= 2 && p.phase_hi >= 2) { for (int it = blockIdx.x; it < 1024; it += gridDim.x) pass1(p, smem, it); }
    if (coop) grid.sync();
    if (p.phase_lo <= 3 && p.phase_hi >= 3) {
        pass2(p);
        if (gridDim.x == 512) {
            const int bi = blockIdx.x;
            const int first = (bi < 256) ? bi * 5 : 1280 + (bi - 256) * 7, cnt = (bi < 256) ? 5 : 7;
            for (int i = 0; i < cnt; ++i) attn_item(p, smem, first + i);
        } else {
            for (int it = blockIdx.x; it < 3072; it += gridDim.x) attn_item(p, smem, it);
        }
    }
    if (coop) grid.sync();
    if (p.phase_lo <= 4 && p.phase_hi >= 4) { for (int it = blockIdx.x; it < 1024; it += gridDim.x) pass3(p, smem, it); }
    if (coop) grid.sync();
    if (p.phase_lo <= 5 && p.phase_hi >= 5) { for (int it = blockIdx.x; it < 512; it += gridDim.x) phase5(p, smem, it); }
}

extern "C" void kernel_launch(void* const* d_in, const int* in_sizes, int n_in, void* d_out, int out_size, void* d_ws, size_t ws_size, hipStream_t stream) {
    static int grid_blocks = 0;
    if (!grid_blocks) {
        int dev = 0, cus = 0, per_cu = 0;
        hipGetDevice(&dev);
        hipDeviceGetAttribute(&cus, hipDeviceAttributeMultiprocessorCount, dev);
        hipOccupancyMaxActiveBlocksPerMultiprocessor(&per_cu, fwd_kernel, 256, 0);
        if (per_cu > 2) per_cu = 2;
        if (per_cu < 1) per_cu = 1;
        grid_blocks = cus * per_cu;
    }
    char* ws = (char*)d_ws;
    P p{};
    p.x = (const float*)d_in[0]; p.norm_w = (const float*)d_in[1]; p.w_in = (const float*)d_in[2]; p.lbl = (const float*)d_in[3];
    p.hgw = (const float*)d_in[4]; p.w_out = (const float*)d_in[5]; p.fw = (const float*)d_in[6];
    p.out = (float*)d_out;
    p.xb = (u16*)(ws + OFF_XB); p.rs = (float*)(ws + OFF_RS); p.winT = (u16*)(ws + OFF_WINT); p.woutT = (u16*)(ws + OFF_WOUTT); p.rope = (float*)(ws + OFF_ROPE);
    p.hq = (u16*)(ws + OFF_HQ); p.lf = (float*)(ws + OFF_LF); p.viT = (u16*)(ws + OFF_VIT); p.hz = (u16*)(ws + OFF_HZ);
    p.aq = (u16*)(ws + OFF_AQ); p.ak = (u16*)(ws + OFF_AK); p.av = (u16*)(ws + OFF_AV); p.az = (u16*)(ws + OFF_AZ);
    p.ST = (u16*)(ws + OFF_ST); p.dec = (float*)(ws + OFF_DEC);
    p.ao0 = (u16*)(ws + OFF_XB); p.ao1 = (u16*)(ws + OFF_XB + 16 * MB); p.ao2 = (u16*)(ws + OFF_AO2);
    p.lse = (float*)(ws + OFF_LSE); p.mixhg = (u16*)(ws + OFF_AQ);
    p.phase_lo = 0; p.phase_hi = 5;
    void* args[] = {&p};
    hipError_t e = hipLaunchCooperativeKernel((void*)fwd_kernel, dim3(grid_blocks), dim3(256), args, 0, stream);
    if (e != hipSuccess) fprintf(stderr, "cooperative launch failed: %s (grid %d)\n", hipGetErrorString(e), grid_blocks);
}
```

```cpp
#include <hip/hip_runtime.h>
#include <cstdio>

typedef short bf16x8 __attribute__((ext_vector_type(8)));
typedef float f32x16 __attribute__((ext_vector_type(16)));
typedef __bf16 bf2_t __attribute__((ext_vector_type(2)));
typedef float f2_t __attribute__((ext_vector_type(2)));
typedef unsigned u32x4 __attribute__((ext_vector_type(4)));
typedef unsigned short u16;

#define DI __device__ __forceinline__
#define MFMA32(a, b, c) __builtin_amdgcn_mfma_f32_32x32x16_bf16((a), (b), (c), 0, 0, 0)

constexpr int NTOK = 16384, DM = 1024, SEQ = 8192;
constexpr float EPS = 1e-6f;
constexpr float LOG2E = 1.4426950408889634f;

constexpr size_t MB = 1024 * 1024;
constexpr size_t OFF_XB = 0;
constexpr size_t OFF_RS = OFF_XB + 32 * MB;
constexpr size_t OFF_WINT = OFF_RS + 65536;
constexpr size_t OFF_WOUTT = OFF_WINT + 8 * MB;
constexpr size_t OFF_ROPE = OFF_WOUTT + 2 * MB;
constexpr size_t OFF_HQ = OFF_ROPE + 2 * MB;
constexpr size_t OFF_LF = OFF_HQ + 16 * MB;
constexpr size_t OFF_VIT = OFF_LF + 32 * MB;
constexpr size_t OFF_HZ = OFF_VIT + 16 * MB;
constexpr size_t OFF_AQ = OFF_HZ + 16 * MB;
constexpr size_t OFF_AK = OFF_AQ + 16 * MB;
constexpr size_t OFF_AV = OFF_AK + 16 * MB;
constexpr size_t OFF_AZ = OFF_AV + 16 * MB;
constexpr size_t OFF_ST = OFF_AZ + 16 * MB;
constexpr size_t OFF_DEC = OFF_ST + 32 * MB;
constexpr size_t OFF_AO2 = OFF_DEC + 512 * 1024;
constexpr size_t OFF_LSE = OFF_AO2 + 16 * MB;
constexpr size_t OFF_BAR = OFF_LSE + 3 * 16384 * 8 * 4;
constexpr size_t OFF_END = OFF_BAR + 16384;

struct P {
    const float* x; const float* norm_w; const float* w_in; const float* lbl; const float* hgw; const float* w_out; const float* fw;
    float* out;
    u16* xb; float* rs; u16* winT; u16* woutT; float* rope;
    u16* hq; float* lf; u16* viT; u16* hz; u16* aq; u16* ak; u16* av; u16* az;
    u16* ST; float* dec; u16* ao0; u16* ao1; u16* ao2; float* lse; u16* mixhg;
    unsigned* bar;
    int phase_lo, phase_hi;
};

DI unsigned pack2(float a, float b) { f2_t v = {a, b}; return __builtin_bit_cast(unsigned, __builtin_convertvector(v, bf2_t)); }
DI u16 f2bf(float x) { return (u16)(pack2(x, 0.f) & 0xffffu); }
DI float bf2f(u16 v) { return __uint_as_float(((unsigned)v) << 16); }
DI float bflo(unsigned v) { return __uint_as_float(v << 16); }
DI float bfhi(unsigned v) { return __uint_as_float(v & 0xffff0000u); }
DI int crow(int reg, int h) { return (reg & 3) + 8 * (reg >> 2) + 4 * h; }
DI float silu(float v) { return v / (1.f + __expf(-v)); }
DI bf16x8 packB(const f32x16& x, int s) {
    u32x4 pk;
    pk[0] = pack2(x[8 * s + 0], x[8 * s + 1]); pk[1] = pack2(x[8 * s + 2], x[8 * s + 3]);
    pk[2] = pack2(x[8 * s + 4], x[8 * s + 5]); pk[3] = pack2(x[8 * s + 6], x[8 * s + 7]);
    return __builtin_bit_cast(bf16x8, pk);
}
DI float kfromlf(float v) { return (v > -0.02f) ? -v * (1.f + v * (0.5f + v * (1.f / 6.f))) : 1.f - __expf(v); }


#define XB_TMO      128
#define XB_XCNT(j)  (256  + 64 * (j))
#define XB_XSUB(j)  (1280 + 64 * (j))
#define XB_XGEN(j)  (2304 + 64 * (j))
#define XB_TOP      3328
#define XB_TOPGEN   3392
#define XCD_BAR_WORDS 3456
#define XB_SPIN_CAP (1u << 22)
#define LAS __attribute__((address_space(3)))
DI unsigned xb_ld(unsigned* p) { return __hip_atomic_load(p, __ATOMIC_RELAXED, __HIP_MEMORY_SCOPE_AGENT); }
DI unsigned xb_add(unsigned* p, unsigned v) { return __hip_atomic_fetch_add(p, v, __ATOMIC_RELAXED, __HIP_MEMORY_SCOPE_AGENT); }
DI unsigned xb_xcc_id() { return (unsigned)__builtin_amdgcn_s_getreg((3 << 11) | 20) & 0xFu; }
#define XB_SPIN(cond, bar) do { unsigned _sp = 0; while (cond) { __builtin_amdgcn_s_sleep(1); \
    if ((++_sp & 255u) == 0u) { if (xb_ld(&(bar)[XB_TMO])) break; if (_sp > XB_SPIN_CAP) { atomicAdd(&(bar)[XB_TMO], 1u); break; } } } } while (0)
struct XcdBarrier { unsigned* bar; unsigned x; volatile unsigned* st; };
DI XcdBarrier xcd_barrier_post(unsigned* bar, volatile unsigned* st) {
    XcdBarrier b; b.bar = bar; b.x = xb_xcc_id(); b.st = st;
    if (threadIdx.x == 0) (void)xb_add(&bar[XB_XCNT(b.x)], 1u);
    return b;
}
DI void xcd_barrier_complete(unsigned* bar, unsigned x, unsigned& nloc, unsigned& nx) {
    const unsigned G = gridDim.x * gridDim.y * gridDim.z;
    unsigned sum, cnt, mine, sp = 0u;
    for (;;) {
        sum = 0u; cnt = 0u; mine = 0u;
#pragma unroll
        for (unsigned j = 0; j < 16; ++j) { const unsigned c = xb_ld(&bar[XB_XCNT(j)]); sum += c; cnt += (c > 0u) ? 1u : 0u; mine = (j == x) ? c : mine; }
        if (sum == G) break;
        __builtin_amdgcn_s_sleep(1);
        if ((++sp & 255u) == 0u) { if (xb_ld(&bar[XB_TMO])) break; if (sp > XB_SPIN_CAP) { atomicAdd(&bar[XB_TMO], 1u); break; } }
    }
    nloc = mine > 0u ? mine : 1u; nx = cnt > 0u ? cnt : 1u;
}
DI void xcd_barrier(const XcdBarrier& b) {
    asm volatile("s_waitcnt vmcnt(0)" ::: "memory");
    __syncthreads();
    if (threadIdx.x == 0) {
        unsigned* bar = b.bar;
        __builtin_amdgcn_s_waitcnt(0);
        unsigned nloc = b.st[0], nx = b.st[1];
        if (nloc == 0u) { xcd_barrier_complete(bar, b.x, nloc, nx); b.st[0] = nloc; b.st[1] = nx; }
        const unsigned old = xb_add(&bar[XB_XSUB(b.x)], 1u);
        const unsigned gen = old / nloc;
        if (old + 1u == (gen + 1u) * nloc) {
            __builtin_amdgcn_fence(__ATOMIC_RELEASE, "agent");
            asm volatile("s_waitcnt vmcnt(0)" ::: "memory");
            const unsigned og = xb_add(&bar[XB_TOP], 1u);
            const unsigned tg = og / nx;
            if (og + 1u == (tg + 1u) * nx) xb_add(&bar[XB_TOPGEN], 1u);
            else XB_SPIN(xb_ld(&bar[XB_TOPGEN]) == tg, bar);
            __builtin_amdgcn_fence(__ATOMIC_ACQUIRE, "agent");
            xb_add(&bar[XB_XGEN(b.x)], 1u);
            asm volatile("s_waitcnt vmcnt(0)" ::: "memory");
        } else {
            XB_SPIN(xb_ld(&bar[XB_XGEN(b.x)]) == gen, bar);
            __builtin_amdgcn_fence(__ATOMIC_ACQUIRE, "agent");
            asm volatile("s_waitcnt vmcnt(0)" ::: "memory");
        }
    }
    __syncthreads();
}

DI void phase0(const P& p, char* smem) {
    const int tid = threadIdx.x, lane = tid & 63, wid = tid >> 6;
    for (int row = blockIdx.x * 4 + wid; row < NTOK; row += gridDim.x * 4) {
        const float4* xr = (const float4*)(p.x + (size_t)row * DM);
        float4 v[4]; float ss = 0.f;
#pragma unroll
        for (int i = 0; i < 4; ++i) { v[i] = xr[lane + 64 * i]; ss += v[i].x * v[i].x + v[i].y * v[i].y + v[i].z * v[i].z + v[i].w * v[i].w; }
#pragma unroll
        for (int o = 32; o >= 1; o >>= 1) ss += __shfl_xor(ss, o);
        uint2* xo = (uint2*)(p.xb + (size_t)row * DM);
#pragma unroll
        for (int i = 0; i < 4; ++i) xo[lane + 64 * i] = make_uint2(pack2(v[i].x, v[i].y), pack2(v[i].z, v[i].w));
        if (lane == 0) p.rs[row] = rsqrtf(ss * (1.f / 1024.f) + EPS);
    }
    float* tile = (float*)smem;
    for (int t = blockIdx.x; t < 1024 + 256; t += gridDim.x) {
        const float* src; u16* dst; int ncols, td, tc; bool scale;
        if (t < 1024) { src = p.w_in; dst = p.winT; ncols = 4096; td = t >> 6; tc = t & 63; scale = true; }
        else { const int t2 = t - 1024; src = p.w_out; dst = p.woutT; ncols = 1024; td = t2 >> 4; tc = t2 & 15; scale = false; }
#pragma unroll
        for (int i = 0; i < 4; ++i) {
            const int r = (tid >> 4) + 16 * i, c4 = (tid & 15) * 4;
            float4 v = *(const float4*)(src + (size_t)(td * 64 + r) * ncols + tc * 64 + c4);
            const float s = scale ? p.norm_w[td * 64 + r] : 1.f;
            tile[r * 65 + c4 + 0] = v.x * s; tile[r * 65 + c4 + 1] = v.y * s; tile[r * 65 + c4 + 2] = v.z * s; tile[r * 65 + c4 + 3] = v.w * s;
        }
        __syncthreads();
#pragma unroll
        for (int u = 0; u < 2; ++u) {
            const int g = (tid & 3) + 4 * u, c = tid >> 2;
            float e[8];
#pragma unroll
            for (int j = 0; j < 8; ++j) e[j] = tile[(g * 8 + j) * 65 + c];
            u32x4 pk; pk[0] = pack2(e[0], e[1]); pk[1] = pack2(e[2], e[3]); pk[2] = pack2(e[4], e[5]); pk[3] = pack2(e[6], e[7]);
            *(u32x4*)(dst + (size_t)(tc * 64 + c) * 1024 + td * 64 + g * 8) = pk;
        }
        __syncthreads();
    }
    for (int idx = blockIdx.x * 256 + tid; idx < SEQ * 32; idx += gridDim.x * 256) {
        const int pos = idx >> 5, j = idx & 31;
        const float inv = (float)(1.0 / exp2((double)j * (13.287712379549449 / 32.0)));
        const float ang = (float)pos * inv;
        const double rev = (double)ang * 0.15915494309189535;
        const float fr = (float)(rev - floor(rev));
        p.rope[idx] = __builtin_amdgcn_cosf(fr);
        p.rope[SEQ * 32 + idx] = __builtin_amdgcn_sinf(fr);
    }
}

template <int GRP, int G4> DI void epi_unit(const P& p, const f32x16& a0, const f32x16& a1, int cl, int rb0, int l31, float oml0, float oml1) {
    const float4 rsv = *(const float4*)(p.rs + rb0);
    float v0[4], v1[4];
    v0[0] = a0[G4 * 4 + 0] * rsv.x; v0[1] = a0[G4 * 4 + 1] * rsv.y; v0[2] = a0[G4 * 4 + 2] * rsv.z; v0[3] = a0[G4 * 4 + 3] * rsv.w;
    v1[0] = a1[G4 * 4 + 0] * rsv.x; v1[1] = a1[G4 * 4 + 1] * rsv.y; v1[2] = a1[G4 * 4 + 2] * rsv.z; v1[3] = a1[G4 * 4 + 3] * rsv.w;
    const size_t o0 = (size_t)rb0 * 512 + cl + l31;
    if (GRP == 0 || GRP == 3 || GRP == 7) {
        u16* dst = ((GRP == 0) ? p.hq : (GRP == 3 ? p.hz : p.az)) + o0;
#pragma unroll
        for (int j = 0; j < 4; ++j) { dst[j * 512] = f2bf(silu(v0[j])); dst[j * 512 + 32] = f2bf(silu(v1[j])); }
    } else if (GRP == 1) {
        float* dst = p.lf + o0;
#pragma unroll
        for (int j = 0; j < 4; ++j) {
            const float u0 = oml0 / (1.f + __expf(v0[j])), u1 = oml1 / (1.f + __expf(v1[j]));
            dst[j * 512] = log1pf(-u0); dst[j * 512 + 32] = log1pf(-u1);
        }
    } else if (GRP == 2) {
        const int b = rb0 >> 13, t = rb0 & 8191;
        *(uint2*)(p.viT + ((size_t)(b * 512 + cl + l31)) * 8192 + t) = make_uint2(pack2(v0[0], v0[1]), pack2(v0[2], v0[3]));
        *(uint2*)(p.viT + ((size_t)(b * 512 + cl + 32 + l31)) * 8192 + t) = make_uint2(pack2(v1[0], v1[1]), pack2(v1[2], v1[3]));
    } else if (GRP == 6) {
        u16* dst = p.av + o0;
#pragma unroll
        for (int j = 0; j < 4; ++j) { dst[j * 512] = f2bf(v0[j]); dst[j * 512 + 32] = f2bf(v1[j]); }
    } else {
        u16* dst = ((GRP == 4) ? p.aq : p.ak) + o0;
        const float sc = (GRP == 4) ? 0.125f : 1.f;
        const float* rp = p.rope + (rb0 & 8191) * 32 + l31;
#pragma unroll
        for (int j = 0; j < 4; ++j) {
            const float cs = rp[j * 32] * sc, sn = rp[SEQ * 32 + j * 32] * sc;
            dst[j * 512] = f2bf(v0[j] * cs - v1[j] * sn);
            dst[j * 512 + 32] = f2bf(v1[j] * cs + v0[j] * sn);
        }
    }
}
template <int GRP> DI void epi1(const P& p, const f32x16 (&acc)[4][2], int cl, int rowb, int l31, int lh) {
    float oml0 = 0.f, oml1 = 0.f;
    if (GRP == 1) {
        const float a0 = p.lbl[cl + l31], a1 = p.lbl[512 + cl + l31];
        const float b0 = p.lbl[cl + 32 + l31], b1 = p.lbl[512 + cl + 32 + l31];
        float lb0 = 1.f / (1.f + __expf(a1 - a0)), lb1 = 1.f / (1.f + __expf(b1 - b0));
        lb0 = fminf(fmaxf(lb0, 1e-6f), 1.f - 1e-6f); lb1 = fminf(fmaxf(lb1, 1e-6f), 1.f - 1e-6f);
        oml0 = 1.f - lb0; oml1 = 1.f - lb1;
    }
    const int rbl = rowb + lh * 4;
#define EPI_U(MT, G4) epi_unit<GRP, G4>(p, acc[MT][0], acc[MT][1], cl, rbl + MT * 32 + G4 * 8, l31, oml0, oml1);
#define EPI_M(MT) EPI_U(MT, 0) EPI_U(MT, 1) EPI_U(MT, 2) EPI_U(MT, 3)
    EPI_M(0) EPI_M(1) EPI_M(2) EPI_M(3)
#undef EPI_M
#undef EPI_U
}

DI void phase1(const P& p, char* smem) {
    const int tid = threadIdx.x, lane = tid & 63, wid = tid >> 6, wr = wid >> 1, wc = wid & 1;
    const int l31 = lane & 31, lh = lane >> 5;
    char* As = smem;
    char* Bs = smem + 256 * 144;
    const int c8 = tid & 7, r0 = tid >> 3;
    for (int tile = blockIdx.x; tile < 2048; tile += gridDim.x) {
        const int xcd = tile & 7, idx = (tile >> 3) & 63, rnd = tile >> 9;
        const int sid = rnd * 8 + xcd;
        const int pm = (sid & 7) * 8 + (idx & 7), pn = (sid >> 3) * 8 + (idx >> 3);
        const u16* Ag = p.xb + (size_t)pm * 256 * 1024 + (size_t)r0 * 1024 + c8 * 8;
        const u16* Bg = p.winT + (size_t)pn * 128 * 1024 + (size_t)r0 * 1024 + c8 * 8;
        f32x16 acc[4][2];
#pragma unroll
        for (int m = 0; m < 4; ++m)
#pragma unroll
            for (int n = 0; n < 2; ++n)
#pragma unroll
                for (int r = 0; r < 16; ++r) acc[m][n][r] = 0.f;
        u32x4 ra[8], rb[4];
#pragma unroll
        for (int i = 0; i < 8; ++i) ra[i] = *(const u32x4*)(Ag + (size_t)(32 * i) * 1024);
#pragma unroll
        for (int i = 0; i < 4; ++i) rb[i] = *(const u32x4*)(Bg + (size_t)(32 * i) * 1024);
        __syncthreads();
#pragma unroll
        for (int i = 0; i < 8; ++i) *(u32x4*)(As + (r0 + 32 * i) * 144 + c8 * 16) = ra[i];
#pragma unroll
        for (int i = 0; i < 4; ++i) *(u32x4*)(Bs + (r0 + 32 * i) * 144 + c8 * 16) = rb[i];
        __syncthreads();
        for (int kt = 0; kt < 16; ++kt) {
            if (kt < 15) {
#pragma unroll
                for (int i = 0; i < 8; ++i) ra[i] = *(const u32x4*)(Ag + (size_t)(32 * i) * 1024 + (kt + 1) * 64);
#pragma unroll
                for (int i = 0; i < 4; ++i) rb[i] = *(const u32x4*)(Bg + (size_t)(32 * i) * 1024 + (kt + 1) * 64);
            }
#pragma unroll
            for (int ks = 0; ks < 4; ++ks) {
                bf16x8 af[4], bfr[2];
#pragma unroll
                for (int m = 0; m < 4; ++m) af[m] = *(const bf16x8*)(As + (wr * 128 + m * 32 + l31) * 144 + (ks * 16 + lh * 8) * 2);
#pragma unroll
                for (int n = 0; n < 2; ++n) bfr[n] = *(const bf16x8*)(Bs + (wc * 64 + n * 32 + l31) * 144 + (ks * 16 + lh * 8) * 2);
#pragma unroll
                for (int m = 0; m < 4; ++m)
#pragma unroll
                    for (int n = 0; n < 2; ++n) acc[m][n] = MFMA32(af[m], bfr[n], acc[m][n]);
            }
            __syncthreads();
            if (kt < 15) {
#pragma unroll
                for (int i = 0; i < 8; ++i) *(u32x4*)(As + (r0 + 32 * i) * 144 + c8 * 16) = ra[i];
#pragma unroll
                for (int i = 0; i < 4; ++i) *(u32x4*)(Bs + (r0 + 32 * i) * 144 + c8 * 16) = rb[i];
                __syncthreads();
            }
        }
        const int grp = pn >> 2;
        const int cl = ((pn & 3) * 128) + wc * 64;
        const int rowb = pm * 256 + wr * 128;
        switch (grp) {
            case 0: epi1<0>(p, acc, cl, rowb, l31, lh); break;
            case 1: epi1<1>(p, acc, cl, rowb, l31, lh); break;
            case 2: epi1<2>(p, acc, cl, rowb, l31, lh); break;
            case 3: epi1<3>(p, acc, cl, rowb, l31, lh); break;
            case 4: epi1<4>(p, acc, cl, rowb, l31, lh); break;
            case 5: epi1<5>(p, acc, cl, rowb, l31, lh); break;
            case 6: epi1<6>(p, acc, cl, rowb, l31, lh); break;
            default: epi1<7>(p, acc, cl, rowb, l31, lh); break;
        }
    }
}

DI void pass1(const P& p, char* smem, int item) {
    const int tid = threadIdx.x, lane = tid & 63, wid = tid >> 6, l31 = lane & 31, lh = lane >> 5;
    const int bh = item >> 7, c = item & 127, b = bh >> 2, h = bh & 3;
    const size_t m0 = (size_t)b * 8192 + c * 64;
    float* tot = (float*)smem;
    char* kdT = smem + 1024;
    const int k = tid & 127, half = tid >> 7;
    const float* lfp = p.lf + (m0 + half * 32) * 512 + h * 128 + k;
    float v[32]; float T = 0.f;
#pragma unroll
    for (int i = 0; i < 32; ++i) { v[i] = lfp[(size_t)i * 512]; T += v[i]; }
    tot[half * 128 + k] = T;
    __syncthreads();
    const float other = tot[(half ^ 1) * 128 + k];
    float suf = (half == 0) ? other : 0.f;
    float kd[32];
#pragma unroll
    for (int i = 31; i >= 0; --i) { kd[i] = kfromlf(v[i]) * __expf(suf); suf += v[i]; }
#pragma unroll
    for (int q = 0; q < 4; ++q) {
        u32x4 pk;
        pk[0] = pack2(kd[8 * q + 0], kd[8 * q + 1]); pk[1] = pack2(kd[8 * q + 2], kd[8 * q + 3]);
        pk[2] = pack2(kd[8 * q + 4], kd[8 * q + 5]); pk[3] = pack2(kd[8 * q + 6], kd[8 * q + 7]);
        *(u32x4*)(kdT + k * 144 + half * 64 + q * 16) = pk;
    }
    if (half == 0) p.dec[(size_t)item * 128 + k] = __expf(T + other);
    __syncthreads();
    const u16* vrow = p.viT + ((size_t)(b * 512 + h * 128 + wid * 32 + l31)) * 8192 + c * 64;
    f32x16 acc[4];
#pragma unroll
    for (int n = 0; n < 4; ++n)
#pragma unroll
        for (int r = 0; r < 16; ++r) acc[n][r] = 0.f;
#pragma unroll
    for (int ks = 0; ks < 4; ++ks) {
        const bf16x8 a = *(const bf16x8*)(vrow + ks * 16 + lh * 8);
#pragma unroll
        for (int nt = 0; nt < 4; ++nt) {
            const bf16x8 bb = *(const bf16x8*)(kdT + (nt * 32 + l31) * 144 + (ks * 16 + lh * 8) * 2);
            acc[nt] = MFMA32(a, bb, acc[nt]);
        }
    }
    u16* so = p.ST + (size_t)item * 16384;
#pragma unroll
    for (int nt = 0; nt < 4; ++nt)
#pragma unroll
        for (int r = 0; r < 16; ++r) so[(wid * 32 + crow(r, lh)) * 128 + nt * 32 + l31] = f2bf(acc[nt][r]);
    __syncthreads();
}

DI void pass2(const P& p) {
    for (int e = blockIdx.x * 256 + threadIdx.x; e < 65536; e += gridDim.x * 256) {
        const int bh = e >> 13, rem = e & 8191, k2 = (rem & 63) * 2;
        unsigned* st = (unsigned*)p.ST + (size_t)bh * 128 * 8192 + rem;
        const float2* dc = (const float2*)(p.dec + (size_t)bh * 128 * 128 + k2);
        float r0 = 0.f, r1 = 0.f;
        for (int c0 = 0; c0 < 128; c0 += 8) {
            unsigned s[8]; float2 d[8];
#pragma unroll
            for (int j = 0; j < 8; ++j) { s[j] = st[(size_t)(c0 + j) * 8192]; d[j] = dc[(c0 + j) * 64]; }
#pragma unroll
            for (int j = 0; j < 8; ++j) {
                st[(size_t)(c0 + j) * 8192] = pack2(r0, r1);
                r0 = d[j].x * r0 + bflo(s[j]); r1 = d[j].y * r1 + bfhi(s[j]);
            }
        }
    }
}

DI void attn_item(const P& p, char* smem, int item) {
    const int tid = threadIdx.x, lane = tid & 63, wid = tid >> 6, l31 = lane & 31, lh = lane >> 5;
    const int pat = item >> 10, idx = item & 1023;
    const int dl = pat * 2, d = 1 << dl, nblk = 64 >> dl;
    const int nb = idx & (nblk - 1);
    int rest = idx >> (6 - dl);
    const int r = rest & (d - 1); rest >>= dl;
    const int hh = rest & 7, b = rest >> 3;
    char* Ks = smem;
    char* VT = smem + 256 * 144;
    const size_t tokbase = (size_t)b * 8192;
    {
        const int c8 = tid & 7, kr = tid >> 3;
#pragma unroll
        for (int i = 0; i < 8; ++i) {
            const int key = kr + 32 * i;
            const int j = nb * 128 - 128 + key;
            if (j >= 0) {
                const size_t off = (tokbase + (size_t)j * d + r) * 512 + hh * 64 + c8 * 8;
                const u32x4 kv = *(const u32x4*)(p.ak + off);
                const u32x4 vv = *(const u32x4*)(p.av + off);
                *(u32x4*)(Ks + key * 144 + c8 * 16) = kv;
#pragma unroll
                for (int e = 0; e < 4; ++e) {
                    *(u16*)(VT + (c8 * 8 + 2 * e) * 520 + key * 2) = (u16)(vv[e] & 0xffffu);
                    *(u16*)(VT + (c8 * 8 + 2 * e + 1) * 520 + key * 2) = (u16)(vv[e] >> 16);
                }
            }
        }
    }
    const int jq = nb * 128 + wid * 32 + l31;
    const size_t mq = tokbase + (size_t)jq * d + r;
    bf16x8 qf[4];
#pragma unroll
    for (int ks = 0; ks < 4; ++ks) qf[ks] = *(const bf16x8*)(p.aq + mq * 512 + hh * 64 + ks * 16 + lh * 8);
    __syncthreads();
    const int kt_lo = (nb == 0) ? 4 : 0;
    f32x16 st[5];
    float mx = -INFINITY;
#pragma unroll
    for (int i = 0; i < 5; ++i) {
        const int kt = wid + i;
        if (kt >= kt_lo) {
#pragma unroll
            for (int rr = 0; rr < 16; ++rr) st[i][rr] = 0.f;
#pragma unroll
            for (int ks = 0; ks < 4; ++ks) {
                const bf16x8 a = *(const bf16x8*)(Ks + (kt * 32 + l31) * 144 + (ks * 16 + lh * 8) * 2);
                st[i] = MFMA32(a, qf[ks], st[i]);
            }
#pragma unroll
            for (int rr = 0; rr < 16; ++rr) {
                const int dist = wid * 32 + l31 + 128 - (kt * 32 + crow(rr, lh));
                if (dist < 0 || dist > 128) st[i][rr] = -INFINITY;
                mx = fmaxf(mx, st[i][rr]);
            }
        } else {
#pragma unroll
            for (int rr = 0; rr < 16; ++rr) st[i][rr] = -INFINITY;
        }
    }
    mx = fmaxf(mx, __shfl_xor(mx, 32));
    float l = 0.f;
    const float mxs = mx * LOG2E;
#pragma unroll
    for (int i = 0; i < 5; ++i)
#pragma unroll
        for (int rr = 0; rr < 16; ++rr) { const float e = exp2f(st[i][rr] * LOG2E - mxs); st[i][rr] = e; l += e; }
    l += __shfl_xor(l, 32);
    f32x16 o[2];
#pragma unroll
    for (int dt = 0; dt < 2; ++dt)
#pragma unroll
        for (int rr = 0; rr < 16; ++rr) o[dt][rr] = 0.f;
#pragma unroll
    for (int i = 0; i < 5; ++i) {
        const int kt = wid + i;
        if (kt >= kt_lo) {
#pragma unroll
            for (int ks2 = 0; ks2 < 2; ++ks2) {
                const bf16x8 bq = packB(st[i], ks2);
#pragma unroll
                for (int dt = 0; dt < 2; ++dt) {
                    const char* ad = VT + (dt * 32 + l31) * 520 + (kt * 32 + ks2 * 16 + lh * 4) * 2;
                    const uint2 lo = *(const uint2*)ad, hi = *(const uint2*)(ad + 16);
                    u32x4 av4; av4[0] = lo.x; av4[1] = lo.y; av4[2] = hi.x; av4[3] = hi.y;
                    o[dt] = MFMA32(__builtin_bit_cast(bf16x8, av4), bq, o[dt]);
                }
            }
        }
    }
    const float inv = 1.f / l;
    u16* op = (pat == 0 ? p.ao0 : (pat == 1 ? p.ao1 : p.ao2)) + mq * 512 + hh * 64;
#pragma unroll
    for (int dt = 0; dt < 2; ++dt)
#pragma unroll
        for (int g4 = 0; g4 < 4; ++g4)
            *(uint2*)(op + dt * 32 + g4 * 8 + lh * 4) = make_uint2(pack2(o[dt][g4 * 4] * inv, o[dt][g4 * 4 + 1] * inv), pack2(o[dt][g4 * 4 + 2] * inv, o[dt][g4 * 4 + 3] * inv));
    if (lh == 0) p.lse[((size_t)pat * NTOK + mq) * 8 + hh] = mx + __logf(l);
    __syncthreads();
}

DI void pass3(const P& p, char* smem, int item) {
    const int tid = threadIdx.x, lane = tid & 63, wid = tid >> 6, l31 = lane & 31, lh = lane >> 5;
    const int bh = item >> 7, c = item & 127, b = bh >> 2, h = bh & 3;
    const size_t m0 = (size_t)b * 8192 + c * 64;
    float* tot = (float*)smem;
    float* red = (float*)(smem + 1024);
    char* Qp = smem + 2048;
    char* Qpp = Qp + 64 * 272;
    char* Kp = Qpp + 64 * 272;
    {
        const int k = tid & 127, half = tid >> 7;
        const float* lfp = p.lf + (m0 + half * 32) * 512 + h * 128 + k;
        const u16* qp = p.hq + (m0 + half * 32) * 512 + h * 128 + k;
        float v[32]; float T = 0.f;
#pragma unroll
        for (int i = 0; i < 32; ++i) { v[i] = lfp[(size_t)i * 512]; T += v[i]; }
        tot[half * 128 + k] = T;
        __syncthreads();
        const float other = tot[(half ^ 1) * 128 + k];
        const float bref = (half == 0) ? T : other;
        const float ebref = __expf(bref);
        const float sub = (half == 0) ? T : 0.f;
        float pre = 0.f;
#pragma unroll
        for (int i = 0; i < 32; ++i) {
            pre += v[i];
            const float xx = pre - sub;
            const float E1 = __expf(xx), Ei = __expf(-xx);
            const float q = bf2f(qp[(size_t)i * 512]);
            const float kk = kfromlf(v[i]);
            const int row = half * 32 + i;
            *(u16*)(Qp + row * 272 + k * 2) = f2bf(q * E1);
            *(u16*)(Qpp + row * 272 + k * 2) = f2bf(q * E1 * ebref);
            *(u16*)(Kp + row * 272 + k * 2) = f2bf(kk * Ei);
        }
    }
    __syncthreads();
    const int tt = wid & 1, vh = wid >> 1;
    f32x16 at[2];
#pragma unroll
    for (int st = 0; st < 2; ++st) {
#pragma unroll
        for (int rr = 0; rr < 16; ++rr) at[st][rr] = 0.f;
        if (st <= tt) {
#pragma unroll
            for (int ks = 0; ks < 8; ++ks) {
                const bf16x8 a = *(const bf16x8*)(Kp + (st * 32 + l31) * 272 + (ks * 16 + lh * 8) * 2);
                const bf16x8 bq = *(const bf16x8*)(Qp + (tt * 32 + l31) * 272 + (ks * 16 + lh * 8) * 2);
                at[st] = MFMA32(a, bq, at[st]);
            }
            if (st == tt) {
#pragma unroll
                for (int rr = 0; rr < 16; ++rr) if (crow(rr, lh) > l31) at[st][rr] = 0.f;
            }
        }
    }
    f32x16 o[2];
#pragma unroll
    for (int vt = 0; vt < 2; ++vt) {
#pragma unroll
        for (int rr = 0; rr < 16; ++rr) o[vt][rr] = 0.f;
        const int vrow = 64 * vh + 32 * vt + l31;
        const u16* srow = p.ST + (size_t)item * 16384 + vrow * 128;
#pragma unroll
        for (int ks = 0; ks < 8; ++ks) {
            const bf16x8 a = *(const bf16x8*)(srow + ks * 16 + lh * 8);
            const bf16x8 bq = *(const bf16x8*)(Qpp + (tt * 32 + l31) * 272 + (ks * 16 + lh * 8) * 2);
            o[vt] = MFMA32(a, bq, o[vt]);
        }
        const u16* vr = p.viT + ((size_t)(b * 512 + h * 128 + vrow)) * 8192 + c * 64;
#pragma unroll
        for (int st = 0; st < 2; ++st) {
            if (st <= tt) {
#pragma unroll
                for (int ks2 = 0; ks2 < 2; ++ks2) {
                    const uint2 lo = *(const uint2*)(vr + st * 32 + ks2 * 16 + lh * 4);
                    const uint2 hi = *(const uint2*)(vr + st * 32 + ks2 * 16 + 8 + lh * 4);
                    u32x4 av4; av4[0] = lo.x; av4[1] = lo.y; av4[2] = hi.x; av4[3] = hi.y;
                    o[vt] = MFMA32(__builtin_bit_cast(bf16x8, av4), packB(at[st], ks2), o[vt]);
                }
            }
        }
    }
    float ss = 0.f;
#pragma unroll
    for (int vt = 0; vt < 2; ++vt)
#pragma unroll
        for (int rr = 0; rr < 16; ++rr) ss += o[vt][rr] * o[vt][rr];
    ss += __shfl_xor(ss, 32);
    if (lh == 0) red[vh * 64 + tt * 32 + l31] = ss;
    __syncthreads();
    const float tot2 = red[tt * 32 + l31] + red[64 + tt * 32 + l31];
    const float rinv = rsqrtf(tot2 * (1.f / 128.f) + EPS);
    const size_t m = m0 + tt * 32 + l31;
#pragma unroll
    for (int vt = 0; vt < 2; ++vt)
#pragma unroll
        for (int g4 = 0; g4 < 4; ++g4) {
            const int vb = 64 * vh + 32 * vt + 8 * g4 + 4 * lh;
            const float4 gw = *(const float4*)(p.hgw + h * 128 + vb);
            const uint2 zz = *(const uint2*)(p.hz + m * 512 + h * 128 + vb);
            const float y0 = o[vt][g4 * 4 + 0] * rinv * gw.x * bflo(zz.x);
            const float y1 = o[vt][g4 * 4 + 1] * rinv * gw.y * bfhi(zz.x);
            const float y2 = o[vt][g4 * 4 + 2] * rinv * gw.z * bflo(zz.y);
            const float y3 = o[vt][g4 * 4 + 3] * rinv * gw.w * bfhi(zz.y);
            *(uint2*)(p.mixhg + m * 512 + h * 128 + vb) = make_uint2(pack2(y0, y1), pack2(y2, y3));
        }
    __syncthreads();
}

DI void phase5(const P& p, char* smem, int tile) {
    int tid = threadIdx.x;
    asm volatile("" : "+v"(tid));
    const int lane = tid & 63, wid = tid >> 6, l31 = lane & 31, lh = lane >> 5;
    const size_t m0 = (size_t)tile * 32;
    char* Am = smem;
    float* red = (float*)(smem + 32 * 2064);
#pragma unroll 1
    for (int i = 0; i < 8; ++i) {
        const int idx = tid + 256 * i, r = idx >> 6, ch = idx & 63;
        const size_t m = m0 + r;
        *(u32x4*)(Am + r * 2064 + ch * 16) = *(const u32x4*)(p.mixhg + m * 512 + ch * 8);
        const int hh = ch >> 3;
        const float l0 = p.lse[(size_t)m * 8 + hh], l1 = p.lse[((size_t)NTOK + m) * 8 + hh], l2 = p.lse[((size_t)2 * NTOK + m) * 8 + hh];
        const float mx = fmaxf(l0, fmaxf(l1, l2));
        float w0 = __expf(l0 - mx), w1 = __expf(l1 - mx), w2 = __expf(l2 - mx);
        const float inv = 1.f / (w0 + w1 + w2);
        w0 *= inv; w1 *= inv; w2 *= inv;
        const u32x4 a0 = *(const u32x4*)(p.ao0 + m * 512 + ch * 8), a1 = *(const u32x4*)(p.ao1 + m * 512 + ch * 8), a2 = *(const u32x4*)(p.ao2 + m * 512 + ch * 8);
        const u32x4 zz = *(const u32x4*)(p.az + m * 512 + ch * 8);
        u32x4 pk;
#pragma unroll
        for (int e = 0; e < 4; ++e) {
            const float y0 = (w0 * bflo(a0[e]) + w1 * bflo(a1[e]) + w2 * bflo(a2[e])) * bflo(zz[e]);
            const float y1 = (w0 * bfhi(a0[e]) + w1 * bfhi(a1[e]) + w2 * bfhi(a2[e])) * bfhi(zz[e]);
            pk[e] = pack2(y0, y1);
        }
        *(u32x4*)(Am + r * 2064 + 1024 + ch * 16) = pk;
    }
    __syncthreads();
    f32x16 acc[8];
#pragma unroll
    for (int mt = 0; mt < 8; ++mt)
#pragma unroll
        for (int rr = 0; rr < 16; ++rr) acc[mt][rr] = 0.f;
    const int widu = __builtin_amdgcn_readfirstlane(wid);
    const u16* wbu = p.woutT + (size_t)widu * 256 * 1024;
    const int loff = l31 * 1024 + lh * 8;
#pragma unroll
    for (int hf = 0; hf < 2; ++hf) {
        const u16* wh = wbu + hf * 4 * 32 * 1024;
        bf16x8 wa[4];
#pragma unroll
        for (int j = 0; j < 4; ++j) wa[j] = *(const bf16x8*)(wh + j * 32 * 1024 + loff);
#pragma unroll 2
        for (int ks = 0; ks < 64; ++ks) {
            bf16x8 wn[4];
            const int kn = (ks + 1 < 64) ? ks + 1 : ks;
            const u16* wk = wh + kn * 16;
#pragma unroll
            for (int j = 0; j < 4; ++j) wn[j] = *(const bf16x8*)(wk + j * 32 * 1024 + loff);
            const bf16x8 bq = *(const bf16x8*)(Am + l31 * 2064 + (ks * 16 + lh * 8) * 2);
#pragma unroll
            for (int j = 0; j < 4; ++j) acc[hf * 4 + j] = MFMA32(wa[j], bq, acc[hf * 4 + j]);
#pragma unroll
            for (int j = 0; j < 4; ++j) wa[j] = wn[j];
        }
    }
    const size_t m = m0 + l31;
    float ss = 0.f;
#pragma unroll
    for (int mt = 0; mt < 8; ++mt) {
        __builtin_amdgcn_sched_barrier(0);
#pragma unroll
        for (int g4 = 0; g4 < 4; ++g4) {
            const int n = 256 * wid + 32 * mt + 8 * g4 + 4 * lh;
            const float4 xv = *(const float4*)(p.x + m * 1024 + n);
            acc[mt][g4 * 4 + 0] += xv.x; acc[mt][g4 * 4 + 1] += xv.y; acc[mt][g4 * 4 + 2] += xv.z; acc[mt][g4 * 4 + 3] += xv.w;
#pragma unroll
            for (int j = 0; j < 4; ++j) ss = fmaf(acc[mt][g4 * 4 + j], acc[mt][g4 * 4 + j], ss);
        }
    }
    ss += __shfl_xor(ss, 32);
    if (lh == 0) red[wid * 32 + l31] = ss;
    __syncthreads();
    const float tot = red[l31] + red[32 + l31] + red[64 + l31] + red[96 + l31];
    const float rinv = rsqrtf(tot * (1.f / 1024.f) + EPS);
#pragma unroll
    for (int mt = 0; mt < 8; ++mt) {
        __builtin_amdgcn_sched_barrier(0);
#pragma unroll
        for (int g4 = 0; g4 < 4; ++g4) {
            const int n = 256 * wid + 32 * mt + 8 * g4 + 4 * lh;
            const float4 fwv = *(const float4*)(p.fw + n);
            float4 ov;
            ov.x = acc[mt][g4 * 4 + 0] * rinv * fwv.x; ov.y = acc[mt][g4 * 4 + 1] * rinv * fwv.y;
            ov.z = acc[mt][g4 * 4 + 2] * rinv * fwv.z; ov.w = acc[mt][g4 * 4 + 3] * rinv * fwv.w;
            *(float4*)(p.out + m * 1024 + n) = ov;
        }
    }
    __syncthreads();
}

constexpr int SMEM_BYTES = 256 * 144 + 64 * 520;

__global__ void __launch_bounds__(256, 2) fwd_kernel(P p) {
    __shared__ __attribute__((aligned(16))) char smem[SMEM_BYTES];
    __shared__ uint4 xb_words;
    if (threadIdx.x == 0) xb_words = make_uint4(0u, 0u, 0u, 0u);
    __syncthreads();
    const XcdBarrier gb = xcd_barrier_post(p.bar, (volatile unsigned*)&xb_words);
    phase0(p, smem);
    xcd_barrier(gb);
    phase1(p, smem);
    xcd_barrier(gb);
    for (int it = blockIdx.x; it < 1024; it += gridDim.x) pass1(p, smem, it);
    xcd_barrier(gb);
    pass2(p);
    if (gridDim.x == 512) {
        const int bi = blockIdx.x;
        const int first = (bi < 256) ? bi * 5 : 1280 + (bi - 256) * 7, cnt = (bi < 256) ? 5 : 7;
        for (int i = 0; i < cnt; ++i) attn_item(p, smem, first + i);
    } else {
        for (int it = blockIdx.x; it < 3072; it += gridDim.x) attn_item(p, smem, it);
    }
    xcd_barrier(gb);
    for (int it = blockIdx.x; it < 1024; it += gridDim.x) pass3(p, smem, it);
    xcd_barrier(gb);
    for (int it = blockIdx.x; it < 512; it += gridDim.x) phase5(p, smem, it);
}

extern "C" void kernel_launch(void* const* d_in, const int* in_sizes, int n_in, void* d_out, int out_size, void* d_ws, size_t ws_size, hipStream_t stream) {
    static int grid_blocks = 0;
    if (!grid_blocks) {
        int dev = 0, cus = 0, per_cu = 0;
        (void)hipGetDevice(&dev);
        (void)hipDeviceGetAttribute(&cus, hipDeviceAttributeMultiprocessorCount, dev);
        (void)hipOccupancyMaxActiveBlocksPerMultiprocessor(&per_cu, fwd_kernel, 256, 0);
        if (per_cu > 2) per_cu = 2;
        if (per_cu < 1) per_cu = 1;
        grid_blocks = cus * per_cu;
    }
    char* ws = (char*)d_ws;
    P p{};
    p.x = (const float*)d_in[0]; p.norm_w = (const float*)d_in[1]; p.w_in = (const float*)d_in[2]; p.lbl = (const float*)d_in[3];
    p.hgw = (const float*)d_in[4]; p.w_out = (const float*)d_in[5]; p.fw = (const float*)d_in[6];
    p.out = (float*)d_out;
    p.xb = (u16*)(ws + OFF_XB); p.rs = (float*)(ws + OFF_RS); p.winT = (u16*)(ws + OFF_WINT); p.woutT = (u16*)(ws + OFF_WOUTT); p.rope = (float*)(ws + OFF_ROPE);
    p.hq = (u16*)(ws + OFF_HQ); p.lf = (float*)(ws + OFF_LF); p.viT = (u16*)(ws + OFF_VIT); p.hz = (u16*)(ws + OFF_HZ);
    p.aq = (u16*)(ws + OFF_AQ); p.ak = (u16*)(ws + OFF_AK); p.av = (u16*)(ws + OFF_AV); p.az = (u16*)(ws + OFF_AZ);
    p.ST = (u16*)(ws + OFF_ST); p.dec = (float*)(ws + OFF_DEC);
    p.ao0 = (u16*)(ws + OFF_XB); p.ao1 = (u16*)(ws + OFF_XB + 16 * MB); p.ao2 = (u16*)(ws + OFF_AO2);
    p.lse = (float*)(ws + OFF_LSE); p.mixhg = (u16*)(ws + OFF_AQ);
    p.bar = (unsigned*)(ws + OFF_BAR);
    p.phase_lo = 0; p.phase_hi = 5;
    (void)hipMemsetAsync(ws + OFF_BAR, 0, 16384, stream);
    void* args[] = {&p};
    hipError_t e = hipLaunchCooperativeKernel((void*)fwd_kernel, dim3(grid_blocks), dim3(256), args, 0, stream);
    if (e != hipSuccess) fprintf(stderr, "cooperative launch failed: %s (grid %d)\n", hipGetErrorString(e), grid_blocks);
}
```

```cpp
#include <hip/hip_runtime.h>
#include <cstdio>

typedef short bf16x8 __attribute__((ext_vector_type(8)));
typedef float f32x16 __attribute__((ext_vector_type(16)));
typedef __bf16 bf2_t __attribute__((ext_vector_type(2)));
typedef float f2_t __attribute__((ext_vector_type(2)));
typedef unsigned u32x4 __attribute__((ext_vector_type(4)));
typedef unsigned short u16;

#define DI __device__ __forceinline__
#define MFMA32(a, b, c) __builtin_amdgcn_mfma_f32_32x32x16_bf16((a), (b), (c), 0, 0, 0)

constexpr int NTOK = 16384, DM = 1024, SEQ = 8192;
constexpr float EPS = 1e-6f;
constexpr float LOG2E = 1.4426950408889634f;

constexpr size_t MB = 1024 * 1024;
constexpr size_t OFF_XB = 0;
constexpr size_t OFF_RS = OFF_XB + 32 * MB;
constexpr size_t OFF_WINT = OFF_RS + 65536;
constexpr size_t OFF_WOUTT = OFF_WINT + 8 * MB;
constexpr size_t OFF_ROPE = OFF_WOUTT + 2 * MB;
constexpr size_t OFF_HQ = OFF_ROPE + 2 * MB;
constexpr size_t OFF_LF = OFF_HQ + 16 * MB;
constexpr size_t OFF_VIT = OFF_LF + 32 * MB;
constexpr size_t OFF_HZ = OFF_VIT + 16 * MB;
constexpr size_t OFF_AQ = OFF_HZ + 16 * MB;
constexpr size_t OFF_AK = OFF_AQ + 16 * MB;
constexpr size_t OFF_AV = OFF_AK + 16 * MB;
constexpr size_t OFF_AZ = OFF_AV + 16 * MB;
constexpr size_t OFF_ST = OFF_AZ + 16 * MB;
constexpr size_t OFF_DEC = OFF_ST + 32 * MB;
constexpr size_t OFF_AO2 = OFF_DEC + 512 * 1024;
constexpr size_t OFF_LSE = OFF_AO2 + 16 * MB;
constexpr size_t OFF_BAR = OFF_LSE + 3 * 16384 * 8 * 4;
constexpr size_t OFF_ROWSS = OFF_BAR + 16384;
constexpr size_t OFF_PCNT = OFF_ROWSS + 65536;
constexpr size_t OFF_END = OFF_PCNT + 1024;

struct P {
    const float* x; const float* norm_w; const float* w_in; const float* lbl; const float* hgw; const float* w_out; const float* fw;
    float* out; char* ws;
    DI u16* xb() const { return (u16*)(ws + OFF_XB); }
    DI float* rs() const { return (float*)(ws + OFF_RS); }
    DI u16* winT() const { return (u16*)(ws + OFF_WINT); }
    DI u16* woutT() const { return (u16*)(ws + OFF_WOUTT); }
    DI float* rope() const { return (float*)(ws + OFF_ROPE); }
    DI u16* hq() const { return (u16*)(ws + OFF_HQ); }
    DI float* lf() const { return (float*)(ws + OFF_LF); }
    DI u16* viT() const { return (u16*)(ws + OFF_VIT); }
    DI u16* hz() const { return (u16*)(ws + OFF_HZ); }
    DI u16* aq() const { return (u16*)(ws + OFF_AQ); }
    DI u16* ak() const { return (u16*)(ws + OFF_AK); }
    DI u16* av() const { return (u16*)(ws + OFF_AV); }
    DI u16* az() const { return (u16*)(ws + OFF_AZ); }
    DI u16* ST() const { return (u16*)(ws + OFF_ST); }
    DI float* dec() const { return (float*)(ws + OFF_DEC); }
    DI u16* ao0() const { return (u16*)(ws + OFF_XB); }
    DI u16* ao1() const { return (u16*)(ws + OFF_XB + 16 * MB); }
    DI u16* ao2() const { return (u16*)(ws + OFF_AO2); }
    DI float* lse() const { return (float*)(ws + OFF_LSE); }
    DI u16* mixed() const { return (u16*)(ws + OFF_AQ); }
    DI float* rowss() const { return (float*)(ws + OFF_ROWSS); }
    DI unsigned* pcnt() const { return (unsigned*)(ws + OFF_PCNT); }
    DI unsigned* bar() const { return (unsigned*)(ws + OFF_BAR); }
};

DI unsigned pack2(float a, float b) { f2_t v = {a, b}; return __builtin_bit_cast(unsigned, __builtin_convertvector(v, bf2_t)); }
DI u16 f2bf(float x) { return (u16)(pack2(x, 0.f) & 0xffffu); }
DI float bf2f(u16 v) { return __uint_as_float(((unsigned)v) << 16); }
DI float bflo(unsigned v) { return __uint_as_float(v << 16); }
DI float bfhi(unsigned v) { return __uint_as_float(v & 0xffff0000u); }
DI int crow(int reg, int h) { return (reg & 3) + 8 * (reg >> 2) + 4 * h; }
DI float silu(float v) { return v / (1.f + __expf(-v)); }
DI bf16x8 packB(const f32x16& x, int s) {
    u32x4 pk;
    pk[0] = pack2(x[8 * s + 0], x[8 * s + 1]); pk[1] = pack2(x[8 * s + 2], x[8 * s + 3]);
    pk[2] = pack2(x[8 * s + 4], x[8 * s + 5]); pk[3] = pack2(x[8 * s + 6], x[8 * s + 7]);
    return __builtin_bit_cast(bf16x8, pk);
}
DI float kfromlf(float v) { return (v > -0.02f) ? -v * (1.f + v * (0.5f + v * (1.f / 6.f))) : 1.f - __expf(v); }


#define XB_TMO      128
#define XB_XCNT(j)  (256  + 64 * (j))
#define XB_XSUB(j)  (1280 + 64 * (j))
#define XB_XGEN(j)  (2304 + 64 * (j))
#define XB_TOP      3328
#define XB_TOPGEN   3392
#define XCD_BAR_WORDS 3456
#define XB_SPIN_CAP (1u << 22)
#define LAS __attribute__((address_space(3)))
DI unsigned xb_ld(unsigned* p) { return __hip_atomic_load(p, __ATOMIC_RELAXED, __HIP_MEMORY_SCOPE_AGENT); }
DI unsigned xb_add(unsigned* p, unsigned v) { return __hip_atomic_fetch_add(p, v, __ATOMIC_RELAXED, __HIP_MEMORY_SCOPE_AGENT); }
DI unsigned xb_xcc_id() { return (unsigned)__builtin_amdgcn_s_getreg((3 << 11) | 20) & 0xFu; }
#define XB_SPIN(cond, bar) do { unsigned _sp = 0; while (cond) { __builtin_amdgcn_s_sleep(1); \
    if ((++_sp & 255u) == 0u) { if (xb_ld(&(bar)[XB_TMO])) break; if (_sp > XB_SPIN_CAP) { atomicAdd(&(bar)[XB_TMO], 1u); break; } } } } while (0)
struct XcdBarrier { unsigned* bar; unsigned x; volatile unsigned* st; };
DI XcdBarrier xcd_barrier_post(unsigned* bar, volatile unsigned* st) {
    XcdBarrier b; b.bar = bar; b.x = xb_xcc_id(); b.st = st;
    if (threadIdx.x == 0) (void)xb_add(&bar[XB_XCNT(b.x)], 1u);
    return b;
}
DI void xcd_barrier_complete(unsigned* bar, unsigned x, unsigned& nloc, unsigned& nx) {
    const unsigned G = gridDim.x * gridDim.y * gridDim.z;
    unsigned sum, cnt, mine, sp = 0u;
    for (;;) {
        sum = 0u; cnt = 0u; mine = 0u;
#pragma unroll
        for (unsigned j = 0; j < 16; ++j) { const unsigned c = xb_ld(&bar[XB_XCNT(j)]); sum += c; cnt += (c > 0u) ? 1u : 0u; mine = (j == x) ? c : mine; }
        if (sum == G) break;
        __builtin_amdgcn_s_sleep(1);
        if ((++sp & 255u) == 0u) { if (xb_ld(&bar[XB_TMO])) break; if (sp > XB_SPIN_CAP) { atomicAdd(&bar[XB_TMO], 1u); break; } }
    }
    nloc = mine > 0u ? mine : 1u; nx = cnt > 0u ? cnt : 1u;
}
DI void xcd_barrier(const XcdBarrier& b) {
    asm volatile("s_waitcnt vmcnt(0)" ::: "memory");
    __syncthreads();
    if (threadIdx.x == 0) {
        unsigned* bar = b.bar;
        __builtin_amdgcn_s_waitcnt(0);
        unsigned nloc = b.st[0], nx = b.st[1];
        if (nloc == 0u) { xcd_barrier_complete(bar, b.x, nloc, nx); b.st[0] = nloc; b.st[1] = nx; }
        const unsigned old = xb_add(&bar[XB_XSUB(b.x)], 1u);
        const unsigned gen = old / nloc;
        if (old + 1u == (gen + 1u) * nloc) {
            __builtin_amdgcn_fence(__ATOMIC_RELEASE, "agent");
            asm volatile("s_waitcnt vmcnt(0)" ::: "memory");
            const unsigned og = xb_add(&bar[XB_TOP], 1u);
            const unsigned tg = og / nx;
            if (og + 1u == (tg + 1u) * nx) xb_add(&bar[XB_TOPGEN], 1u);
            else XB_SPIN(xb_ld(&bar[XB_TOPGEN]) == tg, bar);
            __builtin_amdgcn_fence(__ATOMIC_ACQUIRE, "agent");
            xb_add(&bar[XB_XGEN(b.x)], 1u);
            asm volatile("s_waitcnt vmcnt(0)" ::: "memory");
        } else {
            XB_SPIN(xb_ld(&bar[XB_XGEN(b.x)]) == gen, bar);
            __builtin_amdgcn_fence(__ATOMIC_ACQUIRE, "agent");
            asm volatile("s_waitcnt vmcnt(0)" ::: "memory");
        }
    }
    __syncthreads();
}

DI void phase0(const P& p, char* smem) {
    int tid = threadIdx.x;
    asm volatile("" : "+v"(tid));
    const int lane = tid & 63, wid = tid >> 6;
    for (int row = blockIdx.x * 4 + wid; row < NTOK; row += gridDim.x * 4) {
        const float4* xr = (const float4*)(p.x + (size_t)row * DM);
        float4 v[4]; float ss = 0.f;
#pragma unroll
        for (int i = 0; i < 4; ++i) { v[i] = xr[lane + 64 * i]; ss += v[i].x * v[i].x + v[i].y * v[i].y + v[i].z * v[i].z + v[i].w * v[i].w; }
#pragma unroll
        for (int o = 32; o >= 1; o >>= 1) ss += __shfl_xor(ss, o);
        uint2* xo = (uint2*)(p.xb() + (size_t)row * DM);
#pragma unroll
        for (int i = 0; i < 4; ++i) xo[lane + 64 * i] = make_uint2(pack2(v[i].x, v[i].y), pack2(v[i].z, v[i].w));
        if (lane == 0) p.rs()[row] = rsqrtf(ss * (1.f / 1024.f) + EPS);
    }
    float* tile = (float*)smem;
    for (int t = blockIdx.x; t < 1024 + 256; t += gridDim.x) {
        const float* src; u16* dst; int ncols, td, tc; bool scale;
        if (t < 1024) { src = p.w_in; dst = p.winT(); ncols = 4096; td = t >> 6; tc = t & 63; scale = true; }
        else { const int t2 = t - 1024; src = p.w_out; dst = p.woutT(); ncols = 1024; td = t2 >> 4; tc = t2 & 15; scale = false; }
#pragma unroll
        for (int i = 0; i < 4; ++i) {
            const int r = (tid >> 4) + 16 * i, c4 = (tid & 15) * 4;
            float4 v = *(const float4*)(src + (size_t)(td * 64 + r) * ncols + tc * 64 + c4);
            const float s = scale ? p.norm_w[td * 64 + r] : 1.f;
            tile[r * 65 + c4 + 0] = v.x * s; tile[r * 65 + c4 + 1] = v.y * s; tile[r * 65 + c4 + 2] = v.z * s; tile[r * 65 + c4 + 3] = v.w * s;
        }
        __syncthreads();
#pragma unroll
        for (int u = 0; u < 2; ++u) {
            const int g = (tid & 3) + 4 * u, c = tid >> 2;
            float e[8];
#pragma unroll
            for (int j = 0; j < 8; ++j) e[j] = tile[(g * 8 + j) * 65 + c];
            u32x4 pk; pk[0] = pack2(e[0], e[1]); pk[1] = pack2(e[2], e[3]); pk[2] = pack2(e[4], e[5]); pk[3] = pack2(e[6], e[7]);
            *(u32x4*)(dst + (size_t)(tc * 64 + c) * 1024 + td * 64 + g * 8) = pk;
        }
        __syncthreads();
    }
    for (int idx = blockIdx.x * 256 + tid; idx < SEQ * 32; idx += gridDim.x * 256) {
        const int pos = idx >> 5, j = idx & 31;
        const float inv = (float)(1.0 / exp2((double)j * (13.287712379549449 / 32.0)));
        const float ang = (float)pos * inv;
        const double rev = (double)ang * 0.15915494309189535;
        const float fr = (float)(rev - floor(rev));
        p.rope()[idx] = __builtin_amdgcn_cosf(fr);
        p.rope()[SEQ * 32 + idx] = __builtin_amdgcn_sinf(fr);
    }
}

template <int GRP, int G4> DI void epi_unit(const P& p, const f32x16& a0, const f32x16& a1, int cl, int rb0, int l31, float oml0, float oml1) {
    const float4 rsv = *(const float4*)(p.rs() + rb0);
    float v0[4], v1[4];
    v0[0] = a0[G4 * 4 + 0] * rsv.x; v0[1] = a0[G4 * 4 + 1] * rsv.y; v0[2] = a0[G4 * 4 + 2] * rsv.z; v0[3] = a0[G4 * 4 + 3] * rsv.w;
    v1[0] = a1[G4 * 4 + 0] * rsv.x; v1[1] = a1[G4 * 4 + 1] * rsv.y; v1[2] = a1[G4 * 4 + 2] * rsv.z; v1[3] = a1[G4 * 4 + 3] * rsv.w;
    const size_t o0 = (size_t)rb0 * 512 + cl + l31;
    if (GRP == 0 || GRP == 3 || GRP == 7) {
        u16* dst = ((GRP == 0) ? p.hq() : (GRP == 3 ? p.hz() : p.az())) + o0;
#pragma unroll
        for (int j = 0; j < 4; ++j) { dst[j * 512] = f2bf(silu(v0[j])); dst[j * 512 + 32] = f2bf(silu(v1[j])); }
    } else if (GRP == 1) {
        float* dst = p.lf() + o0;
#pragma unroll
        for (int j = 0; j < 4; ++j) {
            const float u0 = oml0 / (1.f + __expf(v0[j])), u1 = oml1 / (1.f + __expf(v1[j]));
            dst[j * 512] = log1pf(-u0); dst[j * 512 + 32] = log1pf(-u1);
        }
    } else if (GRP == 2) {
        const int b = rb0 >> 13, t = rb0 & 8191;
        *(uint2*)(p.viT() + ((size_t)(b * 512 + cl + l31)) * 8192 + t) = make_uint2(pack2(v0[0], v0[1]), pack2(v0[2], v0[3]));
        *(uint2*)(p.viT() + ((size_t)(b * 512 + cl + 32 + l31)) * 8192 + t) = make_uint2(pack2(v1[0], v1[1]), pack2(v1[2], v1[3]));
    } else if (GRP == 6) {
        u16* dst = p.av() + o0;
#pragma unroll
        for (int j = 0; j < 4; ++j) { dst[j * 512] = f2bf(v0[j]); dst[j * 512 + 32] = f2bf(v1[j]); }
    } else {
        u16* dst = ((GRP == 4) ? p.aq() : p.ak()) + o0;
        const float sc = (GRP == 4) ? 0.125f : 1.f;
        const float* rp = p.rope() + (rb0 & 8191) * 32 + l31;
#pragma unroll
        for (int j = 0; j < 4; ++j) {
            const float cs = rp[j * 32] * sc, sn = rp[SEQ * 32 + j * 32] * sc;
            dst[j * 512] = f2bf(v0[j] * cs - v1[j] * sn);
            dst[j * 512 + 32] = f2bf(v1[j] * cs + v0[j] * sn);
        }
    }
}
template <int GRP> DI void epi1(const P& p, const f32x16 (&acc)[4][2], int cl, int rowb, int l31, int lh) {
    float oml0 = 0.f, oml1 = 0.f;
    if (GRP == 1) {
        const float a0 = p.lbl[cl + l31], a1 = p.lbl[512 + cl + l31];
        const float b0 = p.lbl[cl + 32 + l31], b1 = p.lbl[512 + cl + 32 + l31];
        float lb0 = 1.f / (1.f + __expf(a1 - a0)), lb1 = 1.f / (1.f + __expf(b1 - b0));
        lb0 = fminf(fmaxf(lb0, 1e-6f), 1.f - 1e-6f); lb1 = fminf(fmaxf(lb1, 1e-6f), 1.f - 1e-6f);
        oml0 = 1.f - lb0; oml1 = 1.f - lb1;
    }
    const int rbl = rowb + lh * 4;
#define EPI_U(MT, G4) epi_unit<GRP, G4>(p, acc[MT][0], acc[MT][1], cl, rbl + MT * 32 + G4 * 8, l31, oml0, oml1);
#define EPI_M(MT) EPI_U(MT, 0) EPI_U(MT, 1) EPI_U(MT, 2) EPI_U(MT, 3)
    EPI_M(0) EPI_M(1) EPI_M(2) EPI_M(3)
#undef EPI_M
#undef EPI_U
}

template <int GRP> DI void epiT(const P& p, const f32x16 (&acc)[4][2], char* smem, int cl, int rowb, int wid, int lane, int l31, int lh) {
    char* wreg = smem + wid * (128 * 144);
#pragma unroll
    for (int m = 0; m < 4; ++m) {
        const int row = rowb + m * 32 + l31;
        const float rs = p.rs()[row];
#pragma unroll
        for (int g4 = 0; g4 < 4; ++g4) {
            __builtin_amdgcn_sched_barrier(0);
            const int j0 = g4 * 8 + lh * 4;
            float v0[4], v1[4];
#pragma unroll
            for (int j = 0; j < 4; ++j) { v0[j] = acc[m][0][g4 * 4 + j] * rs; v1[j] = acc[m][1][g4 * 4 + j] * rs; }
            if (GRP == 1) {
                const float4 a0 = *(const float4*)(p.lbl + cl + j0), a1 = *(const float4*)(p.lbl + 512 + cl + j0);
                const float4 b0 = *(const float4*)(p.lbl + cl + 32 + j0), b1 = *(const float4*)(p.lbl + 512 + cl + 32 + j0);
                const float la0[4] = {a0.x, a0.y, a0.z, a0.w}, la1[4] = {a1.x, a1.y, a1.z, a1.w}, lb0[4] = {b0.x, b0.y, b0.z, b0.w}, lb1[4] = {b1.x, b1.y, b1.z, b1.w};
                float o0[4], o1[4];
#pragma unroll
                for (int j = 0; j < 4; ++j) {
                    float l0 = 1.f / (1.f + __expf(la1[j] - la0[j])), l1 = 1.f / (1.f + __expf(lb1[j] - lb0[j]));
                    l0 = fminf(fmaxf(l0, 1e-6f), 1.f - 1e-6f); l1 = fminf(fmaxf(l1, 1e-6f), 1.f - 1e-6f);
                    o0[j] = log1pf(-(1.f - l0) / (1.f + __expf(v0[j])));
                    o1[j] = log1pf(-(1.f - l1) / (1.f + __expf(v1[j])));
                }
                float* dst = p.lf() + (size_t)row * 512 + cl + j0;
                *(float4*)dst = make_float4(o0[0], o0[1], o0[2], o0[3]);
                *(float4*)(dst + 32) = make_float4(o1[0], o1[1], o1[2], o1[3]);
            } else {
                float o0[4], o1[4];
                if (GRP == 0 || GRP == 3 || GRP == 7) {
#pragma unroll
                    for (int j = 0; j < 4; ++j) { o0[j] = silu(v0[j]); o1[j] = silu(v1[j]); }
                } else if (GRP == 6) {
#pragma unroll
                    for (int j = 0; j < 4; ++j) { o0[j] = v0[j]; o1[j] = v1[j]; }
                } else {
                    const float sc = (GRP == 4) ? 0.125f : 1.f;
                    const float4 c4 = *(const float4*)(p.rope() + (row & 8191) * 32 + j0), s4 = *(const float4*)(p.rope() + SEQ * 32 + (row & 8191) * 32 + j0);
                    const float cs[4] = {c4.x, c4.y, c4.z, c4.w}, sn[4] = {s4.x, s4.y, s4.z, s4.w};
#pragma unroll
                    for (int j = 0; j < 4; ++j) { o0[j] = (v0[j] * cs[j] - v1[j] * sn[j]) * sc; o1[j] = (v1[j] * cs[j] + v0[j] * sn[j]) * sc; }
                }
                *(uint2*)(wreg + (m * 32 + l31) * 144 + j0 * 2) = make_uint2(pack2(o0[0], o0[1]), pack2(o0[2], o0[3]));
                *(uint2*)(wreg + (m * 32 + l31) * 144 + (32 + j0) * 2) = make_uint2(pack2(o1[0], o1[1]), pack2(o1[2], o1[3]));
            }
        }
    }
    if (GRP != 1) {
        __syncthreads();
        u16* dst = (GRP == 0) ? p.hq() : (GRP == 3) ? p.hz() : (GRP == 4) ? p.aq() : (GRP == 5) ? p.ak() : (GRP == 6) ? p.av() : p.az();
        const int ch = lane & 7, r8 = lane >> 3;
#pragma unroll 4
        for (int i = 0; i < 16; ++i) {
            const int r = r8 + 8 * i;
            const u32x4 v = *(const u32x4*)(wreg + r * 144 + ch * 16);
            *(u32x4*)(dst + (size_t)(rowb + r) * 512 + cl + ch * 8) = v;
        }
    }
}

template <bool SWAP> DI void gemm_core(const u16* Apanel, const u16* Bpanel, char* smem, f32x16 (&acc)[4][2], int tid, int wr, int wc, int l31, int lh) {
    char* As = smem;
    char* Bs = smem + 256 * 144;
    const int c8 = tid & 7, r0 = tid >> 3;
    const unsigned toff = (unsigned)(r0 * 1024 + c8 * 8) * 2u;
    const char* Ag = (const char*)Apanel;
    const char* Bg = (const char*)Bpanel;
#pragma unroll
    for (int m = 0; m < 4; ++m)
#pragma unroll
        for (int n = 0; n < 2; ++n)
#pragma unroll
            for (int r = 0; r < 16; ++r) acc[m][n][r] = 0.f;
    u32x4 ra[8], rb[4];
#pragma unroll
    for (int i = 0; i < 8; ++i) ra[i] = *(const u32x4*)(Ag + (size_t)(32 * i) * 2048 + toff);
#pragma unroll
    for (int i = 0; i < 4; ++i) rb[i] = *(const u32x4*)(Bg + (size_t)(32 * i) * 2048 + toff);
    __syncthreads();
#pragma unroll
    for (int i = 0; i < 8; ++i) *(u32x4*)(As + (r0 + 32 * i) * 144 + c8 * 16) = ra[i];
#pragma unroll
    for (int i = 0; i < 4; ++i) *(u32x4*)(Bs + (r0 + 32 * i) * 144 + c8 * 16) = rb[i];
    __syncthreads();
    for (int kt = 0; kt < 16; ++kt) {
        if (kt < 15) {
#pragma unroll
            for (int i = 0; i < 8; ++i) ra[i] = *(const u32x4*)(Ag + (size_t)(32 * i) * 2048 + (kt + 1) * 128 + toff);
#pragma unroll
            for (int i = 0; i < 4; ++i) rb[i] = *(const u32x4*)(Bg + (size_t)(32 * i) * 2048 + (kt + 1) * 128 + toff);
        }
#pragma unroll
        for (int ks = 0; ks < 4; ++ks) {
            bf16x8 af[4], bfr[2];
#pragma unroll
            for (int m = 0; m < 4; ++m) af[m] = *(const bf16x8*)(As + (wr * 128 + m * 32 + l31) * 144 + (ks * 16 + lh * 8) * 2);
#pragma unroll
            for (int n = 0; n < 2; ++n) bfr[n] = *(const bf16x8*)(Bs + (wc * 64 + n * 32 + l31) * 144 + (ks * 16 + lh * 8) * 2);
#pragma unroll
            for (int m = 0; m < 4; ++m)
#pragma unroll
                for (int n = 0; n < 2; ++n) acc[m][n] = SWAP ? MFMA32(bfr[n], af[m], acc[m][n]) : MFMA32(af[m], bfr[n], acc[m][n]);
        }
        __syncthreads();
        if (kt < 15) {
#pragma unroll
            for (int i = 0; i < 8; ++i) *(u32x4*)(As + (r0 + 32 * i) * 144 + c8 * 16) = ra[i];
#pragma unroll
            for (int i = 0; i < 4; ++i) *(u32x4*)(Bs + (r0 + 32 * i) * 144 + c8 * 16) = rb[i];
            __syncthreads();
        }
    }
}

DI void phase1(const P& p, char* smem) {
    for (int tile = blockIdx.x; tile < 2048; tile += gridDim.x) {
        int tid = threadIdx.x;
        asm volatile("" : "+v"(tid));
        const int lane = tid & 63, wid = __builtin_amdgcn_readfirstlane(tid >> 6), wr = wid >> 1, wc = wid & 1;
        const int l31 = lane & 31, lh = lane >> 5;
        const int xcd = tile & 7, idx = (tile >> 3) & 63, rnd = tile >> 9;
        const int sid = rnd * 8 + xcd;
        const int pm = (sid & 7) * 8 + (idx & 7), pn = (sid >> 3) * 8 + (idx >> 3);
        f32x16 acc[4][2];
        const int grp = pn >> 2;
        const int cl = ((pn & 3) * 128) + wc * 64;
        const int rowb = pm * 256 + wr * 128;
        const u16* Ap = p.xb() + (size_t)pm * 256 * 1024;
        const u16* Bp = p.winT() + (size_t)pn * 128 * 1024;
        if (grp == 2) {
            gemm_core<false>(Ap, Bp, smem, acc, tid, wr, wc, l31, lh);
            epi1<2>(p, acc, cl, rowb, l31, lh);
        } else {
            gemm_core<true>(Ap, Bp, smem, acc, tid, wr, wc, l31, lh);
            switch (grp) {
                case 0: epiT<0>(p, acc, smem, cl, rowb, wid, lane, l31, lh); break;
                case 1: epiT<1>(p, acc, smem, cl, rowb, wid, lane, l31, lh); break;
                case 3: epiT<3>(p, acc, smem, cl, rowb, wid, lane, l31, lh); break;
                case 4: epiT<4>(p, acc, smem, cl, rowb, wid, lane, l31, lh); break;
                case 5: epiT<5>(p, acc, smem, cl, rowb, wid, lane, l31, lh); break;
                case 6: epiT<6>(p, acc, smem, cl, rowb, wid, lane, l31, lh); break;
                default: epiT<7>(p, acc, smem, cl, rowb, wid, lane, l31, lh); break;
            }
        }
    }
}

DI void pass1(const P& p, char* smem, int item) {
    int tid = threadIdx.x;
    asm volatile("" : "+v"(tid));
    const int lane = tid & 63, wid = tid >> 6, l31 = lane & 31, lh = lane >> 5;
    const int bh = item >> 7, c = item & 127, b = bh >> 2, h = bh & 3;
    const size_t m0 = (size_t)b * 8192 + c * 64;
    float* tot = (float*)smem;
    char* kdT = smem + 1024;
    const int k = tid & 127, half = tid >> 7;
    const float* lfp = p.lf() + (m0 + half * 32) * 512 + h * 128 + k;
    float v[32]; float T = 0.f;
#pragma unroll
    for (int i = 0; i < 32; ++i) { v[i] = lfp[(size_t)i * 512]; T += v[i]; }
    tot[half * 128 + k] = T;
    __syncthreads();
    const float other = tot[(half ^ 1) * 128 + k];
    float suf = (half == 0) ? other : 0.f;
    float kd[32];
#pragma unroll
    for (int i = 31; i >= 0; --i) { kd[i] = kfromlf(v[i]) * __expf(suf); suf += v[i]; }
#pragma unroll
    for (int q = 0; q < 4; ++q) {
        u32x4 pk;
        pk[0] = pack2(kd[8 * q + 0], kd[8 * q + 1]); pk[1] = pack2(kd[8 * q + 2], kd[8 * q + 3]);
        pk[2] = pack2(kd[8 * q + 4], kd[8 * q + 5]); pk[3] = pack2(kd[8 * q + 6], kd[8 * q + 7]);
        *(u32x4*)(kdT + k * 144 + half * 64 + q * 16) = pk;
    }
    if (half == 0) p.dec()[(size_t)item * 128 + k] = __expf(T + other);
    __syncthreads();
    const u16* vrow = p.viT() + ((size_t)(b * 512 + h * 128 + wid * 32 + l31)) * 8192 + c * 64;
    f32x16 acc[4];
#pragma unroll
    for (int n = 0; n < 4; ++n)
#pragma unroll
        for (int r = 0; r < 16; ++r) acc[n][r] = 0.f;
#pragma unroll
    for (int ks = 0; ks < 4; ++ks) {
        const bf16x8 a = *(const bf16x8*)(vrow + ks * 16 + lh * 8);
#pragma unroll
        for (int nt = 0; nt < 4; ++nt) {
            const bf16x8 bb = *(const bf16x8*)(kdT + (nt * 32 + l31) * 144 + (ks * 16 + lh * 8) * 2);
            acc[nt] = MFMA32(a, bb, acc[nt]);
        }
    }
    u16* so = p.ST() + (size_t)item * 16384;
#pragma unroll
    for (int nt = 0; nt < 4; ++nt)
#pragma unroll
        for (int r = 0; r < 16; ++r) so[(wid * 32 + crow(r, lh)) * 128 + nt * 32 + l31] = f2bf(acc[nt][r]);
    __syncthreads();
}

DI void pass2(const P& p) {
    int tid = threadIdx.x;
    asm volatile("" : "+v"(tid));
    for (int e = blockIdx.x * 256 + tid; e < 65536; e += gridDim.x * 256) {
        const int bh = e >> 13, rem = e & 8191, k2 = (rem & 63) * 2;
        unsigned* st = (unsigned*)p.ST() + (size_t)bh * 128 * 8192 + rem;
        const float2* dc = (const float2*)(p.dec() + (size_t)bh * 128 * 128 + k2);
        float r0 = 0.f, r1 = 0.f;
        for (int c0 = 0; c0 < 128; c0 += 8) {
            unsigned s[8]; float2 d[8];
#pragma unroll
            for (int j = 0; j < 8; ++j) { s[j] = st[(size_t)(c0 + j) * 8192]; d[j] = dc[(c0 + j) * 64]; }
#pragma unroll
            for (int j = 0; j < 8; ++j) {
                st[(size_t)(c0 + j) * 8192] = pack2(r0, r1);
                r0 = d[j].x * r0 + bflo(s[j]); r1 = d[j].y * r1 + bfhi(s[j]);
            }
        }
    }
}

DI void attn_item(const P& p, char* smem, int item) {
    int tid = threadIdx.x;
    asm volatile("" : "+v"(tid));
    const int lane = tid & 63, wid = tid >> 6, l31 = lane & 31, lh = lane >> 5;
    const int pat = item >> 10, idx = item & 1023;
    const int dl = pat * 2, d = 1 << dl, nblk = 64 >> dl;
    const int nb = idx & (nblk - 1);
    int rest = idx >> (6 - dl);
    const int r = rest & (d - 1); rest >>= dl;
    const int hh = rest & 7, b = rest >> 3;
    char* Ks = smem;
    char* VT = smem + 256 * 144;
    const size_t tokbase = (size_t)b * 8192;
    {
        const int c8 = tid & 7, kr = tid >> 3;
#pragma unroll
        for (int i = 0; i < 8; ++i) {
            const int key = kr + 32 * i;
            const int j = nb * 128 - 128 + key;
            if (j >= 0) {
                const size_t off = (tokbase + (size_t)j * d + r) * 512 + hh * 64 + c8 * 8;
                const u32x4 kv = *(const u32x4*)(p.ak() + off);
                const u32x4 vv = *(const u32x4*)(p.av() + off);
                *(u32x4*)(Ks + key * 144 + c8 * 16) = kv;
#pragma unroll
                for (int e = 0; e < 4; ++e) {
                    *(u16*)(VT + (c8 * 8 + 2 * e) * 520 + key * 2) = (u16)(vv[e] & 0xffffu);
                    *(u16*)(VT + (c8 * 8 + 2 * e + 1) * 520 + key * 2) = (u16)(vv[e] >> 16);
                }
            }
        }
    }
    const int jq = nb * 128 + wid * 32 + l31;
    const size_t mq = tokbase + (size_t)jq * d + r;
    bf16x8 qf[4];
#pragma unroll
    for (int ks = 0; ks < 4; ++ks) qf[ks] = *(const bf16x8*)(p.aq() + mq * 512 + hh * 64 + ks * 16 + lh * 8);
    __syncthreads();
    const int kt_lo = (nb == 0) ? 4 : 0;
    f32x16 st[5];
    float mx = -INFINITY;
#pragma unroll
    for (int i = 0; i < 5; ++i) {
        const int kt = wid + i;
        if (kt >= kt_lo) {
#pragma unroll
            for (int rr = 0; rr < 16; ++rr) st[i][rr] = 0.f;
#pragma unroll
            for (int ks = 0; ks < 4; ++ks) {
                const bf16x8 a = *(const bf16x8*)(Ks + (kt * 32 + l31) * 144 + (ks * 16 + lh * 8) * 2);
                st[i] = MFMA32(a, qf[ks], st[i]);
            }
#pragma unroll
            for (int rr = 0; rr < 16; ++rr) {
                const int dist = wid * 32 + l31 + 128 - (kt * 32 + crow(rr, lh));
                if (dist < 0 || dist > 128) st[i][rr] = -INFINITY;
                mx = fmaxf(mx, st[i][rr]);
            }
        } else {
#pragma unroll
            for (int rr = 0; rr < 16; ++rr) st[i][rr] = -INFINITY;
        }
    }
    mx = fmaxf(mx, __shfl_xor(mx, 32));
    float l = 0.f;
    const float mxs = mx * LOG2E;
#pragma unroll
    for (int i = 0; i < 5; ++i)
#pragma unroll
        for (int rr = 0; rr < 16; ++rr) { const float e = exp2f(st[i][rr] * LOG2E - mxs); st[i][rr] = e; l += e; }
    l += __shfl_xor(l, 32);
    f32x16 o[2];
#pragma unroll
    for (int dt = 0; dt < 2; ++dt)
#pragma unroll
        for (int rr = 0; rr < 16; ++rr) o[dt][rr] = 0.f;
#pragma unroll
    for (int i = 0; i < 5; ++i) {
        const int kt = wid + i;
        if (kt >= kt_lo) {
#pragma unroll
            for (int ks2 = 0; ks2 < 2; ++ks2) {
                const bf16x8 bq = packB(st[i], ks2);
#pragma unroll
                for (int dt = 0; dt < 2; ++dt) {
                    const char* ad = VT + (dt * 32 + l31) * 520 + (kt * 32 + ks2 * 16 + lh * 4) * 2;
                    const uint2 lo = *(const uint2*)ad, hi = *(const uint2*)(ad + 16);
                    u32x4 av4; av4[0] = lo.x; av4[1] = lo.y; av4[2] = hi.x; av4[3] = hi.y;
                    o[dt] = MFMA32(__builtin_bit_cast(bf16x8, av4), bq, o[dt]);
                }
            }
        }
    }
    const float inv = 1.f / l;
    u16* op = (pat == 0 ? p.ao0() : (pat == 1 ? p.ao1() : p.ao2())) + mq * 512 + hh * 64;
#pragma unroll
    for (int dt = 0; dt < 2; ++dt)
#pragma unroll
        for (int g4 = 0; g4 < 4; ++g4)
            *(uint2*)(op + dt * 32 + g4 * 8 + lh * 4) = make_uint2(pack2(o[dt][g4 * 4] * inv, o[dt][g4 * 4 + 1] * inv), pack2(o[dt][g4 * 4 + 2] * inv, o[dt][g4 * 4 + 3] * inv));
    if (lh == 0) p.lse()[((size_t)pat * NTOK + mq) * 8 + hh] = mx + __logf(l);
    __syncthreads();
}

DI void pass3(const P& p, char* smem, int item) {
    int tid = threadIdx.x;
    asm volatile("" : "+v"(tid));
    const int lane = tid & 63, wid = tid >> 6, l31 = lane & 31, lh = lane >> 5;
    const int bh = item >> 7, c = item & 127, b = bh >> 2, h = bh & 3;
    const size_t m0 = (size_t)b * 8192 + c * 64;
    float* tot = (float*)smem;
    float* red = (float*)(smem + 1024);
    char* Qp = smem + 2048;
    char* Qpp = Qp + 64 * 272;
    char* Kp = Qpp + 64 * 272;
    {
        const int k = tid & 127, half = tid >> 7;
        const float* lfp = p.lf() + (m0 + half * 32) * 512 + h * 128 + k;
        const u16* qp = p.hq() + (m0 + half * 32) * 512 + h * 128 + k;
        float v[32]; float T = 0.f;
#pragma unroll
        for (int i = 0; i < 32; ++i) { v[i] = lfp[(size_t)i * 512]; T += v[i]; }
        tot[half * 128 + k] = T;
        __syncthreads();
        const float other = tot[(half ^ 1) * 128 + k];
        const float bref = (half == 0) ? T : other;
        const float ebref = __expf(bref);
        const float sub = (half == 0) ? T : 0.f;
        float pre = 0.f;
#pragma unroll
        for (int i = 0; i < 32; ++i) {
            pre += v[i];
            const float xx = pre - sub;
            const float E1 = __expf(xx), Ei = __expf(-xx);
            const float q = bf2f(qp[(size_t)i * 512]);
            const float kk = kfromlf(v[i]);
            const int row = half * 32 + i;
            *(u16*)(Qp + row * 272 + k * 2) = f2bf(q * E1);
            *(u16*)(Qpp + row * 272 + k * 2) = f2bf(q * E1 * ebref);
            *(u16*)(Kp + row * 272 + k * 2) = f2bf(kk * Ei);
        }
    }
    __syncthreads();
    const int tt = wid & 1, vh = wid >> 1;
    f32x16 at[2];
#pragma unroll
    for (int st = 0; st < 2; ++st) {
#pragma unroll
        for (int rr = 0; rr < 16; ++rr) at[st][rr] = 0.f;
        if (st <= tt) {
#pragma unroll
            for (int ks = 0; ks < 8; ++ks) {
                const bf16x8 a = *(const bf16x8*)(Kp + (st * 32 + l31) * 272 + (ks * 16 + lh * 8) * 2);
                const bf16x8 bq = *(const bf16x8*)(Qp + (tt * 32 + l31) * 272 + (ks * 16 + lh * 8) * 2);
                at[st] = MFMA32(a, bq, at[st]);
            }
            if (st == tt) {
#pragma unroll
                for (int rr = 0; rr < 16; ++rr) if (crow(rr, lh) > l31) at[st][rr] = 0.f;
            }
        }
    }
    f32x16 o[2];
#pragma unroll
    for (int vt = 0; vt < 2; ++vt) {
#pragma unroll
        for (int rr = 0; rr < 16; ++rr) o[vt][rr] = 0.f;
        const int vrow = 64 * vh + 32 * vt + l31;
        const u16* srow = p.ST() + (size_t)item * 16384 + vrow * 128;
#pragma unroll
        for (int ks = 0; ks < 8; ++ks) {
            const bf16x8 a = *(const bf16x8*)(srow + ks * 16 + lh * 8);
            const bf16x8 bq = *(const bf16x8*)(Qpp + (tt * 32 + l31) * 272 + (ks * 16 + lh * 8) * 2);
            o[vt] = MFMA32(a, bq, o[vt]);
        }
        const u16* vr = p.viT() + ((size_t)(b * 512 + h * 128 + vrow)) * 8192 + c * 64;
#pragma unroll
        for (int st = 0; st < 2; ++st) {
            if (st <= tt) {
#pragma unroll
                for (int ks2 = 0; ks2 < 2; ++ks2) {
                    const uint2 lo = *(const uint2*)(vr + st * 32 + ks2 * 16 + lh * 4);
                    const uint2 hi = *(const uint2*)(vr + st * 32 + ks2 * 16 + 8 + lh * 4);
                    u32x4 av4; av4[0] = lo.x; av4[1] = lo.y; av4[2] = hi.x; av4[3] = hi.y;
                    o[vt] = MFMA32(__builtin_bit_cast(bf16x8, av4), packB(at[st], ks2), o[vt]);
                }
            }
        }
    }
    float ss = 0.f;
#pragma unroll
    for (int vt = 0; vt < 2; ++vt)
#pragma unroll
        for (int rr = 0; rr < 16; ++rr) ss += o[vt][rr] * o[vt][rr];
    ss += __shfl_xor(ss, 32);
    if (lh == 0) red[vh * 64 + tt * 32 + l31] = ss;
    __syncthreads();
    const float tot2 = red[tt * 32 + l31] + red[64 + tt * 32 + l31];
    const float rinv = rsqrtf(tot2 * (1.f / 128.f) + EPS);
    const size_t m = m0 + tt * 32 + l31;
#pragma unroll
    for (int vt = 0; vt < 2; ++vt)
#pragma unroll
        for (int g4 = 0; g4 < 4; ++g4) {
            const int vb = 64 * vh + 32 * vt + 8 * g4 + 4 * lh;
            const float4 gw = *(const float4*)(p.hgw + h * 128 + vb);
            const uint2 zz = *(const uint2*)(p.hz() + m * 512 + h * 128 + vb);
            const float y0 = o[vt][g4 * 4 + 0] * rinv * gw.x * bflo(zz.x);
            const float y1 = o[vt][g4 * 4 + 1] * rinv * gw.y * bfhi(zz.x);
            const float y2 = o[vt][g4 * 4 + 2] * rinv * gw.z * bflo(zz.y);
            const float y3 = o[vt][g4 * 4 + 3] * rinv * gw.w * bfhi(zz.y);
            *(uint2*)(p.mixed() + m * 1024 + h * 128 + vb) = make_uint2(pack2(y0, y1), pack2(y2, y3));
        }
    __syncthreads();
}

DI void combine_items(const P& p) {
    int tid = threadIdx.x;
    asm volatile("" : "+v"(tid));
    for (int idx = blockIdx.x * 256 + tid; idx < NTOK * 64; idx += gridDim.x * 256) {
        const size_t m = (size_t)(idx >> 6); const int ch = idx & 63, hh = ch >> 3;
        const float l0 = p.lse()[m * 8 + hh], l1 = p.lse()[((size_t)NTOK + m) * 8 + hh], l2 = p.lse()[((size_t)2 * NTOK + m) * 8 + hh];
        const float mx = fmaxf(l0, fmaxf(l1, l2));
        float w0 = __expf(l0 - mx), w1 = __expf(l1 - mx), w2 = __expf(l2 - mx);
        const float inv = 1.f / (w0 + w1 + w2);
        w0 *= inv; w1 *= inv; w2 *= inv;
        const u32x4 a0 = *(const u32x4*)(p.ao0() + m * 512 + ch * 8), a1 = *(const u32x4*)(p.ao1() + m * 512 + ch * 8), a2 = *(const u32x4*)(p.ao2() + m * 512 + ch * 8);
        const u32x4 zz = *(const u32x4*)(p.az() + m * 512 + ch * 8);
        u32x4 pk;
#pragma unroll
        for (int e = 0; e < 4; ++e) {
            const float y0 = (w0 * bflo(a0[e]) + w1 * bflo(a1[e]) + w2 * bflo(a2[e])) * bflo(zz[e]);
            const float y1 = (w0 * bfhi(a0[e]) + w1 * bfhi(a1[e]) + w2 * bfhi(a2[e])) * bfhi(zz[e]);
            pk[e] = pack2(y0, y1);
        }
        *(u32x4*)(p.mixed() + m * 1024 + 512 + ch * 8) = pk;
    }
}

DI float rowsum32(float v) {
    v += __shfl_xor(v, 1); v += __shfl_xor(v, 2); v += __shfl_xor(v, 4); v += __shfl_xor(v, 8); v += __shfl_xor(v, 16);
    return v;
}
DI void phase5(const P& p, char* smem, int tile) {
    int tid = threadIdx.x;
    asm volatile("" : "+v"(tid));
    const int lane = tid & 63, wid = __builtin_amdgcn_readfirstlane(tid >> 6), wr = wid >> 1, wc = wid & 1, l31 = lane & 31, lh = lane >> 5;
    const int pm = (tile & 7) + 8 * (tile >> 6), pn = (tile >> 3) & 7;
    f32x16 acc[4][2];
    gemm_core<false>(p.mixed() + (size_t)pm * 256 * 1024, p.woutT() + (size_t)pn * 128 * 1024, smem, acc, tid, wr, wc, l31, lh);
    float* red = (float*)smem;
    float* rinvs = (float*)(smem + 2048);
    const int loff = lh * 4 * 1024 + l31;
    const size_t ubase = ((size_t)pm * 256 + wr * 128) * 1024 + pn * 128 + wc * 64;
#pragma unroll
    for (int m = 0; m < 4; ++m) {
#pragma unroll
        for (int g4 = 0; g4 < 4; ++g4) {
            __builtin_amdgcn_sched_barrier(0);
#pragma unroll
            for (int j = 0; j < 4; ++j) {
                const int r = g4 * 4 + j;
                const float* xp = p.x + ubase + (size_t)(m * 32 + g4 * 8 + j) * 1024;
                acc[m][0][r] += xp[loff]; acc[m][1][r] += xp[loff + 32];
                const float part = rowsum32(fmaf(acc[m][0][r], acc[m][0][r], acc[m][1][r] * acc[m][1][r]));
                if (l31 == 0) red[wc * 256 + wr * 128 + m * 32 + crow(r, lh)] = part;
            }
        }
    }
    __syncthreads();
    (void)__hip_atomic_fetch_add(p.rowss() + pm * 256 + tid, red[tid] + red[256 + tid], __ATOMIC_RELAXED, __HIP_MEMORY_SCOPE_AGENT);
    __threadfence();
    __syncthreads();
    if (tid == 0) {
        (void)__hip_atomic_fetch_add(p.pcnt() + pm, 1u, __ATOMIC_RELAXED, __HIP_MEMORY_SCOPE_AGENT);
        unsigned sp = 0;
        while (__hip_atomic_load(p.pcnt() + pm, __ATOMIC_RELAXED, __HIP_MEMORY_SCOPE_AGENT) < 8u) { __builtin_amdgcn_s_sleep(2); if (++sp > (1u << 22)) break; }
        __builtin_amdgcn_fence(__ATOMIC_ACQUIRE, "agent");
    }
    __syncthreads();
    {
        const float tot = __hip_atomic_load(p.rowss() + pm * 256 + tid, __ATOMIC_RELAXED, __HIP_MEMORY_SCOPE_AGENT);
        rinvs[tid] = rsqrtf(tot * (1.f / 1024.f) + EPS);
    }
    __syncthreads();
    const float fw0 = p.fw[pn * 128 + wc * 64 + l31], fw1 = p.fw[pn * 128 + wc * 64 + l31 + 32];
#pragma unroll
    for (int m = 0; m < 4; ++m) {
#pragma unroll
        for (int g4 = 0; g4 < 4; ++g4) {
            __builtin_amdgcn_sched_barrier(0);
            const float4 rv = *(const float4*)(rinvs + wr * 128 + m * 32 + g4 * 8 + lh * 4);
            const float rva[4] = {rv.x, rv.y, rv.z, rv.w};
#pragma unroll
            for (int j = 0; j < 4; ++j) {
                float* op = p.out + ubase + (size_t)(m * 32 + g4 * 8 + j) * 1024;
                op[loff] = acc[m][0][g4 * 4 + j] * rva[j] * fw0;
                op[loff + 32] = acc[m][1][g4 * 4 + j] * rva[j] * fw1;
            }
        }
    }
    __syncthreads();
}

constexpr int SMEM_BYTES = 4 * 128 * 144;

__global__ void __launch_bounds__(256, 2) fwd_kernel(P p) {
    __shared__ __attribute__((aligned(16))) char smem[SMEM_BYTES];
    __shared__ uint4 xb_words;
    if (threadIdx.x == 0) xb_words = make_uint4(0u, 0u, 0u, 0u);
    __syncthreads();
    const XcdBarrier gb = xcd_barrier_post(p.bar(), (volatile unsigned*)&xb_words);
    phase0(p, smem);
    xcd_barrier(gb);
    phase1(p, smem);
    xcd_barrier(gb);
    for (int it = blockIdx.x; it < 1024; it += gridDim.x) pass1(p, smem, it);
    xcd_barrier(gb);
    pass2(p);
    if (gridDim.x == 512) {
        const int bi = blockIdx.x;
        const int first = (bi < 256) ? bi * 5 : 1280 + (bi - 256) * 7, cnt = (bi < 256) ? 5 : 7;
        for (int i = 0; i < cnt; ++i) attn_item(p, smem, first + i);
    } else {
        for (int it = blockIdx.x; it < 3072; it += gridDim.x) attn_item(p, smem, it);
    }
    xcd_barrier(gb);
    for (int it = blockIdx.x; it < 1024; it += gridDim.x) pass3(p, smem, it);
    combine_items(p);
    xcd_barrier(gb);
    for (int it = blockIdx.x; it < 512; it += gridDim.x) phase5(p, smem, it);
}

extern "C" void kernel_launch(void* const* d_in, const int* in_sizes, int n_in, void* d_out, int out_size, void* d_ws, size_t ws_size, hipStream_t stream) {
    static int grid_blocks = 0;
    if (!grid_blocks) {
        int dev = 0, cus = 0, per_cu = 0;
        (void)hipGetDevice(&dev);
        (void)hipDeviceGetAttribute(&cus, hipDeviceAttributeMultiprocessorCount, dev);
        (void)hipOccupancyMaxActiveBlocksPerMultiprocessor(&per_cu, fwd_kernel, 256, 0);
        if (per_cu > 2) per_cu = 2;
        if (per_cu < 1) per_cu = 1;
        grid_blocks = cus * per_cu;
    }
    char* ws = (char*)d_ws;
    P p{};
    p.x = (const float*)d_in[0]; p.norm_w = (const float*)d_in[1]; p.w_in = (const float*)d_in[2]; p.lbl = (const float*)d_in[3];
    p.hgw = (const float*)d_in[4]; p.w_out = (const float*)d_in[5]; p.fw = (const float*)d_in[6];
    p.out = (float*)d_out;
    p.ws = ws;
    (void)hipMemsetAsync(ws + OFF_BAR, 0, OFF_END - OFF_BAR, stream);
    void* args[] = {&p};
    hipError_t e = hipLaunchCooperativeKernel((void*)fwd_kernel, dim3(grid_blocks), dim3(256), args, 0, stream);
    if (e != hipSuccess) fprintf(stderr, "cooperative launch failed: %s (grid %d)\n", hipGetErrorString(e), grid_blocks);
}
```

```cpp
#include <hip/hip_runtime.h>
#include <cstdio>

typedef short bf16x8 __attribute__((ext_vector_type(8)));
typedef float f32x16 __attribute__((ext_vector_type(16)));
typedef __bf16 bf2_t __attribute__((ext_vector_type(2)));
typedef float f2_t __attribute__((ext_vector_type(2)));
typedef unsigned u32x4 __attribute__((ext_vector_type(4)));
typedef unsigned short u16;
typedef _Float16 h16;
typedef _Float16 h16x4 __attribute__((ext_vector_type(4)));

#define DI __device__ __forceinline__
#define VTID ((int)(threadIdx.x & 255u))
#define VB ((int)(blockIdx.x * 2u + (threadIdx.x >> 8)))
#define VGRID ((int)(gridDim.x * 2u))
#define MFMA32(a, b, c) __builtin_amdgcn_mfma_f32_32x32x16_bf16((a), (b), (c), 0, 0, 0)

constexpr int NTOK = 16384, DM = 1024, SEQ = 8192;
constexpr float EPS = 1e-6f;
constexpr float LOG2E = 1.4426950408889634f;

constexpr size_t MB = 1024 * 1024;
constexpr size_t OFF_XB = 0;
constexpr size_t OFF_RS = OFF_XB + 32 * MB;
constexpr size_t OFF_WINT = OFF_RS + 65536;
constexpr size_t OFF_WOUTT = OFF_WINT + 8 * MB;
constexpr size_t OFF_ROPE = OFF_WOUTT + 2 * MB;
constexpr size_t OFF_HQ = OFF_ROPE + 2 * MB;
constexpr size_t OFF_LF = OFF_HQ + 16 * MB;
constexpr size_t OFF_VIT = OFF_LF + 32 * MB;
constexpr size_t OFF_HZ = OFF_VIT + 16 * MB;
constexpr size_t OFF_AQ = OFF_HZ + 16 * MB;
constexpr size_t OFF_AK = OFF_AQ + 16 * MB;
constexpr size_t OFF_AV = OFF_AK + 16 * MB;
constexpr size_t OFF_AZ = OFF_AV + 16 * MB;
constexpr size_t OFF_ST = OFF_AZ + 16 * MB;
constexpr size_t OFF_DEC = OFF_ST + 32 * MB;
constexpr size_t OFF_AO2 = OFF_DEC + 512 * 1024;
constexpr size_t OFF_LSE = OFF_AO2 + 16 * MB;
constexpr size_t OFF_BAR = OFF_LSE + 3 * 16384 * 8 * 4;
constexpr size_t OFF_ROWSS = OFF_BAR + 16384;
constexpr size_t OFF_PCNT = OFF_ROWSS + 65536;
constexpr size_t OFF_END = OFF_PCNT + 1024;

struct P {
    const float* x; const float* norm_w; const float* w_in; const float* lbl; const float* hgw; const float* w_out; const float* fw;
    float* out; char* ws;
    DI u16* xb() const { return (u16*)(ws + OFF_XB); }
    DI float* rs() const { return (float*)(ws + OFF_RS); }
    DI u16* winT() const { return (u16*)(ws + OFF_WINT); }
    DI u16* woutT() const { return (u16*)(ws + OFF_WOUTT); }
    DI float* rope() const { return (float*)(ws + OFF_ROPE); }
    DI u16* hq() const { return (u16*)(ws + OFF_HQ); }
    DI h16* lf() const { return (h16*)(ws + OFF_LF); }
    DI u16* viT() const { return (u16*)(ws + OFF_VIT); }
    DI u16* hz() const { return (u16*)(ws + OFF_HZ); }
    DI u16* aq() const { return (u16*)(ws + OFF_AQ); }
    DI u16* ak() const { return (u16*)(ws + OFF_AK); }
    DI u16* av() const { return (u16*)(ws + OFF_AV); }
    DI u16* az() const { return (u16*)(ws + OFF_AZ); }
    DI u16* ST() const { return (u16*)(ws + OFF_ST); }
    DI float* dec() const { return (float*)(ws + OFF_DEC); }
    DI u16* ao0() const { return (u16*)(ws + OFF_XB); }
    DI u16* ao1() const { return (u16*)(ws + OFF_XB + 16 * MB); }
    DI u16* ao2() const { return (u16*)(ws + OFF_AO2); }
    DI float* lse() const { return (float*)(ws + OFF_LSE); }
    DI u16* mixed() const { return (u16*)(ws + OFF_AQ); }
    DI float* rowss() const { return (float*)(ws + OFF_ROWSS); }
    DI unsigned* pcnt() const { return (unsigned*)(ws + OFF_PCNT); }
    DI unsigned* bar() const { return (unsigned*)(ws + OFF_BAR); }
};

DI unsigned pack2(float a, float b) { f2_t v = {a, b}; return __builtin_bit_cast(unsigned, __builtin_convertvector(v, bf2_t)); }
DI u16 f2bf(float x) { return (u16)(pack2(x, 0.f) & 0xffffu); }
DI float bf2f(u16 v) { return __uint_as_float(((unsigned)v) << 16); }
DI float bflo(unsigned v) { return __uint_as_float(v << 16); }
DI float bfhi(unsigned v) { return __uint_as_float(v & 0xffff0000u); }
DI int crow(int reg, int h) { return (reg & 3) + 8 * (reg >> 2) + 4 * h; }
DI float silu(float v) { return v / (1.f + __expf(-v)); }
DI bf16x8 packB(const f32x16& x, int s) {
    u32x4 pk;
    pk[0] = pack2(x[8 * s + 0], x[8 * s + 1]); pk[1] = pack2(x[8 * s + 2], x[8 * s + 3]);
    pk[2] = pack2(x[8 * s + 4], x[8 * s + 5]); pk[3] = pack2(x[8 * s + 6], x[8 * s + 7]);
    return __builtin_bit_cast(bf16x8, pk);
}
DI float kfromlf(float v) { return (v > -0.02f) ? -v * (1.f + v * (0.5f + v * (1.f / 6.f))) : 1.f - __expf(v); }


#define XB_TMO      128
#define XB_XCNT(j)  (256  + 64 * (j))
#define XB_XSUB(j)  (1280 + 64 * (j))
#define XB_XGEN(j)  (2304 + 64 * (j))
#define XB_TOP      3328
#define XB_TOPGEN   3392
#define XCD_BAR_WORDS 3456
#define XB_SPIN_CAP (1u << 22)
#define LAS __attribute__((address_space(3)))
DI unsigned xb_ld(unsigned* p) { return __hip_atomic_load(p, __ATOMIC_RELAXED, __HIP_MEMORY_SCOPE_AGENT); }
DI unsigned xb_add(unsigned* p, unsigned v) { return __hip_atomic_fetch_add(p, v, __ATOMIC_RELAXED, __HIP_MEMORY_SCOPE_AGENT); }
DI unsigned xb_xcc_id() { return (unsigned)__builtin_amdgcn_s_getreg((3 << 11) | 20) & 0xFu; }
#define XB_SPIN(cond, bar) do { unsigned _sp = 0; while (cond) { __builtin_amdgcn_s_sleep(1); \
    if ((++_sp & 255u) == 0u) { if (xb_ld(&(bar)[XB_TMO])) break; if (_sp > XB_SPIN_CAP) { atomicAdd(&(bar)[XB_TMO], 1u); break; } } } } while (0)
struct XcdBarrier { unsigned* bar; unsigned x; volatile unsigned* st; };
DI XcdBarrier xcd_barrier_post(unsigned* bar, volatile unsigned* st) {
    XcdBarrier b; b.bar = bar; b.x = xb_xcc_id(); b.st = st;
    if (threadIdx.x == 0) (void)xb_add(&bar[XB_XCNT(b.x)], 1u);
    return b;
}
DI void xcd_barrier_complete(unsigned* bar, unsigned x, unsigned& nloc, unsigned& nx) {
    const unsigned G = gridDim.x * gridDim.y * gridDim.z;
    unsigned sum, cnt, mine, sp = 0u;
    for (;;) {
        sum = 0u; cnt = 0u; mine = 0u;
#pragma unroll
        for (unsigned j = 0; j < 16; ++j) { const unsigned c = xb_ld(&bar[XB_XCNT(j)]); sum += c; cnt += (c > 0u) ? 1u : 0u; mine = (j == x) ? c : mine; }
        if (sum == G) break;
        __builtin_amdgcn_s_sleep(1);
        if ((++sp & 255u) == 0u) { if (xb_ld(&bar[XB_TMO])) break; if (sp > XB_SPIN_CAP) { atomicAdd(&bar[XB_TMO], 1u); break; } }
    }
    nloc = mine > 0u ? mine : 1u; nx = cnt > 0u ? cnt : 1u;
}
DI void xcd_barrier(const XcdBarrier& b) {
    asm volatile("s_waitcnt vmcnt(0)" ::: "memory");
    __syncthreads();
    if (threadIdx.x == 0) {
        unsigned* bar = b.bar;
        __builtin_amdgcn_s_waitcnt(0);
        unsigned nloc = b.st[0], nx = b.st[1];
        if (nloc == 0u) { xcd_barrier_complete(bar, b.x, nloc, nx); b.st[0] = nloc; b.st[1] = nx; }
        const unsigned old = xb_add(&bar[XB_XSUB(b.x)], 1u);
        const unsigned gen = old / nloc;
        if (old + 1u == (gen + 1u) * nloc) {
            __builtin_amdgcn_fence(__ATOMIC_RELEASE, "agent");
            asm volatile("s_waitcnt vmcnt(0)" ::: "memory");
            const unsigned og = xb_add(&bar[XB_TOP], 1u);
            const unsigned tg = og / nx;
            if (og + 1u == (tg + 1u) * nx) xb_add(&bar[XB_TOPGEN], 1u);
            else XB_SPIN(xb_ld(&bar[XB_TOPGEN]) == tg, bar);
            __builtin_amdgcn_fence(__ATOMIC_ACQUIRE, "agent");
            xb_add(&bar[XB_XGEN(b.x)], 1u);
            asm volatile("s_waitcnt vmcnt(0)" ::: "memory");
        } else {
            XB_SPIN(xb_ld(&bar[XB_XGEN(b.x)]) == gen, bar);
            __builtin_amdgcn_fence(__ATOMIC_ACQUIRE, "agent");
            asm volatile("s_waitcnt vmcnt(0)" ::: "memory");
        }
    }
    __syncthreads();
}

DI void phase0(const P& p, char* smem) {
    int tid = VTID;
    asm volatile("" : "+v"(tid));
    const int lane = tid & 63, wid = tid >> 6;
    for (int row = VB * 4 + wid; row < NTOK; row += VGRID * 4) {
        const float4* xr = (const float4*)(p.x + (size_t)row * DM);
        float4 v[4]; float ss = 0.f;
#pragma unroll
        for (int i = 0; i < 4; ++i) { typedef float f4v __attribute__((ext_vector_type(4))); const f4v t4 = __builtin_nontemporal_load((const f4v*)(xr + lane + 64 * i)); v[i] = make_float4(t4[0], t4[1], t4[2], t4[3]); ss += v[i].x * v[i].x + v[i].y * v[i].y + v[i].z * v[i].z + v[i].w * v[i].w; }
#pragma unroll
        for (int o = 32; o >= 1; o >>= 1) ss += __shfl_xor(ss, o);
        uint2* xo = (uint2*)(p.xb() + (size_t)row * DM);
#pragma unroll
        for (int i = 0; i < 4; ++i) xo[lane + 64 * i] = make_uint2(pack2(v[i].x, v[i].y), pack2(v[i].z, v[i].w));
        if (lane == 0) p.rs()[row] = rsqrtf(ss * (1.f / 1024.f) + EPS);
    }
    float* tile = (float*)smem;
    for (int t = VB; t < 1024 + 256; t += VGRID) {
        const float* src; u16* dst; int ncols, td, tc; bool scale;
        if (t < 1024) { src = p.w_in; dst = p.winT(); ncols = 4096; td = t >> 6; tc = t & 63; scale = true; }
        else { const int t2 = t - 1024; src = p.w_out; dst = p.woutT(); ncols = 1024; td = t2 >> 4; tc = t2 & 15; scale = false; }
#pragma unroll
        for (int i = 0; i < 4; ++i) {
            const int r = (tid >> 4) + 16 * i, c4 = (tid & 15) * 4;
            float4 v = *(const float4*)(src + (size_t)(td * 64 + r) * ncols + tc * 64 + c4);
            const float s = scale ? p.norm_w[td * 64 + r] : 1.f;
            tile[r * 65 + c4 + 0] = v.x * s; tile[r * 65 + c4 + 1] = v.y * s; tile[r * 65 + c4 + 2] = v.z * s; tile[r * 65 + c4 + 3] = v.w * s;
        }
        __syncthreads();
#pragma unroll
        for (int u = 0; u < 2; ++u) {
            const int g = (tid & 3) + 4 * u, c = tid >> 2;
            float e[8];
#pragma unroll
            for (int j = 0; j < 8; ++j) e[j] = tile[(g * 8 + j) * 65 + c];
            u32x4 pk; pk[0] = pack2(e[0], e[1]); pk[1] = pack2(e[2], e[3]); pk[2] = pack2(e[4], e[5]); pk[3] = pack2(e[6], e[7]);
            int orow = tc * 64 + c;
            if (scale && orow >= 2048 && orow < 3072) { const int d = orow & 63; orow = (orow & ~63) + ((d & 31) << 1) + (d >> 5); }
            *(u32x4*)(dst + (size_t)orow * 1024 + td * 64 + g * 8) = pk;
        }
        __syncthreads();
    }
    for (int idx = VB * 256 + tid; idx < SEQ * 32; idx += VGRID * 256) {
        const int pos = idx >> 5, j = idx & 31;
        const float inv = (float)(1.0 / exp2((double)j * (13.287712379549449 / 32.0)));
        const float ang = (float)pos * inv;
        const double rev = (double)ang * 0.15915494309189535;
        const float fr = (float)(rev - floor(rev));
        p.rope()[idx] = __builtin_amdgcn_cosf(fr);
        p.rope()[SEQ * 32 + idx] = __builtin_amdgcn_sinf(fr);
    }
}

namespace pg8 {
#define PG8_LAS __attribute__((address_space(3)))
typedef unsigned short bf16_t;
typedef short bf16x8 __attribute__((ext_vector_type(8)));
typedef float f32x4 __attribute__((ext_vector_type(4)));
typedef unsigned u32x4 __attribute__((ext_vector_type(4)));
constexpr int BM = 256, BK = 64, HALF = 128, HTB = HALF * BK * 2  , STAGE_BYTES = 8 * HTB, NXCD = 8, WGM = 8;

__host__ __device__ __forceinline__ int lds_byte(int r, int c) { const int st = (r >> 4) * 2 + (c >> 5), rr = r & 15, cc = c & 31, ob = rr * 64 + cc * 2; return st * 1024 + (ob ^ (((ob >> 9) & 1) << 5)); }
__host__ __device__ __forceinline__ void stage_rc(int b, int& R, int& C) { const int st = b / 1024, sb = b % 1024, swz = sb ^ (((sb >> 9) & 1) << 5); R = (st >> 1) * 16 + swz / 64; C = (st & 1) * 32 + (swz % 64) / 2; }
__host__ __device__ __forceinline__ int perm32(int rho) { const int n = rho >> 4, i = rho & 15; return 8 * (i >> 2) + 4 * n + (i & 3); }

struct Unit { int pm, pn; };
struct Gemm { const bf16_t* A; const bf16_t* Bt; int M, N, K; };

struct StaticOrder {
    int nM, nN, nwg, G, c;
    __host__ __device__ void init(int M, int N, int G_, int c_) { nM = M / BM; nN = N / BM; nwg = nM * nN; G = G_; c = c_; }
    __host__ __device__ bool next(int i, Unit& u) const {
        const long L = (long)i * G + c; if (L >= nwg) return false;
        int wgid = (int)L; { const int q = nwg / NXCD, r = nwg % NXCD, xcd = wgid % NXCD, off = wgid / NXCD; wgid = (xcd < r ? xcd * (q + 1) : r * (q + 1) + (xcd - r) * q) + off; }
        const int nig = WGM * nN, gid = wgid / nig, fm = gid * WGM, gsz = (nM - fm) < WGM ? (nM - fm) : WGM;
        u.pm = fm + ((wgid % nig) % gsz); u.pn = (wgid % nig) / gsz; return true;
    }
    __device__ __forceinline__ void a_ready(const Unit&) const {}
    __device__ __forceinline__ void done(const Unit&) const {}
};
template <class Epi, class Sched, bool STAMP = false>
__device__ __forceinline__ void gemm_phase(PG8_LAS unsigned char* lds, const Gemm g, const Sched& S, const Epi& E, unsigned long long* stamps) {
    const int tid = threadIdx.x, wid = __builtin_amdgcn_readfirstlane(tid >> 6), lane = tid & 63, wr = wid >> 2, wc = wid & 3, fr = lane & 15, fq = lane >> 4;
    const int K = g.K, nt = K / BK;
    int ts_lo = 0, ts_hi = 0, nts = 0; const unsigned long long rt_entry = STAMP ? (unsigned long long)wall_clock64() : 0ull;
#define PG8_STAMP() do { if (STAMP && wid == 0 && nts < 64) { const unsigned long long _c = (unsigned long long)clock64(); \
        ts_lo = (lane == nts) ? (int)(unsigned)_c : ts_lo; ts_hi = (lane == nts) ? (int)(unsigned)(_c >> 32) : ts_hi; ++nts; } } while (0)
    PG8_STAMP();
    unsigned voffA[2], voffB[2];
#pragma unroll
    for (int i = 0; i < 2; ++i) { int R, C; stage_rc(tid * 16 + i * 8192, R, C); const int Rb = Epi::PERM ? ((R & ~31) + perm32(R & 31)) : R;
        voffA[i] = (unsigned)(R * K + C) * 2u; voffB[i] = (unsigned)(Rb * K + C) * 2u; }
    const size_t kstep = (size_t)(BK * 2);
    const size_t hstep = (size_t)HALF * K * 2;
    const size_t tstep = 2 * hstep;
    const unsigned ldsw = (unsigned)wid * 1024u;
    const int aoff = lds_byte(wr * 64 + fr, fq * 8), boff = lds_byte(wc * 32 + fr, fq * 8);
#define PG8_SA(b, h) (((b) * 2 + (h)) * HTB)
#define PG8_SB(b, h) ((4 + (b) * 2 + (h)) * HTB)
#define PG8_STAGE(bufoff, gbase, voff) do { _Pragma("unroll") for (int _i = 0; _i < 2; ++_i) \
        __builtin_amdgcn_global_load_lds((const unsigned*)((const char*)(gbase) + (voff)[_i]), (PG8_LAS unsigned*)(lds + (bufoff) + ldsw + _i * 8192), 16, 0, 0); } while (0)
#define PG8_LDA(dst, b, h) do { _Pragma("unroll") for (int m = 0; m < 4; ++m) _Pragma("unroll") for (int k = 0; k < 2; ++k) dst[m][k] = *(const PG8_LAS bf16x8*)(lds + PG8_SA(b, h) + aoff + m * 2048 + k * 1024); } while (0)
#define PG8_LDB(dst, b, h) do { _Pragma("unroll") for (int n = 0; n < 2; ++n) _Pragma("unroll") for (int k = 0; k < 2; ++k) dst[n][k] = *(const PG8_LAS bf16x8*)(lds + PG8_SB(b, h) + boff + n * 2048 + k * 1024); } while (0)
#define PG8_MMA(ai, bj, At, Bt) do { __builtin_amdgcn_s_setprio(1); _Pragma("unroll") for (int m = 0; m < 4; ++m) _Pragma("unroll") for (int n = 0; n < 2; ++n) _Pragma("unroll") for (int k = 0; k < 2; ++k) \
        acc[ai][bj][m][n] = __builtin_amdgcn_mfma_f32_16x16x32_bf16(Bt[n][k], At[m][k], acc[ai][bj][m][n], 0, 0, 0); __builtin_amdgcn_s_setprio(0); } while (0)
#define PG8_WAIT_V(n) asm volatile("s_waitcnt vmcnt(" #n ")" ::: "memory")
#define PG8_WAIT_L(n) asm volatile("s_waitcnt lgkmcnt(" #n ")" ::: "memory")
#define PG8_BAR __builtin_amdgcn_s_barrier()
#define PG8_SCHED __builtin_amdgcn_sched_barrier(0)
    Unit cur, nxt; int ui = 0;
    if (!S.next(0, cur)) return;
    f32x4 acc[2][2][4][2];
#pragma unroll
    for (int a = 0; a < 2; ++a)
#pragma unroll
        for (int b = 0; b < 2; ++b)
#pragma unroll
            for (int m = 0; m < 4; ++m)
#pragma unroll
                for (int n = 0; n < 2; ++n) acc[a][b][m][n] = (f32x4){0.f, 0.f, 0.f, 0.f};
    bf16x8 At[4][2], B0[2][2], B1[2][2];
    const char* cA = (const char*)g.A + (size_t)cur.pm * tstep; const char* cB = (const char*)g.Bt + (size_t)cur.pn * tstep;
    S.a_ready(cur);
    PG8_STAGE(PG8_SB(0, 0), cB, voffB); PG8_STAGE(PG8_SA(0, 0), cA, voffA); PG8_STAGE(PG8_SB(0, 1), cB + hstep, voffB); PG8_STAGE(PG8_SA(0, 1), cA + hstep, voffA);
    if (wr == 1) PG8_BAR;
    PG8_WAIT_V(4); PG8_BAR;
    PG8_STAGE(PG8_SB(1, 0), cB + kstep, voffB); PG8_STAGE(PG8_SA(1, 0), cA + kstep, voffA); PG8_STAGE(PG8_SB(1, 1), cB + hstep + kstep, voffB);
    PG8_WAIT_V(6); PG8_BAR;
    PG8_STAMP();
    for (;;) {
        const bool has_next = S.next(ui + 1, nxt);
        const char* nA = has_next ? (const char*)g.A + (size_t)nxt.pm * tstep : cA; const char* nB = has_next ? (const char*)g.Bt + (size_t)nxt.pn * tstep : cB;
        for (int t = 0; t < nt; t += 2) {
            const bool last = (t == nt - 2);
            const char* a1 = cA + (size_t)(t + 1) * kstep;
            const char* a2 = last ? nA : cA + (size_t)(t + 2) * kstep; const char* b2 = last ? nB : cB + (size_t)(t + 2) * kstep;
            const char* a3 = a2 + kstep; const char* b3 = b2 + kstep;
            if (last && has_next) S.a_ready(nxt);
            PG8_LDB(B0, 0, 0); PG8_SCHED; PG8_LDA(At, 0, 0); PG8_STAGE(PG8_SA(1, 1), a1 + hstep, voffA);
            PG8_WAIT_L(8); PG8_BAR; PG8_WAIT_L(0); PG8_MMA(0, 0, At, B0); PG8_BAR; PG8_SCHED;
            PG8_LDB(B1, 0, 1); PG8_STAGE(PG8_SB(0, 0), b2, voffB);
            PG8_BAR; PG8_WAIT_L(0); PG8_MMA(0, 1, At, B1); PG8_BAR;
            PG8_LDA(At, 0, 1); PG8_STAGE(PG8_SA(0, 0), a2, voffA);
            PG8_BAR; PG8_WAIT_L(0); PG8_MMA(1, 0, At, B0); PG8_BAR; PG8_SCHED;
            PG8_STAGE(PG8_SB(0, 1), b2 + hstep, voffB);
            PG8_WAIT_V(6); PG8_BAR; PG8_MMA(1, 1, At, B1); PG8_BAR;
            PG8_LDB(B0, 1, 0); PG8_SCHED; PG8_LDA(At, 1, 0); PG8_STAGE(PG8_SA(0, 1), a2 + hstep, voffA);
            PG8_WAIT_L(8); PG8_BAR; PG8_WAIT_L(0); PG8_MMA(0, 0, At, B0); PG8_BAR; PG8_SCHED;
            PG8_LDB(B1, 1, 1); PG8_STAGE(PG8_SB(1, 0), b3, voffB);
            PG8_BAR; PG8_WAIT_L(0); PG8_MMA(0, 1, At, B1); PG8_BAR;
            PG8_LDA(At, 1, 1); PG8_STAGE(PG8_SA(1, 0), a3, voffA);
            PG8_BAR; PG8_WAIT_L(0); PG8_MMA(1, 0, At, B0); PG8_BAR; PG8_SCHED;
            PG8_STAGE(PG8_SB(1, 1), b3 + hstep, voffB);
            PG8_WAIT_V(6); PG8_BAR; PG8_MMA(1, 1, At, B1); PG8_BAR;
        }
        PG8_STAMP();
        if constexpr (!Epi::AFTER_DRAIN) { E(acc, cur, wr, wc, fr, fq); S.done(cur); }
        PG8_STAMP();
        if (!has_next) break;
#pragma unroll
        for (int a = 0; a < 2; ++a)
#pragma unroll
            for (int b = 0; b < 2; ++b)
#pragma unroll
                for (int m = 0; m < 4; ++m)
#pragma unroll
                    for (int n = 0; n < 2; ++n) acc[a][b][m][n] = (f32x4){0.f, 0.f, 0.f, 0.f};
        cur = nxt; cA = nA; cB = nB; ++ui;
    }
    PG8_WAIT_V(0);
    if (wr == 0) PG8_BAR;
    PG8_BAR;
    if constexpr (Epi::AFTER_DRAIN) { E.fused(acc, cur, wr, wc, fr, fq, lds, wid, lane); S.done(cur); }
    PG8_STAMP();
    if (STAMP && wid == 0) { stamps[lane] = lane < nts ? (((unsigned long long)(unsigned)ts_hi << 32) | (unsigned)ts_lo) : 0ull;
        if (lane == 62) stamps[62] = rt_entry; if (lane == 63) stamps[63] = (unsigned long long)wall_clock64(); }
#undef PG8_STAMP
#undef PG8_SA
#undef PG8_SB
#undef PG8_STAGE
#undef PG8_LDA
#undef PG8_LDB
#undef PG8_MMA
#undef PG8_WAIT_V
#undef PG8_WAIT_L
#undef PG8_BAR
#undef PG8_SCHED
}
}


struct EpiIn {
    static constexpr bool PERM = true, AFTER_DRAIN = false;
    P p;
    template <int GRP> DI void run(const pg8::f32x4 (&acc)[2][2][4][2], const pg8::Unit& u, int wr, int wc, int fr, int fq) const {
        const int cg0 = (u.pn & 1) * 256 + wc * 32 + fq * 8;
        const int row0 = u.pm * 256 + wr * 64 + fr;
        float oml[2][8];
        if (GRP == 1) {
#pragma unroll
            for (int bj = 0; bj < 2; ++bj) {
                const float* l0 = p.lbl + cg0 + 128 * bj;
#pragma unroll
                for (int j = 0; j < 8; ++j) {
                    float lb = __builtin_amdgcn_rcpf(1.f + __builtin_amdgcn_exp2f((l0[512 + j] - l0[j]) * LOG2E));
                    lb = fminf(fmaxf(lb, 1e-6f), 1.f - 1e-6f);
                    oml[bj][j] = 1.f - lb;
                }
            }
        }
        float rsv[2][4];
#pragma unroll
        for (int ai = 0; ai < 2; ++ai)
#pragma unroll
            for (int m = 0; m < 4; ++m) rsv[ai][m] = p.rs()[row0 + 128 * ai + 16 * m];
#pragma unroll
        for (int ai = 0; ai < 2; ++ai)
#pragma unroll
            for (int m = 0; m < 4; ++m) {
                const int row = row0 + 128 * ai + 16 * m;
                const float rs = rsv[ai][m];
#pragma unroll
                for (int bj = 0; bj < 2; ++bj) {
                    const int cg = cg0 + 128 * bj;
                    float v[8];
#pragma unroll
                    for (int j = 0; j < 8; ++j) v[j] = acc[ai][bj][m][j >> 2][j & 3] * rs;
                    if (GRP == 2) {
                        const int b = row >> 13, t = row & 8191;
                        u16* dst = p.viT() + ((((size_t)(b * 4 + (cg >> 7)) * 128 + (t >> 6)) * 128 + (cg & 127)) * 64) + (t & 63);
#pragma unroll
                        for (int j = 0; j < 8; ++j) dst[j * 64] = f2bf(v[j]);
                    } else if (GRP == 1) {
                        typedef _Float16 h16x8 __attribute__((ext_vector_type(8)));
                        h16x8 hv;
#pragma unroll
                        for (int j = 0; j < 8; ++j) hv[j] = (h16)(__builtin_amdgcn_logf(1.f - oml[bj][j] * __builtin_amdgcn_rcpf(1.f + __builtin_amdgcn_exp2f(v[j] * LOG2E))) * 0.6931471805599453f);
                        *(h16x8*)(p.lf() + ((size_t)((row >> 13) * 4 + (cg >> 7)) * 8192 + (row & 8191)) * 128 + (cg & 127)) = hv;
                    } else {
                        float o[8];
                        if (GRP == 0 || GRP == 3 || GRP == 7) {
#pragma unroll
                            for (int j = 0; j < 8; ++j) o[j] = v[j] * __builtin_amdgcn_rcpf(1.f + __builtin_amdgcn_exp2f(-v[j] * LOG2E));
                        } else if (GRP == 6) {
#pragma unroll
                            for (int j = 0; j < 8; ++j) o[j] = v[j];
                        } else {
                            const float sc = (GRP == 4) ? 0.125f : 1.f;
                            const int f0 = (cg & 63) >> 1, pos = row & 8191;
                            const float4 c4 = *(const float4*)(p.rope() + pos * 32 + f0), s4 = *(const float4*)(p.rope() + SEQ * 32 + pos * 32 + f0);
                            const float cs[4] = {c4.x, c4.y, c4.z, c4.w}, sn[4] = {s4.x, s4.y, s4.z, s4.w};
#pragma unroll
                            for (int i = 0; i < 4; ++i) {
                                o[2 * i] = (v[2 * i] * cs[i] - v[2 * i + 1] * sn[i]) * sc;
                                o[2 * i + 1] = (v[2 * i + 1] * cs[i] + v[2 * i] * sn[i]) * sc;
                            }
                        }
                        const size_t doff = (GRP == 4 || GRP == 5 || GRP == 6) ? ((size_t)((row >> 13) * 8 + (cg >> 6)) * 8192 + (row & 8191)) * 64 + (cg & 63)
                                                                                : ((size_t)((row >> 13) * 4 + (cg >> 7)) * 8192 + (row & 8191)) * 128 + (cg & 127);
                        u16* dst = ((GRP == 0) ? p.hq() : (GRP == 3) ? p.hz() : (GRP == 4) ? p.aq() : (GRP == 5) ? p.ak() : (GRP == 6) ? p.av() : p.az()) + doff;
                        u32x4 pk; pk[0] = pack2(o[0], o[1]); pk[1] = pack2(o[2], o[3]); pk[2] = pack2(o[4], o[5]); pk[3] = pack2(o[6], o[7]);
                        *(u32x4*)dst = pk;
                    }
                }
            }
    }
    DI void operator()(const pg8::f32x4 (&acc)[2][2][4][2], const pg8::Unit& u, int wr, int wc, int fr, int fq) const {
        switch (u.pn >> 1) {
            case 0: run<0>(acc, u, wr, wc, fr, fq); break;
            case 1: run<1>(acc, u, wr, wc, fr, fq); break;
            case 2: run<2>(acc, u, wr, wc, fr, fq); break;
            case 3: run<3>(acc, u, wr, wc, fr, fq); break;
            case 4: run<4>(acc, u, wr, wc, fr, fq); break;
            case 5: run<5>(acc, u, wr, wc, fr, fq); break;
            case 6: run<6>(acc, u, wr, wc, fr, fq); break;
            default: run<7>(acc, u, wr, wc, fr, fq); break;
        }
    }
};

DI void pass1(const P& p, char* smem, int item) {
    int tid = VTID;
    asm volatile("" : "+v"(tid));
    const int lane = tid & 63, wid = tid >> 6, l31 = lane & 31, lh = lane >> 5;
    const int bh = item >> 7, c = item & 127, b = bh >> 2, h = bh & 3;
    const size_t m0 = (size_t)b * 8192 + c * 64;
    float* tot = (float*)smem;
    char* kdT = smem + 1024;
    const int k = tid & 127, half = tid >> 7;
    const h16* lfp = p.lf() + ((size_t)(b * 4 + h) * 8192 + c * 64 + half * 32) * 128 + k;
    float v[32]; float T = 0.f;
#pragma unroll
    for (int i = 0; i < 32; ++i) { v[i] = (float)lfp[(size_t)i * 128]; T += v[i]; }
    tot[half * 128 + k] = T;
    __syncthreads();
    const float other = tot[(half ^ 1) * 128 + k];
    float suf = (half == 0) ? other : 0.f;
    float kd[32];
#pragma unroll
    for (int i = 31; i >= 0; --i) { kd[i] = kfromlf(v[i]) * __expf(suf); suf += v[i]; }
#pragma unroll
    for (int q = 0; q < 4; ++q) {
        u32x4 pk;
        pk[0] = pack2(kd[8 * q + 0], kd[8 * q + 1]); pk[1] = pack2(kd[8 * q + 2], kd[8 * q + 3]);
        pk[2] = pack2(kd[8 * q + 4], kd[8 * q + 5]); pk[3] = pack2(kd[8 * q + 6], kd[8 * q + 7]);
        *(u32x4*)(kdT + k * 144 + half * 64 + q * 16) = pk;
    }
    if (half == 0) p.dec()[(size_t)item * 128 + k] = __expf(T + other);
    __syncthreads();
    const u16* vrow = p.viT() + (((size_t)(b * 4 + h) * 128 + c) * 128 + (wid * 32 + l31)) * 64;
    f32x16 acc[4];
#pragma unroll
    for (int n = 0; n < 4; ++n)
#pragma unroll
        for (int r = 0; r < 16; ++r) acc[n][r] = 0.f;
#pragma unroll
    for (int ks = 0; ks < 4; ++ks) {
        const bf16x8 a = *(const bf16x8*)(vrow + ks * 16 + lh * 8);
#pragma unroll
        for (int nt = 0; nt < 4; ++nt) {
            const bf16x8 bb = *(const bf16x8*)(kdT + (nt * 32 + l31) * 144 + (ks * 16 + lh * 8) * 2);
            acc[nt] = MFMA32(a, bb, acc[nt]);
        }
    }
    u16* so = p.ST() + (size_t)item * 16384;
#pragma unroll
    for (int nt = 0; nt < 4; ++nt)
#pragma unroll
        for (int r = 0; r < 16; ++r) so[(wid * 32 + crow(r, lh)) * 128 + nt * 32 + l31] = f2bf(acc[nt][r]);
    __syncthreads();
}

DI void pass2(const P& p) {
    int tid = VTID;
    asm volatile("" : "+v"(tid));
    for (int e = VB * 256 + tid; e < 65536; e += VGRID * 256) {
        const int bh = e >> 13, rem = e & 8191, k2 = (rem & 63) * 2;
        unsigned* st = (unsigned*)p.ST() + (size_t)bh * 128 * 8192 + rem;
        const float2* dc = (const float2*)(p.dec() + (size_t)bh * 128 * 128 + k2);
        float r0 = 0.f, r1 = 0.f;
        for (int c0 = 0; c0 < 128; c0 += 8) {
            unsigned s[8]; float2 d[8];
#pragma unroll
            for (int j = 0; j < 8; ++j) { s[j] = st[(size_t)(c0 + j) * 8192]; d[j] = dc[(c0 + j) * 64]; }
#pragma unroll
            for (int j = 0; j < 8; ++j) {
                st[(size_t)(c0 + j) * 8192] = pack2(r0, r1);
                r0 = d[j].x * r0 + bflo(s[j]); r1 = d[j].y * r1 + bfhi(s[j]);
            }
        }
    }
}

DI void attn_item(const P& p, char* smem, int item) {
    int tid = VTID;
    asm volatile("" : "+v"(tid));
    const int lane = tid & 63, wid = tid >> 6, l31 = lane & 31, lh = lane >> 5;
    const int pat = item >> 10, idx = item & 1023;
    const int dl = pat * 2, d = 1 << dl, nblk = 64 >> dl;
    const int nb = idx & (nblk - 1);
    int rest = idx >> (6 - dl);
    const int r = rest & (d - 1); rest >>= dl;
    const int hh = rest & 7, b = rest >> 3;
    char* Ks = smem;
    char* VT = smem + 256 * 144;
    const size_t tokbase = ((size_t)b * 8 + hh) * 8192;
    {
        const int c8 = tid & 7, kr = tid >> 3;
#pragma unroll
        for (int i = 0; i < 8; ++i) {
            const int key = kr + 32 * i;
            const int j = nb * 128 - 128 + key;
            if (j >= 0) {
                const size_t off = (tokbase + (size_t)j * d + r) * 64 + c8 * 8;
                const u32x4 kv = *(const u32x4*)(p.ak() + off);
                const u32x4 vv = *(const u32x4*)(p.av() + off);
                *(u32x4*)(Ks + key * 144 + c8 * 16) = kv;
#pragma unroll
                for (int e = 0; e < 4; ++e) {
                    *(u16*)(VT + (c8 * 8 + 2 * e) * 520 + key * 2) = (u16)(vv[e] & 0xffffu);
                    *(u16*)(VT + (c8 * 8 + 2 * e + 1) * 520 + key * 2) = (u16)(vv[e] >> 16);
                }
            }
        }
    }
    const int jq = nb * 128 + wid * 32 + l31;
    const size_t mq = tokbase + (size_t)jq * d + r;
    bf16x8 qf[4];
#pragma unroll
    for (int ks = 0; ks < 4; ++ks) qf[ks] = *(const bf16x8*)(p.aq() + mq * 64 + ks * 16 + lh * 8);
    __syncthreads();
    const int kt_lo = (nb == 0) ? 4 : 0;
    f32x16 st[5];
    float mx = -INFINITY;
#pragma unroll
    for (int i = 0; i < 5; ++i) {
        const int kt = wid + i;
        if (kt >= kt_lo) {
#pragma unroll
            for (int rr = 0; rr < 16; ++rr) st[i][rr] = 0.f;
#pragma unroll
            for (int ks = 0; ks < 4; ++ks) {
                const bf16x8 a = *(const bf16x8*)(Ks + (kt * 32 + l31) * 144 + (ks * 16 + lh * 8) * 2);
                st[i] = MFMA32(a, qf[ks], st[i]);
            }
#pragma unroll
            for (int rr = 0; rr < 16; ++rr) {
                const int dist = wid * 32 + l31 + 128 - (kt * 32 + crow(rr, lh));
                if (dist < 0 || dist > 128) st[i][rr] = -INFINITY;
                mx = fmaxf(mx, st[i][rr]);
            }
        } else {
#pragma unroll
            for (int rr = 0; rr < 16; ++rr) st[i][rr] = -INFINITY;
        }
    }
    mx = fmaxf(mx, __shfl_xor(mx, 32));
    float l = 0.f;
    const float mxs = mx * LOG2E;
#pragma unroll
    for (int i = 0; i < 5; ++i)
#pragma unroll
        for (int rr = 0; rr < 16; ++rr) { const float e = __builtin_amdgcn_exp2f(st[i][rr] * LOG2E - mxs); st[i][rr] = e; l += e; }
    l += __shfl_xor(l, 32);
    f32x16 o[2];
#pragma unroll
    for (int dt = 0; dt < 2; ++dt)
#pragma unroll
        for (int rr = 0; rr < 16; ++rr) o[dt][rr] = 0.f;
#pragma unroll
    for (int i = 0; i < 5; ++i) {
        const int kt = wid + i;
        if (kt >= kt_lo) {
#pragma unroll
            for (int ks2 = 0; ks2 < 2; ++ks2) {
                const bf16x8 bq = packB(st[i], ks2);
#pragma unroll
                for (int dt = 0; dt < 2; ++dt) {
                    const char* ad = VT + (dt * 32 + l31) * 520 + (kt * 32 + ks2 * 16 + lh * 4) * 2;
                    const uint2 lo = *(const uint2*)ad, hi = *(const uint2*)(ad + 16);
                    u32x4 av4; av4[0] = lo.x; av4[1] = lo.y; av4[2] = hi.x; av4[3] = hi.y;
                    o[dt] = MFMA32(__builtin_bit_cast(bf16x8, av4), bq, o[dt]);
                }
            }
        }
    }
    const float inv = 1.f / l;
    u16* op = (pat == 0 ? p.ao0() : (pat == 1 ? p.ao1() : p.ao2())) + mq * 64;
#pragma unroll
    for (int dt = 0; dt < 2; ++dt)
#pragma unroll
        for (int g4 = 0; g4 < 4; ++g4)
            *(uint2*)(op + dt * 32 + g4 * 8 + lh * 4) = make_uint2(pack2(o[dt][g4 * 4] * inv, o[dt][g4 * 4 + 1] * inv), pack2(o[dt][g4 * 4 + 2] * inv, o[dt][g4 * 4 + 3] * inv));
    if (lh == 0) p.lse()[((size_t)pat * NTOK + (size_t)b * 8192 + (size_t)jq * d + r) * 8 + hh] = mx + __logf(l);
    __syncthreads();
}

DI void pass3(const P& p, char* smem, int item) {
    int tid = VTID;
    asm volatile("" : "+v"(tid));
    const int lane = tid & 63, wid = tid >> 6, l31 = lane & 31, lh = lane >> 5;
    const int bh = item >> 7, c = item & 127, b = bh >> 2, h = bh & 3;
    const size_t m0 = (size_t)b * 8192 + c * 64;
    float* tot = (float*)smem;
    float* red = (float*)(smem + 1024);
    char* Qp = smem + 2048;
    char* Qpp = Qp + 64 * 272;
    char* Kp = Qpp + 64 * 272;
    u32x4 ca0[4], ca1[4], ca2[4], caz[4]; float cl0[4], cl1[4], cl2[4];
#pragma unroll
    for (int i = 0; i < 4; ++i) {
        const int e = tid + 256 * i, r = e >> 4, ch = (e & 15) + 16 * h;
        const size_t m = m0 + r; const int hh = ch >> 3;
        const size_t ho = (((size_t)b * 8 + hh) * 8192 + (size_t)c * 64 + r) * 64 + (ch & 7) * 8;
        ca0[i] = *(const u32x4*)(p.ao0() + ho); ca1[i] = *(const u32x4*)(p.ao1() + ho); ca2[i] = *(const u32x4*)(p.ao2() + ho);
        caz[i] = *(const u32x4*)(p.az() + ((size_t)(b * 4 + h) * 8192 + (size_t)c * 64 + r) * 128 + (e & 15) * 8);
        cl0[i] = p.lse()[m * 8 + hh]; cl1[i] = p.lse()[((size_t)NTOK + m) * 8 + hh]; cl2[i] = p.lse()[((size_t)2 * NTOK + m) * 8 + hh];
    }
    {
        const int k = tid & 127, half = tid >> 7;
        const h16* lfp = p.lf() + ((size_t)(b * 4 + h) * 8192 + c * 64 + half * 32) * 128 + k;
        const u16* qp = p.hq() + ((size_t)(b * 4 + h) * 8192 + c * 64 + half * 32) * 128 + k;
        float v[32]; float T = 0.f;
#pragma unroll
        for (int i = 0; i < 32; ++i) { v[i] = (float)lfp[(size_t)i * 128]; T += v[i]; }
        tot[half * 128 + k] = T;
        __syncthreads();
        const float other = tot[(half ^ 1) * 128 + k];
        const float bref = (half == 0) ? T : other;
        const float ebref = __expf(bref);
        const float sub = (half == 0) ? T : 0.f;
        float pre = 0.f;
#pragma unroll
        for (int i = 0; i < 32; ++i) {
            pre += v[i];
            const float xx = pre - sub;
            const float E1 = __builtin_amdgcn_exp2f(xx * LOG2E), Ei = __builtin_amdgcn_exp2f(-xx * LOG2E);
            const float q = bf2f(qp[(size_t)i * 128]);
            const float kk = kfromlf(v[i]);
            const int row = half * 32 + i;
            *(u16*)(Qp + row * 272 + k * 2) = f2bf(q * E1);
            *(u16*)(Qpp + row * 272 + k * 2) = f2bf(q * E1 * ebref);
            *(u16*)(Kp + row * 272 + k * 2) = f2bf(kk * Ei);
        }
    }
    __syncthreads();
    const int tt = wid & 1, vh = wid >> 1;
    f32x16 at[2];
#pragma unroll
    for (int st = 0; st < 2; ++st) {
#pragma unroll
        for (int rr = 0; rr < 16; ++rr) at[st][rr] = 0.f;
        if (st <= tt) {
#pragma unroll
            for (int ks = 0; ks < 8; ++ks) {
                const bf16x8 a = *(const bf16x8*)(Kp + (st * 32 + l31) * 272 + (ks * 16 + lh * 8) * 2);
                const bf16x8 bq = *(const bf16x8*)(Qp + (tt * 32 + l31) * 272 + (ks * 16 + lh * 8) * 2);
                at[st] = MFMA32(a, bq, at[st]);
            }
            if (st == tt) {
#pragma unroll
                for (int rr = 0; rr < 16; ++rr) if (crow(rr, lh) > l31) at[st][rr] = 0.f;
            }
        }
    }
    f32x16 o[2];
#pragma unroll
    for (int vt = 0; vt < 2; ++vt) {
#pragma unroll
        for (int rr = 0; rr < 16; ++rr) o[vt][rr] = 0.f;
        const int vrow = 64 * vh + 32 * vt + l31;
        const u16* srow = p.ST() + (size_t)item * 16384 + vrow * 128;
#pragma unroll
        for (int ks = 0; ks < 8; ++ks) {
            const bf16x8 a = *(const bf16x8*)(srow + ks * 16 + lh * 8);
            const bf16x8 bq = *(const bf16x8*)(Qpp + (tt * 32 + l31) * 272 + (ks * 16 + lh * 8) * 2);
            o[vt] = MFMA32(a, bq, o[vt]);
        }
        const u16* vr = p.viT() + (((size_t)(b * 4 + h) * 128 + c) * 128 + vrow) * 64;
#pragma unroll
        for (int st = 0; st < 2; ++st) {
            if (st <= tt) {
#pragma unroll
                for (int ks2 = 0; ks2 < 2; ++ks2) {
                    const uint2 lo = *(const uint2*)(vr + st * 32 + ks2 * 16 + lh * 4);
                    const uint2 hi = *(const uint2*)(vr + st * 32 + ks2 * 16 + 8 + lh * 4);
                    u32x4 av4; av4[0] = lo.x; av4[1] = lo.y; av4[2] = hi.x; av4[3] = hi.y;
                    o[vt] = MFMA32(__builtin_bit_cast(bf16x8, av4), packB(at[st], ks2), o[vt]);
                }
            }
        }
    }
    float ss = 0.f;
#pragma unroll
    for (int vt = 0; vt < 2; ++vt)
#pragma unroll
        for (int rr = 0; rr < 16; ++rr) ss += o[vt][rr] * o[vt][rr];
    ss += __shfl_xor(ss, 32);
    if (lh == 0) red[vh * 64 + tt * 32 + l31] = ss;
    __syncthreads();
    const float tot2 = red[tt * 32 + l31] + red[64 + tt * 32 + l31];
    const float rinv = rsqrtf(tot2 * (1.f / 128.f) + EPS);
    const size_t m = m0 + tt * 32 + l31;
#pragma unroll
    for (int vt = 0; vt < 2; ++vt)
#pragma unroll
        for (int g4 = 0; g4 < 4; ++g4) {
            const int vb = 64 * vh + 32 * vt + 8 * g4 + 4 * lh;
            const float4 gw = *(const float4*)(p.hgw + h * 128 + vb);
            const uint2 zz = *(const uint2*)(p.hz() + ((size_t)(b * 4 + h) * 8192 + (size_t)c * 64 + tt * 32 + l31) * 128 + vb);
            const float y0 = o[vt][g4 * 4 + 0] * rinv * gw.x * bflo(zz.x);
            const float y1 = o[vt][g4 * 4 + 1] * rinv * gw.y * bfhi(zz.x);
            const float y2 = o[vt][g4 * 4 + 2] * rinv * gw.z * bflo(zz.y);
            const float y3 = o[vt][g4 * 4 + 3] * rinv * gw.w * bfhi(zz.y);
            *(uint2*)(p.mixed() + m * 1024 + h * 128 + vb) = make_uint2(pack2(y0, y1), pack2(y2, y3));
        }
#pragma unroll
    for (int i = 0; i < 4; ++i) {
        const int e = tid + 256 * i, r = e >> 4, ch = (e & 15) + 16 * h;
        const float mx = fmaxf(cl0[i], fmaxf(cl1[i], cl2[i]));
        float w0 = __expf(cl0[i] - mx), w1 = __expf(cl1[i] - mx), w2 = __expf(cl2[i] - mx);
        const float inv = __builtin_amdgcn_rcpf(w0 + w1 + w2);
        w0 *= inv; w1 *= inv; w2 *= inv;
        u32x4 pk;
#pragma unroll
        for (int q = 0; q < 4; ++q) {
            const float y0 = (w0 * bflo(ca0[i][q]) + w1 * bflo(ca1[i][q]) + w2 * bflo(ca2[i][q])) * bflo(caz[i][q]);
            const float y1 = (w0 * bfhi(ca0[i][q]) + w1 * bfhi(ca1[i][q]) + w2 * bfhi(ca2[i][q])) * bfhi(caz[i][q]);
            pk[q] = pack2(y0, y1);
        }
        *(u32x4*)(p.mixed() + (m0 + r) * 1024 + 512 + ch * 8) = pk;
    }
    __syncthreads();
}

struct EpiOut {
    static constexpr bool PERM = false, AFTER_DRAIN = true;
    P p;
    DI void fused(pg8::f32x4 (&acc)[2][2][4][2], const pg8::Unit& u, int wr, int wc, int fr, int fq, PG8_LAS unsigned char* lds, int wid, int lane) const {
        PG8_LAS float* Pt = (PG8_LAS float*)lds;
        PG8_LAS float* Rt = (PG8_LAS float*)(lds + 4096);
        const int tid = threadIdx.x;
        const int rl0 = wr * 64 + fr, c0 = u.pn * 256 + wc * 32 + fq * 4;
#pragma unroll
        for (int ai = 0; ai < 2; ++ai)
#pragma unroll
            for (int m = 0; m < 4; ++m) {
                __builtin_amdgcn_sched_barrier(0);
                const int rl = rl0 + 128 * ai + 16 * m;
                const float* xr = p.x + ((size_t)u.pm * 256 + rl) * 1024 + c0;
                float ss = 0.f;
#pragma unroll
                for (int bj = 0; bj < 2; ++bj)
#pragma unroll
                    for (int n = 0; n < 2; ++n) {
                        const float4 xv = *(const float4*)(xr + 128 * bj + 16 * n);
                        pg8::f32x4& a = acc[ai][bj][m][n];
                        a[0] += xv.x; a[1] += xv.y; a[2] += xv.z; a[3] += xv.w;
                        ss = fmaf(a[0], a[0], ss); ss = fmaf(a[1], a[1], ss); ss = fmaf(a[2], a[2], ss); ss = fmaf(a[3], a[3], ss);
                    }
                ss += __shfl_xor(ss, 16); ss += __shfl_xor(ss, 32);
                if (fq == 0) Pt[rl * 4 + wc] = ss;
            }
        __syncthreads();
        if (tid < 256) (void)__hip_atomic_fetch_add(p.rowss() + u.pm * 256 + tid, (Pt[tid * 4] + Pt[tid * 4 + 1]) + (Pt[tid * 4 + 2] + Pt[tid * 4 + 3]), __ATOMIC_RELAXED, __HIP_MEMORY_SCOPE_AGENT);
        __threadfence();
        __syncthreads();
        if (tid == 0) {
            (void)__hip_atomic_fetch_add(p.pcnt() + u.pm, 1u, __ATOMIC_RELAXED, __HIP_MEMORY_SCOPE_AGENT);
            unsigned sp = 0;
            while (__hip_atomic_load(p.pcnt() + u.pm, __ATOMIC_RELAXED, __HIP_MEMORY_SCOPE_AGENT) < 4u) { __builtin_amdgcn_s_sleep(2); if (++sp > (1u << 22)) break; }
            __builtin_amdgcn_fence(__ATOMIC_ACQUIRE, "agent");
        }
        __syncthreads();
        if (tid < 256) Rt[tid] = rsqrtf(__hip_atomic_load(p.rowss() + u.pm * 256 + tid, __ATOMIC_RELAXED, __HIP_MEMORY_SCOPE_AGENT) * (1.f / 1024.f) + EPS);
        __syncthreads();
#pragma unroll
        for (int ai = 0; ai < 2; ++ai)
#pragma unroll
            for (int m = 0; m < 4; ++m) {
                __builtin_amdgcn_sched_barrier(0);
                const int rl = rl0 + 128 * ai + 16 * m;
                const float rinv = Rt[rl];
                float* orow = p.out + ((size_t)u.pm * 256 + rl) * 1024 + c0;
#pragma unroll
                for (int bj = 0; bj < 2; ++bj)
#pragma unroll
                    for (int n = 0; n < 2; ++n) {
                        const float4 fwv = *(const float4*)(p.fw + c0 + 128 * bj + 16 * n);
                        const pg8::f32x4& a = acc[ai][bj][m][n];
                        *(float4*)(orow + 128 * bj + 16 * n) = make_float4(a[0] * rinv * fwv.x, a[1] * rinv * fwv.y, a[2] * rinv * fwv.z, a[3] * rinv * fwv.w);
                    }
            }
    }
};

constexpr int VSMEM = 4 * 128 * 144;
constexpr int LDS_BYTES = 163840;

__global__ void __launch_bounds__(512, 2) fwd_kernel(P p) {
    extern __shared__ __attribute__((aligned(16))) unsigned char dynlds[];
    volatile unsigned* xbw = (volatile unsigned*)(dynlds + LDS_BYTES - 16);
    if (threadIdx.x < 4) xbw[threadIdx.x] = 0u;
    __syncthreads();
    const XcdBarrier gb = xcd_barrier_post(p.bar(), xbw);
    char* smem = (char*)dynlds + (threadIdx.x >> 8) * VSMEM;
    phase0(p, smem);
    xcd_barrier(gb);
    {
        pg8::Gemm g; g.A = p.xb(); g.Bt = p.winT(); g.M = NTOK; g.N = 4096; g.K = 1024;
        pg8::StaticOrder S; S.init(NTOK, 4096, gridDim.x, blockIdx.x);
        EpiIn E; E.p = p;
        pg8::gemm_phase<EpiIn, pg8::StaticOrder, false>((PG8_LAS unsigned char*)dynlds, g, S, E, nullptr);
    }
    xcd_barrier(gb);
    for (int it = VB; it < 1024; it += VGRID) pass1(p, smem, it);
    xcd_barrier(gb);
    pass2(p);
    if (VGRID == 512) {
        const int bi = VB;
        const int first = (bi < 256) ? bi * 5 : 1280 + (bi - 256) * 7, cnt = (bi < 256) ? 5 : 7;
        for (int i = 0; i < cnt; ++i) attn_item(p, smem, first + i);
    } else {
        for (int it = VB; it < 3072; it += VGRID) attn_item(p, smem, it);
    }
    xcd_barrier(gb);
    for (int it = VB; it < 1024; it += VGRID) pass3(p, smem, it);
    xcd_barrier(gb);
    {
        pg8::Gemm g; g.A = p.mixed(); g.Bt = p.woutT(); g.M = NTOK; g.N = 1024; g.K = 1024;
        pg8::StaticOrder S; S.init(NTOK, 1024, gridDim.x, blockIdx.x);
        EpiOut E; E.p = p;
        pg8::gemm_phase<EpiOut, pg8::StaticOrder, false>((PG8_LAS unsigned char*)dynlds, g, S, E, nullptr);
    }
}

extern "C" void kernel_launch(void* const* d_in, const int* in_sizes, int n_in, void* d_out, int out_size, void* d_ws, size_t ws_size, hipStream_t stream) {
    static int grid_blocks = 0;
    if (!grid_blocks) {
        int per_cu = 0;
        (void)hipFuncSetAttribute((const void*)fwd_kernel, hipFuncAttributeMaxDynamicSharedMemorySize, LDS_BYTES);
        (void)hipOccupancyMaxActiveBlocksPerMultiprocessor(&per_cu, fwd_kernel, 512, LDS_BYTES);
        grid_blocks = 256;
    }
    char* ws = (char*)d_ws;
    P p{};
    p.x = (const float*)d_in[0]; p.norm_w = (const float*)d_in[1]; p.w_in = (const float*)d_in[2]; p.lbl = (const float*)d_in[3];
    p.hgw = (const float*)d_in[4]; p.w_out = (const float*)d_in[5]; p.fw = (const float*)d_in[6];
    p.out = (float*)d_out;
    p.ws = ws;
    (void)hipMemsetAsync(ws + OFF_BAR, 0, OFF_END - OFF_BAR, stream);
    void* args[] = {&p};
    hipError_t e = hipLaunchCooperativeKernel((void*)fwd_kernel, dim3(grid_blocks), dim3(512), args, LDS_BYTES, stream);
    if (e != hipSuccess) fprintf(stderr, "cooperative launch failed: %s (grid %d)\n", hipGetErrorString(e), grid_blocks);
}
```

```cpp
#include <hip/hip_runtime.h>
#include <cstdio>

typedef short bf16x8 __attribute__((ext_vector_type(8)));
typedef float f32x16 __attribute__((ext_vector_type(16)));
typedef __bf16 bf2_t __attribute__((ext_vector_type(2)));
typedef float f2_t __attribute__((ext_vector_type(2)));
typedef unsigned u32x4 __attribute__((ext_vector_type(4)));
typedef unsigned short u16;
typedef _Float16 h16;
typedef _Float16 h16x4 __attribute__((ext_vector_type(4)));

#define DI __device__ __forceinline__
#define VTID ((int)(threadIdx.x & 255u))
#define VB ((int)(blockIdx.x * 2u + (threadIdx.x >> 8)))
#define VGRID ((int)(gridDim.x * 2u))
#define MFMA32(a, b, c) __builtin_amdgcn_mfma_f32_32x32x16_bf16((a), (b), (c), 0, 0, 0)

constexpr int NTOK = 16384, DM = 1024, SEQ = 8192;
constexpr float EPS = 1e-6f;
constexpr float LOG2E = 1.4426950408889634f;

constexpr size_t MB = 1024 * 1024;
constexpr size_t OFF_XB = 0;
constexpr size_t OFF_RS = OFF_XB + 32 * MB;
constexpr size_t OFF_WINT = OFF_RS + 65536;
constexpr size_t OFF_WOUTT = OFF_WINT + 8 * MB;
constexpr size_t OFF_ROPE = OFF_WOUTT + 2 * MB;
constexpr size_t OFF_HQ = OFF_ROPE + 2 * MB;
constexpr size_t OFF_LF = OFF_HQ + 16 * MB;
constexpr size_t OFF_VIT = OFF_LF + 32 * MB;
constexpr size_t OFF_HZ = OFF_VIT + 16 * MB;
constexpr size_t OFF_AQ = OFF_HZ + 16 * MB;
constexpr size_t OFF_AK = OFF_AQ + 16 * MB;
constexpr size_t OFF_AV = OFF_AK + 16 * MB;
constexpr size_t OFF_AZ = OFF_AV + 16 * MB;
constexpr size_t OFF_ST = OFF_AZ + 16 * MB;
constexpr size_t OFF_DEC = OFF_ST + 32 * MB;
constexpr size_t OFF_AO2 = OFF_DEC + 512 * 1024;
constexpr size_t OFF_LSE = OFF_AO2 + 16 * MB;
constexpr size_t OFF_BAR = OFF_LSE + 3 * 16384 * 8 * 4;
constexpr size_t OFF_ROWSS = OFF_BAR + 16384;
constexpr size_t OFF_PCNT = OFF_ROWSS + 65536;
constexpr size_t OFF_END = OFF_PCNT + 1024;

struct P {
    const float* x; const float* norm_w; const float* w_in; const float* lbl; const float* hgw; const float* w_out; const float* fw;
    float* out; char* ws;
    DI u16* xb() const { return (u16*)(ws + OFF_XB); }
    DI float* rs() const { return (float*)(ws + OFF_RS); }
    DI u16* winT() const { return (u16*)(ws + OFF_WINT); }
    DI u16* woutT() const { return (u16*)(ws + OFF_WOUTT); }
    DI float* rope() const { return (float*)(ws + OFF_ROPE); }
    DI u16* hq() const { return (u16*)(ws + OFF_HQ); }
    DI h16* lf() const { return (h16*)(ws + OFF_LF); }
    DI u16* viT() const { return (u16*)(ws + OFF_VIT); }
    DI u16* hz() const { return (u16*)(ws + OFF_HZ); }
    DI u16* aq() const { return (u16*)(ws + OFF_AQ); }
    DI u16* ak() const { return (u16*)(ws + OFF_AK); }
    DI u16* av() const { return (u16*)(ws + OFF_AV); }
    DI u16* az() const { return (u16*)(ws + OFF_AZ); }
    DI u16* ST() const { return (u16*)(ws + OFF_ST); }
    DI float* dec() const { return (float*)(ws + OFF_DEC); }
    DI u16* ao0() const { return (u16*)(ws + OFF_XB); }
    DI u16* ao1() const { return (u16*)(ws + OFF_XB + 16 * MB); }
    DI u16* ao2() const { return (u16*)(ws + OFF_AO2); }
    DI float* lse() const { return (float*)(ws + OFF_LSE); }
    DI u16* mixed() const { return (u16*)(ws + OFF_AQ); }
    DI float* rowss() const { return (float*)(ws + OFF_ROWSS); }
    DI unsigned* pcnt() const { return (unsigned*)(ws + OFF_PCNT); }
    DI unsigned* bar() const { return (unsigned*)(ws + OFF_BAR); }
};

DI unsigned pack2(float a, float b) { f2_t v = {a, b}; return __builtin_bit_cast(unsigned, __builtin_convertvector(v, bf2_t)); }
DI u16 f2bf(float x) { return (u16)(pack2(x, 0.f) & 0xffffu); }
DI float bf2f(u16 v) { return __uint_as_float(((unsigned)v) << 16); }
DI float bflo(unsigned v) { return __uint_as_float(v << 16); }
DI float bfhi(unsigned v) { return __uint_as_float(v & 0xffff0000u); }
DI int crow(int reg, int h) { return (reg & 3) + 8 * (reg >> 2) + 4 * h; }
DI float silu(float v) { return v / (1.f + __expf(-v)); }
DI bf16x8 packB(const f32x16& x, int s) {
    u32x4 pk;
    pk[0] = pack2(x[8 * s + 0], x[8 * s + 1]); pk[1] = pack2(x[8 * s + 2], x[8 * s + 3]);
    pk[2] = pack2(x[8 * s + 4], x[8 * s + 5]); pk[3] = pack2(x[8 * s + 6], x[8 * s + 7]);
    return __builtin_bit_cast(bf16x8, pk);
}
DI float kfromlf(float v) { return (v > -0.02f) ? -v * (1.f + v * (0.5f + v * (1.f / 6.f))) : 1.f - __expf(v); }


#define XB_TMO      128
#define XB_XCNT(j)  (256  + 64 * (j))
#define XB_XSUB(j)  (1280 + 64 * (j))
#define XB_XGEN(j)  (2304 + 64 * (j))
#define XB_TOP      3328
#define XB_TOPGEN   3392
#define XCD_BAR_WORDS 3456
#define XB_SPIN_CAP (1u << 22)
#define LAS __attribute__((address_space(3)))
DI unsigned xb_ld(unsigned* p) { return __hip_atomic_load(p, __ATOMIC_RELAXED, __HIP_MEMORY_SCOPE_AGENT); }
DI unsigned xb_add(unsigned* p, unsigned v) { return __hip_atomic_fetch_add(p, v, __ATOMIC_RELAXED, __HIP_MEMORY_SCOPE_AGENT); }
DI unsigned xb_xcc_id() { return (unsigned)__builtin_amdgcn_s_getreg((3 << 11) | 20) & 0xFu; }
#define XB_SPIN(cond, bar) do { unsigned _sp = 0; while (cond) { __builtin_amdgcn_s_sleep(1); \
    if ((++_sp & 255u) == 0u) { if (xb_ld(&(bar)[XB_TMO])) break; if (_sp > XB_SPIN_CAP) { atomicAdd(&(bar)[XB_TMO], 1u); break; } } } } while (0)
struct XcdBarrier { unsigned* bar; unsigned x; volatile unsigned* st; };
DI XcdBarrier xcd_barrier_post(unsigned* bar, volatile unsigned* st) {
    XcdBarrier b; b.bar = bar; b.x = xb_xcc_id(); b.st = st;
    if (threadIdx.x == 0) (void)xb_add(&bar[XB_XCNT(b.x)], 1u);
    return b;
}
DI void xcd_barrier_complete(unsigned* bar, unsigned x, unsigned& nloc, unsigned& nx) {
    const unsigned G = gridDim.x * gridDim.y * gridDim.z;
    unsigned sum, cnt, mine, sp = 0u;
    for (;;) {
        sum = 0u; cnt = 0u; mine = 0u;
#pragma unroll
        for (unsigned j = 0; j < 16; ++j) { const unsigned c = xb_ld(&bar[XB_XCNT(j)]); sum += c; cnt += (c > 0u) ? 1u : 0u; mine = (j == x) ? c : mine; }
        if (sum == G) break;
        __builtin_amdgcn_s_sleep(1);
        if ((++sp & 255u) == 0u) { if (xb_ld(&bar[XB_TMO])) break; if (sp > XB_SPIN_CAP) { atomicAdd(&bar[XB_TMO], 1u); break; } }
    }
    nloc = mine > 0u ? mine : 1u; nx = cnt > 0u ? cnt : 1u;
}
DI void xcd_barrier(const XcdBarrier& b) {
    asm volatile("s_waitcnt vmcnt(0)" ::: "memory");
    __syncthreads();
    if (threadIdx.x == 0) {
        unsigned* bar = b.bar;
        __builtin_amdgcn_s_waitcnt(0);
        unsigned nloc = b.st[0], nx = b.st[1];
        if (nloc == 0u) { xcd_barrier_complete(bar, b.x, nloc, nx); b.st[0] = nloc; b.st[1] = nx; }
        const unsigned old = xb_add(&bar[XB_XSUB(b.x)], 1u);
        const unsigned gen = old / nloc;
        if (old + 1u == (gen + 1u) * nloc) {
            __builtin_amdgcn_fence(__ATOMIC_RELEASE, "agent");
            asm volatile("s_waitcnt vmcnt(0)" ::: "memory");
            const unsigned og = xb_add(&bar[XB_TOP], 1u);
            const unsigned tg = og / nx;
            if (og + 1u == (tg + 1u) * nx) xb_add(&bar[XB_TOPGEN], 1u);
            else XB_SPIN(xb_ld(&bar[XB_TOPGEN]) == tg, bar);
            __builtin_amdgcn_fence(__ATOMIC_ACQUIRE, "agent");
            xb_add(&bar[XB_XGEN(b.x)], 1u);
            asm volatile("s_waitcnt vmcnt(0)" ::: "memory");
        } else {
            XB_SPIN(xb_ld(&bar[XB_XGEN(b.x)]) == gen, bar);
            __builtin_amdgcn_fence(__ATOMIC_ACQUIRE, "agent");
            asm volatile("s_waitcnt vmcnt(0)" ::: "memory");
        }
    }
    __syncthreads();
}

DI void phase0(const P& p, char* smem) {
    int tid = VTID;
    asm volatile("" : "+v"(tid));
    const int lane = tid & 63, wid = tid >> 6;
    for (int row = VB * 4 + wid; row < NTOK; row += VGRID * 4) {
        const float4* xr = (const float4*)(p.x + (size_t)row * DM);
        float4 v[4]; float ss = 0.f;
#pragma unroll
        for (int i = 0; i < 4; ++i) { typedef float f4v __attribute__((ext_vector_type(4))); const f4v t4 = __builtin_nontemporal_load((const f4v*)(xr + lane + 64 * i)); v[i] = make_float4(t4[0], t4[1], t4[2], t4[3]); ss += v[i].x * v[i].x + v[i].y * v[i].y + v[i].z * v[i].z + v[i].w * v[i].w; }
#pragma unroll
        for (int o = 32; o >= 1; o >>= 1) ss += __shfl_xor(ss, o);
        uint2* xo = (uint2*)(p.xb() + (size_t)row * DM);
#pragma unroll
        for (int i = 0; i < 4; ++i) xo[lane + 64 * i] = make_uint2(pack2(v[i].x, v[i].y), pack2(v[i].z, v[i].w));
        if (lane == 0) p.rs()[row] = rsqrtf(ss * (1.f / 1024.f) + EPS);
    }
    float* tile = (float*)smem;
    for (int t = VB; t < 1024 + 256; t += VGRID) {
        const float* src; u16* dst; int ncols, td, tc; bool scale;
        if (t < 1024) { src = p.w_in; dst = p.winT(); ncols = 4096; td = t >> 6; tc = t & 63; scale = true; }
        else { const int t2 = t - 1024; src = p.w_out; dst = p.woutT(); ncols = 1024; td = t2 >> 4; tc = t2 & 15; scale = false; }
#pragma unroll
        for (int i = 0; i < 4; ++i) {
            const int r = (tid >> 4) + 16 * i, c4 = (tid & 15) * 4;
            float4 v = *(const float4*)(src + (size_t)(td * 64 + r) * ncols + tc * 64 + c4);
            const float s = scale ? p.norm_w[td * 64 + r] : 1.f;
            tile[r * 65 + c4 + 0] = v.x * s; tile[r * 65 + c4 + 1] = v.y * s; tile[r * 65 + c4 + 2] = v.z * s; tile[r * 65 + c4 + 3] = v.w * s;
        }
        __syncthreads();
#pragma unroll
        for (int u = 0; u < 2; ++u) {
            const int g = (tid & 3) + 4 * u, c = tid >> 2;
            float e[8];
#pragma unroll
            for (int j = 0; j < 8; ++j) e[j] = tile[(g * 8 + j) * 65 + c];
            u32x4 pk; pk[0] = pack2(e[0], e[1]); pk[1] = pack2(e[2], e[3]); pk[2] = pack2(e[4], e[5]); pk[3] = pack2(e[6], e[7]);
            int orow = tc * 64 + c;
            if (scale && orow >= 2048 && orow < 3072) { const int d = orow & 63; orow = (orow & ~63) + ((d & 31) << 1) + (d >> 5); }
            *(u32x4*)(dst + (size_t)orow * 1024 + td * 64 + g * 8) = pk;
        }
        __syncthreads();
    }
    for (int idx = VB * 256 + tid; idx < SEQ * 32; idx += VGRID * 256) {
        const int pos = idx >> 5, j = idx & 31;
        const float inv = (float)(1.0 / exp2((double)j * (13.287712379549449 / 32.0)));
        const float ang = (float)pos * inv;
        const double rev = (double)ang * 0.15915494309189535;
        const float fr = (float)(rev - floor(rev));
        p.rope()[idx] = __builtin_amdgcn_cosf(fr);
        p.rope()[SEQ * 32 + idx] = __builtin_amdgcn_sinf(fr);
    }
}

namespace pg8 {
#define PG8_LAS __attribute__((address_space(3)))
typedef unsigned short bf16_t;
typedef short bf16x8 __attribute__((ext_vector_type(8)));
typedef float f32x4 __attribute__((ext_vector_type(4)));
typedef unsigned u32x4 __attribute__((ext_vector_type(4)));
constexpr int BM = 256, BK = 64, HALF = 128, HTB = HALF * BK * 2  , STAGE_BYTES = 8 * HTB, NXCD = 8, WGM = 8;

__host__ __device__ __forceinline__ int lds_byte(int r, int c) { const int st = (r >> 4) * 2 + (c >> 5), rr = r & 15, cc = c & 31, ob = rr * 64 + cc * 2; return st * 1024 + (ob ^ (((ob >> 9) & 1) << 5)); }
__host__ __device__ __forceinline__ void stage_rc(int b, int& R, int& C) { const int st = b / 1024, sb = b % 1024, swz = sb ^ (((sb >> 9) & 1) << 5); R = (st >> 1) * 16 + swz / 64; C = (st & 1) * 32 + (swz % 64) / 2; }
__host__ __device__ __forceinline__ int perm32(int rho) { const int n = rho >> 4, i = rho & 15; return 8 * (i >> 2) + 4 * n + (i & 3); }

struct Unit { int pm, pn; };
struct Gemm { const bf16_t* A; const bf16_t* Bt; int M, N, K; };

struct StaticOrder {
    int nM, nN, nwg, G, c;
    __host__ __device__ void init(int M, int N, int G_, int c_) { nM = M / BM; nN = N / BM; nwg = nM * nN; G = G_; c = c_; }
    __host__ __device__ bool next(int i, Unit& u) const {
        const long L = (long)i * G + c; if (L >= nwg) return false;
        int wgid = (int)L; { const int q = nwg / NXCD, r = nwg % NXCD, xcd = wgid % NXCD, off = wgid / NXCD; wgid = (xcd < r ? xcd * (q + 1) : r * (q + 1) + (xcd - r) * q) + off; }
        const int nig = WGM * nN, gid = wgid / nig, fm = gid * WGM, gsz = (nM - fm) < WGM ? (nM - fm) : WGM;
        u.pm = fm + ((wgid % nig) % gsz); u.pn = (wgid % nig) / gsz; return true;
    }
    __device__ __forceinline__ void a_ready(const Unit&) const {}
    __device__ __forceinline__ void done(const Unit&) const {}
};
template <class Epi, class Sched, bool STAMP = false>
__device__ __forceinline__ void gemm_phase(PG8_LAS unsigned char* lds, const Gemm g, const Sched& S, const Epi& E, unsigned long long* stamps) {
    const int tid = threadIdx.x, wid = __builtin_amdgcn_readfirstlane(tid >> 6), lane = tid & 63, wr = wid >> 2, wc = wid & 3, fr = lane & 15, fq = lane >> 4;
    const int K = g.K, nt = K / BK;
    int ts_lo = 0, ts_hi = 0, nts = 0; const unsigned long long rt_entry = STAMP ? (unsigned long long)wall_clock64() : 0ull;
#define PG8_STAMP() do { if (STAMP && wid == 0 && nts < 64) { const unsigned long long _c = (unsigned long long)clock64(); \
        ts_lo = (lane == nts) ? (int)(unsigned)_c : ts_lo; ts_hi = (lane == nts) ? (int)(unsigned)(_c >> 32) : ts_hi; ++nts; } } while (0)
    PG8_STAMP();
    unsigned voffA[2], voffB[2];
#pragma unroll
    for (int i = 0; i < 2; ++i) { int R, C; stage_rc(tid * 16 + i * 8192, R, C); const int Rb = Epi::PERM ? ((R & ~31) + perm32(R & 31)) : R;
        voffA[i] = (unsigned)(R * K + C) * 2u; voffB[i] = (unsigned)(Rb * K + C) * 2u; }
    const size_t kstep = (size_t)(BK * 2);
    const size_t hstep = (size_t)HALF * K * 2;
    const size_t tstep = 2 * hstep;
    const unsigned ldsw = (unsigned)wid * 1024u;
    const int aoff = lds_byte(wr * 64 + fr, fq * 8), boff = lds_byte(wc * 32 + fr, fq * 8);
#define PG8_SA(b, h) (((b) * 2 + (h)) * HTB)
#define PG8_SB(b, h) ((4 + (b) * 2 + (h)) * HTB)
#define PG8_STAGE(bufoff, gbase, voff) do { _Pragma("unroll") for (int _i = 0; _i < 2; ++_i) \
        __builtin_amdgcn_global_load_lds((const unsigned*)((const char*)(gbase) + (voff)[_i]), (PG8_LAS unsigned*)(lds + (bufoff) + ldsw + _i * 8192), 16, 0, 0); } while (0)
#define PG8_LDA(dst, b, h) do { _Pragma("unroll") for (int m = 0; m < 4; ++m) _Pragma("unroll") for (int k = 0; k < 2; ++k) dst[m][k] = *(const PG8_LAS bf16x8*)(lds + PG8_SA(b, h) + aoff + m * 2048 + k * 1024); } while (0)
#define PG8_LDB(dst, b, h) do { _Pragma("unroll") for (int n = 0; n < 2; ++n) _Pragma("unroll") for (int k = 0; k < 2; ++k) dst[n][k] = *(const PG8_LAS bf16x8*)(lds + PG8_SB(b, h) + boff + n * 2048 + k * 1024); } while (0)
#define PG8_MMA(ai, bj, At, Bt) do { __builtin_amdgcn_s_setprio(1); _Pragma("unroll") for (int m = 0; m < 4; ++m) _Pragma("unroll") for (int n = 0; n < 2; ++n) _Pragma("unroll") for (int k = 0; k < 2; ++k) \
        acc[ai][bj][m][n] = __builtin_amdgcn_mfma_f32_16x16x32_bf16(Bt[n][k], At[m][k], acc[ai][bj][m][n], 0, 0, 0); __builtin_amdgcn_s_setprio(0); } while (0)
#define PG8_WAIT_V(n) asm volatile("s_waitcnt vmcnt(" #n ")" ::: "memory")
#define PG8_WAIT_L(n) asm volatile("s_waitcnt lgkmcnt(" #n ")" ::: "memory")
#define PG8_BAR __builtin_amdgcn_s_barrier()
#define PG8_SCHED __builtin_amdgcn_sched_barrier(0)
    Unit cur, nxt; int ui = 0;
    if (!S.next(0, cur)) return;
    f32x4 acc[2][2][4][2];
#pragma unroll
    for (int a = 0; a < 2; ++a)
#pragma unroll
        for (int b = 0; b < 2; ++b)
#pragma unroll
            for (int m = 0; m < 4; ++m)
#pragma unroll
                for (int n = 0; n < 2; ++n) acc[a][b][m][n] = (f32x4){0.f, 0.f, 0.f, 0.f};
    bf16x8 At[4][2], B0[2][2], B1[2][2];
    const char* cA = (const char*)g.A + (size_t)cur.pm * tstep; const char* cB = (const char*)g.Bt + (size_t)cur.pn * tstep;
    S.a_ready(cur);
    PG8_STAGE(PG8_SB(0, 0), cB, voffB); PG8_STAGE(PG8_SA(0, 0), cA, voffA); PG8_STAGE(PG8_SB(0, 1), cB + hstep, voffB); PG8_STAGE(PG8_SA(0, 1), cA + hstep, voffA);
    if (wr == 1) PG8_BAR;
    PG8_WAIT_V(4); PG8_BAR;
    PG8_STAGE(PG8_SB(1, 0), cB + kstep, voffB); PG8_STAGE(PG8_SA(1, 0), cA + kstep, voffA); PG8_STAGE(PG8_SB(1, 1), cB + hstep + kstep, voffB);
    PG8_WAIT_V(6); PG8_BAR;
    PG8_STAMP();
    for (;;) {
        const bool has_next = S.next(ui + 1, nxt);
        const char* nA = has_next ? (const char*)g.A + (size_t)nxt.pm * tstep : cA; const char* nB = has_next ? (const char*)g.Bt + (size_t)nxt.pn * tstep : cB;
        for (int t = 0; t < nt; t += 2) {
            const bool last = (t == nt - 2);
            const char* a1 = cA + (size_t)(t + 1) * kstep;
            const char* a2 = last ? nA : cA + (size_t)(t + 2) * kstep; const char* b2 = last ? nB : cB + (size_t)(t + 2) * kstep;
            const char* a3 = a2 + kstep; const char* b3 = b2 + kstep;
            if (last && has_next) S.a_ready(nxt);
            PG8_LDB(B0, 0, 0); PG8_SCHED; PG8_LDA(At, 0, 0); PG8_STAGE(PG8_SA(1, 1), a1 + hstep, voffA);
            PG8_WAIT_L(8); PG8_BAR; PG8_WAIT_L(0); PG8_MMA(0, 0, At, B0); PG8_BAR; PG8_SCHED;
            PG8_LDB(B1, 0, 1); PG8_STAGE(PG8_SB(0, 0), b2, voffB);
            PG8_BAR; PG8_WAIT_L(0); PG8_MMA(0, 1, At, B1); PG8_BAR;
            PG8_LDA(At, 0, 1); PG8_STAGE(PG8_SA(0, 0), a2, voffA);
            PG8_BAR; PG8_WAIT_L(0); PG8_MMA(1, 0, At, B0); PG8_BAR; PG8_SCHED;
            PG8_STAGE(PG8_SB(0, 1), b2 + hstep, voffB);
            PG8_WAIT_V(6); PG8_BAR; PG8_MMA(1, 1, At, B1); PG8_BAR;
            PG8_LDB(B0, 1, 0); PG8_SCHED; PG8_LDA(At, 1, 0); PG8_STAGE(PG8_SA(0, 1), a2 + hstep, voffA);
            PG8_WAIT_L(8); PG8_BAR; PG8_WAIT_L(0); PG8_MMA(0, 0, At, B0); PG8_BAR; PG8_SCHED;
            PG8_LDB(B1, 1, 1); PG8_STAGE(PG8_SB(1, 0), b3, voffB);
            PG8_BAR; PG8_WAIT_L(0); PG8_MMA(0, 1, At, B1); PG8_BAR;
            PG8_LDA(At, 1, 1); PG8_STAGE(PG8_SA(1, 0), a3, voffA);
            PG8_BAR; PG8_WAIT_L(0); PG8_MMA(1, 0, At, B0); PG8_BAR; PG8_SCHED;
            PG8_STAGE(PG8_SB(1, 1), b3 + hstep, voffB);
            PG8_WAIT_V(6); PG8_BAR; PG8_MMA(1, 1, At, B1); PG8_BAR;
        }
        PG8_STAMP();
        if constexpr (!Epi::AFTER_DRAIN) { E(acc, cur, wr, wc, fr, fq); S.done(cur); }
        PG8_STAMP();
        if (!has_next) break;
#pragma unroll
        for (int a = 0; a < 2; ++a)
#pragma unroll
            for (int b = 0; b < 2; ++b)
#pragma unroll
                for (int m = 0; m < 4; ++m)
#pragma unroll
                    for (int n = 0; n < 2; ++n) acc[a][b][m][n] = (f32x4){0.f, 0.f, 0.f, 0.f};
        cur = nxt; cA = nA; cB = nB; ++ui;
    }
    PG8_WAIT_V(0);
    if (wr == 0) PG8_BAR;
    PG8_BAR;
    if constexpr (Epi::AFTER_DRAIN) { E.fused(acc, cur, wr, wc, fr, fq, lds, wid, lane); S.done(cur); }
    PG8_STAMP();
    if (STAMP && wid == 0) { stamps[lane] = lane < nts ? (((unsigned long long)(unsigned)ts_hi << 32) | (unsigned)ts_lo) : 0ull;
        if (lane == 62) stamps[62] = rt_entry; if (lane == 63) stamps[63] = (unsigned long long)wall_clock64(); }
#undef PG8_STAMP
#undef PG8_SA
#undef PG8_SB
#undef PG8_STAGE
#undef PG8_LDA
#undef PG8_LDB
#undef PG8_MMA
#undef PG8_WAIT_V
#undef PG8_WAIT_L
#undef PG8_BAR
#undef PG8_SCHED
}
}


struct EpiIn {
    static constexpr bool PERM = true, AFTER_DRAIN = false;
    P p;
    template <int GRP> DI void run(const pg8::f32x4 (&acc)[2][2][4][2], const pg8::Unit& u, int wr, int wc, int fr, int fq) const {
        const int cg0 = (u.pn & 1) * 256 + wc * 32 + fq * 8;
        const int row0 = u.pm * 256 + wr * 64 + fr;
        float oml[2][8];
        if (GRP == 1) {
#pragma unroll
            for (int bj = 0; bj < 2; ++bj) {
                const float* l0 = p.lbl + cg0 + 128 * bj;
#pragma unroll
                for (int j = 0; j < 8; ++j) {
                    float lb = __builtin_amdgcn_rcpf(1.f + __builtin_amdgcn_exp2f((l0[512 + j] - l0[j]) * LOG2E));
                    lb = fminf(fmaxf(lb, 1e-6f), 1.f - 1e-6f);
                    oml[bj][j] = 1.f - lb;
                }
            }
        }
        float rsv[2][4];
#pragma unroll
        for (int ai = 0; ai < 2; ++ai)
#pragma unroll
            for (int m = 0; m < 4; ++m) rsv[ai][m] = p.rs()[row0 + 128 * ai + 16 * m];
#pragma unroll
        for (int ai = 0; ai < 2; ++ai)
#pragma unroll
            for (int m = 0; m < 4; ++m) {
                const int row = row0 + 128 * ai + 16 * m;
                const float rs = rsv[ai][m];
#pragma unroll
                for (int bj = 0; bj < 2; ++bj) {
                    const int cg = cg0 + 128 * bj;
                    float v[8];
#pragma unroll
                    for (int j = 0; j < 8; ++j) v[j] = acc[ai][bj][m][j >> 2][j & 3] * rs;
                    if (GRP == 2) {
                        const int b = row >> 13, t = row & 8191;
                        u16* dst = p.viT() + ((size_t)(b * 512 + cg)) * 8192 + t;
#pragma unroll
                        for (int j = 0; j < 8; ++j) dst[(size_t)j * 8192] = f2bf(v[j]);
                    } else if (GRP == 1) {
                        typedef _Float16 h16x8 __attribute__((ext_vector_type(8)));
                        h16x8 hv;
#pragma unroll
                        for (int j = 0; j < 8; ++j) hv[j] = (h16)(__builtin_amdgcn_logf(1.f - oml[bj][j] * __builtin_amdgcn_rcpf(1.f + __builtin_amdgcn_exp2f(v[j] * LOG2E))) * 0.6931471805599453f);
                        *(h16x8*)(p.lf() + ((size_t)((row >> 13) * 4 + (cg >> 7)) * 8192 + (row & 8191)) * 128 + (cg & 127)) = hv;
                    } else {
                        float o[8];
                        if (GRP == 0 || GRP == 3 || GRP == 7) {
#pragma unroll
                            for (int j = 0; j < 8; ++j) o[j] = v[j] * __builtin_amdgcn_rcpf(1.f + __builtin_amdgcn_exp2f(-v[j] * LOG2E));
                        } else if (GRP == 6) {
#pragma unroll
                            for (int j = 0; j < 8; ++j) o[j] = v[j];
                        } else {
                            const float sc = (GRP == 4) ? 0.125f : 1.f;
                            const int f0 = (cg & 63) >> 1, pos = row & 8191;
                            const float4 c4 = *(const float4*)(p.rope() + pos * 32 + f0), s4 = *(const float4*)(p.rope() + SEQ * 32 + pos * 32 + f0);
                            const float cs[4] = {c4.x, c4.y, c4.z, c4.w}, sn[4] = {s4.x, s4.y, s4.z, s4.w};
#pragma unroll
                            for (int i = 0; i < 4; ++i) {
                                o[2 * i] = (v[2 * i] * cs[i] - v[2 * i + 1] * sn[i]) * sc;
                                o[2 * i + 1] = (v[2 * i + 1] * cs[i] + v[2 * i] * sn[i]) * sc;
                            }
                        }
                        const size_t doff = (GRP == 4 || GRP == 5 || GRP == 6) ? ((size_t)((row >> 13) * 8 + (cg >> 6)) * 8192 + (row & 8191)) * 64 + (cg & 63)
                                                                                : ((size_t)((row >> 13) * 4 + (cg >> 7)) * 8192 + (row & 8191)) * 128 + (cg & 127);
                        u16* dst = ((GRP == 0) ? p.hq() : (GRP == 3) ? p.hz() : (GRP == 4) ? p.aq() : (GRP == 5) ? p.ak() : (GRP == 6) ? p.av() : p.az()) + doff;
                        u32x4 pk; pk[0] = pack2(o[0], o[1]); pk[1] = pack2(o[2], o[3]); pk[2] = pack2(o[4], o[5]); pk[3] = pack2(o[6], o[7]);
                        *(u32x4*)dst = pk;
                    }
                }
            }
    }
    DI void operator()(const pg8::f32x4 (&acc)[2][2][4][2], const pg8::Unit& u, int wr, int wc, int fr, int fq) const {
        switch (u.pn >> 1) {
            case 0: run<0>(acc, u, wr, wc, fr, fq); break;
            case 1: run<1>(acc, u, wr, wc, fr, fq); break;
            case 2: run<2>(acc, u, wr, wc, fr, fq); break;
            case 3: run<3>(acc, u, wr, wc, fr, fq); break;
            case 4: run<4>(acc, u, wr, wc, fr, fq); break;
            case 5: run<5>(acc, u, wr, wc, fr, fq); break;
            case 6: run<6>(acc, u, wr, wc, fr, fq); break;
            default: run<7>(acc, u, wr, wc, fr, fq); break;
        }
    }
};

DI void pass1(const P& p, char* smem, int item) {
    int tid = VTID;
    asm volatile("" : "+v"(tid));
    const int lane = tid & 63, wid = tid >> 6, l31 = lane & 31, lh = lane >> 5;
    const int bh = item >> 7, c = item & 127, b = bh >> 2, h = bh & 3;
    const size_t m0 = (size_t)b * 8192 + c * 64;
    float* tot = (float*)smem;
    char* kdT = smem + 1024;
    const int k = tid & 127, half = tid >> 7;
    const h16* lfp = p.lf() + ((size_t)(b * 4 + h) * 8192 + c * 64 + half * 32) * 128 + k;
    float v[32]; float T = 0.f;
#pragma unroll
    for (int i = 0; i < 32; ++i) { v[i] = (float)lfp[(size_t)i * 128]; T += v[i]; }
    tot[half * 128 + k] = T;
    __syncthreads();
    const float other = tot[(half ^ 1) * 128 + k];
    float suf = (half == 0) ? other : 0.f;
    float kd[32];
#pragma unroll
    for (int i = 31; i >= 0; --i) { kd[i] = kfromlf(v[i]) * __expf(suf); suf += v[i]; }
#pragma unroll
    for (int q = 0; q < 4; ++q) {
        u32x4 pk;
        pk[0] = pack2(kd[8 * q + 0], kd[8 * q + 1]); pk[1] = pack2(kd[8 * q + 2], kd[8 * q + 3]);
        pk[2] = pack2(kd[8 * q + 4], kd[8 * q + 5]); pk[3] = pack2(kd[8 * q + 6], kd[8 * q + 7]);
        *(u32x4*)(kdT + k * 144 + half * 64 + q * 16) = pk;
    }
    if (half == 0) p.dec()[(size_t)item * 128 + k] = __expf(T + other);
    __syncthreads();
    const u16* vrow = p.viT() + ((size_t)(b * 512 + h * 128 + wid * 32 + l31)) * 8192 + c * 64;
    f32x16 acc[4];
#pragma unroll
    for (int n = 0; n < 4; ++n)
#pragma unroll
        for (int r = 0; r < 16; ++r) acc[n][r] = 0.f;
#pragma unroll
    for (int ks = 0; ks < 4; ++ks) {
        const bf16x8 a = *(const bf16x8*)(vrow + ks * 16 + lh * 8);
#pragma unroll
        for (int nt = 0; nt < 4; ++nt) {
            const bf16x8 bb = *(const bf16x8*)(kdT + (nt * 32 + l31) * 144 + (ks * 16 + lh * 8) * 2);
            acc[nt] = MFMA32(a, bb, acc[nt]);
        }
    }
    u16* so = p.ST() + (size_t)item * 16384;
#pragma unroll
    for (int nt = 0; nt < 4; ++nt)
#pragma unroll
        for (int r = 0; r < 16; ++r) so[(wid * 32 + crow(r, lh)) * 128 + nt * 32 + l31] = f2bf(acc[nt][r]);
    __syncthreads();
}

DI void pass2(const P& p) {
    int tid = VTID;
    asm volatile("" : "+v"(tid));
    for (int e = VB * 256 + tid; e < 65536; e += VGRID * 256) {
        const int bh = e >> 13, rem = e & 8191, k2 = (rem & 63) * 2;
        unsigned* st = (unsigned*)p.ST() + (size_t)bh * 128 * 8192 + rem;
        const float2* dc = (const float2*)(p.dec() + (size_t)bh * 128 * 128 + k2);
        float r0 = 0.f, r1 = 0.f;
        for (int c0 = 0; c0 < 128; c0 += 8) {
            unsigned s[8]; float2 d[8];
#pragma unroll
            for (int j = 0; j < 8; ++j) { s[j] = st[(size_t)(c0 + j) * 8192]; d[j] = dc[(c0 + j) * 64]; }
#pragma unroll
            for (int j = 0; j < 8; ++j) {
                st[(size_t)(c0 + j) * 8192] = pack2(r0, r1);
                r0 = d[j].x * r0 + bflo(s[j]); r1 = d[j].y * r1 + bfhi(s[j]);
            }
        }
    }
}

DI void attn_item(const P& p, char* smem, int item, bool reuse, int par) {
    int tid = VTID;
    asm volatile("" : "+v"(tid));
    const int lane = tid & 63, wid = tid >> 6, l31 = lane & 31, lh = lane >> 5;
    const int pat = item >> 10, idx = item & 1023;
    const int dl = pat * 2, d = 1 << dl, nblk = 64 >> dl;
    const int nb = idx & (nblk - 1);
    int rest = idx >> (6 - dl);
    const int r = rest & (d - 1); rest >>= dl;
    const int hh = rest & 7, b = rest >> 3;
    char* Ks = smem;
    char* VT = smem + 256 * 144;
    const size_t tokbase = ((size_t)b * 8 + hh) * 8192;
    {
        const int c8 = tid & 7, kr = tid >> 3;
#pragma unroll
        for (int i = 0; i < 8; ++i) {
            const int lkey = kr + 32 * i;
            const int j = nb * 128 - 128 + lkey;
            const int key = (lkey & 127) + 128 * ((i >> 2) ^ par ^ 1);
            if (j >= 0 && !(reuse && i < 4)) {
                const size_t off = (tokbase + (size_t)j * d + r) * 64 + c8 * 8;
                const u32x4 kv = *(const u32x4*)(p.ak() + off);
                const u32x4 vv = *(const u32x4*)(p.av() + off);
                *(u32x4*)(Ks + key * 144 + c8 * 16) = kv;
#pragma unroll
                for (int e = 0; e < 4; ++e) {
                    *(u16*)(VT + (c8 * 8 + 2 * e) * 520 + key * 2) = (u16)(vv[e] & 0xffffu);
                    *(u16*)(VT + (c8 * 8 + 2 * e + 1) * 520 + key * 2) = (u16)(vv[e] >> 16);
                }
            }
        }
    }
    const int jq = nb * 128 + wid * 32 + l31;
    const size_t mq = tokbase + (size_t)jq * d + r;
    bf16x8 qf[4];
#pragma unroll
    for (int ks = 0; ks < 4; ++ks) qf[ks] = *(const bf16x8*)(p.aq() + mq * 64 + ks * 16 + lh * 8);
    __syncthreads();
    const int kt_lo = (nb == 0) ? 4 : 0;
    f32x16 st[5];
    float mx = -INFINITY;
#pragma unroll
    for (int i = 0; i < 5; ++i) {
        const int kt = wid + i;
        const int pkt = (kt & 3) + 4 * ((kt >> 2) ^ par ^ 1);
        if (kt >= kt_lo) {
#pragma unroll
            for (int rr = 0; rr < 16; ++rr) st[i][rr] = 0.f;
#pragma unroll
            for (int ks = 0; ks < 4; ++ks) {
                const bf16x8 a = *(const bf16x8*)(Ks + (pkt * 32 + l31) * 144 + (ks * 16 + lh * 8) * 2);
                st[i] = MFMA32(a, qf[ks], st[i]);
            }
#pragma unroll
            for (int rr = 0; rr < 16; ++rr) {
                const int dist = wid * 32 + l31 + 128 - (kt * 32 + crow(rr, lh));
                if (dist < 0 || dist > 128) st[i][rr] = -INFINITY;
                mx = fmaxf(mx, st[i][rr]);
            }
        } else {
#pragma unroll
            for (int rr = 0; rr < 16; ++rr) st[i][rr] = -INFINITY;
        }
    }
    mx = fmaxf(mx, __shfl_xor(mx, 32));
    float l = 0.f;
    const float mxs = mx * LOG2E;
#pragma unroll
    for (int i = 0; i < 5; ++i)
#pragma unroll
        for (int rr = 0; rr < 16; ++rr) { const float e = __builtin_amdgcn_exp2f(st[i][rr] * LOG2E - mxs); st[i][rr] = e; l += e; }
    l += __shfl_xor(l, 32);
    f32x16 o[2];
#pragma unroll
    for (int dt = 0; dt < 2; ++dt)
#pragma unroll
        for (int rr = 0; rr < 16; ++rr) o[dt][rr] = 0.f;
#pragma unroll
    for (int i = 0; i < 5; ++i) {
        const int kt = wid + i;
        const int pkt = (kt & 3) + 4 * ((kt >> 2) ^ par ^ 1);
        if (kt >= kt_lo) {
#pragma unroll
            for (int ks2 = 0; ks2 < 2; ++ks2) {
                const bf16x8 bq = packB(st[i], ks2);
#pragma unroll
                for (int dt = 0; dt < 2; ++dt) {
                    const char* ad = VT + (dt * 32 + l31) * 520 + (pkt * 32 + ks2 * 16 + lh * 4) * 2;
                    const uint2 lo = *(const uint2*)ad, hi = *(const uint2*)(ad + 16);
                    u32x4 av4; av4[0] = lo.x; av4[1] = lo.y; av4[2] = hi.x; av4[3] = hi.y;
                    o[dt] = MFMA32(__builtin_bit_cast(bf16x8, av4), bq, o[dt]);
                }
            }
        }
    }
    const float inv = 1.f / l;
    u16* op = (pat == 0 ? p.ao0() : (pat == 1 ? p.ao1() : p.ao2())) + mq * 64;
#pragma unroll
    for (int dt = 0; dt < 2; ++dt)
#pragma unroll
        for (int g4 = 0; g4 < 4; ++g4)
            *(uint2*)(op + dt * 32 + g4 * 8 + lh * 4) = make_uint2(pack2(o[dt][g4 * 4] * inv, o[dt][g4 * 4 + 1] * inv), pack2(o[dt][g4 * 4 + 2] * inv, o[dt][g4 * 4 + 3] * inv));
    if (lh == 0) p.lse()[((size_t)pat * NTOK + (size_t)b * 8192 + (size_t)jq * d + r) * 8 + hh] = mx + __logf(l);
    __syncthreads();
}

DI void pass3(const P& p, char* smem, int item) {
    int tid = VTID;
    asm volatile("" : "+v"(tid));
    const int lane = tid & 63, wid = tid >> 6, l31 = lane & 31, lh = lane >> 5;
    const int bh = item >> 7, c = item & 127, b = bh >> 2, h = bh & 3;
    const size_t m0 = (size_t)b * 8192 + c * 64;
    float* tot = (float*)smem;
    float* red = (float*)(smem + 1024);
    char* Qp = smem + 2048;
    char* Qpp = Qp + 64 * 272;
    char* Kp = Qpp + 64 * 272;
    u32x4 ca0[4], ca1[4], ca2[4], caz[4]; float cl0[4], cl1[4], cl2[4];
#pragma unroll
    for (int i = 0; i < 4; ++i) {
        const int e = tid + 256 * i, r = e >> 4, ch = (e & 15) + 16 * h;
        const size_t m = m0 + r; const int hh = ch >> 3;
        const size_t ho = (((size_t)b * 8 + hh) * 8192 + (size_t)c * 64 + r) * 64 + (ch & 7) * 8;
        ca0[i] = *(const u32x4*)(p.ao0() + ho); ca1[i] = *(const u32x4*)(p.ao1() + ho); ca2[i] = *(const u32x4*)(p.ao2() + ho);
        caz[i] = *(const u32x4*)(p.az() + ((size_t)(b * 4 + h) * 8192 + (size_t)c * 64 + r) * 128 + (e & 15) * 8);
        cl0[i] = p.lse()[m * 8 + hh]; cl1[i] = p.lse()[((size_t)NTOK + m) * 8 + hh]; cl2[i] = p.lse()[((size_t)2 * NTOK + m) * 8 + hh];
    }
    {
        const int k = tid & 127, half = tid >> 7;
        const h16* lfp = p.lf() + ((size_t)(b * 4 + h) * 8192 + c * 64 + half * 32) * 128 + k;
        const u16* qp = p.hq() + ((size_t)(b * 4 + h) * 8192 + c * 64 + half * 32) * 128 + k;
        float v[32]; float T = 0.f;
#pragma unroll
        for (int i = 0; i < 32; ++i) { v[i] = (float)lfp[(size_t)i * 128]; T += v[i]; }
        tot[half * 128 + k] = T;
        __syncthreads();
        const float other = tot[(half ^ 1) * 128 + k];
        const float bref = (half == 0) ? T : other;
        const float ebref = __expf(bref);
        const float sub = (half == 0) ? T : 0.f;
        float pre = 0.f;
#pragma unroll
        for (int i = 0; i < 32; ++i) {
            pre += v[i];
            const float xx = pre - sub;
            const float E1 = __builtin_amdgcn_exp2f(xx * LOG2E), Ei = __builtin_amdgcn_exp2f(-xx * LOG2E);
            const float q = bf2f(qp[(size_t)i * 128]);
            const float kk = kfromlf(v[i]);
            const int row = half * 32 + i;
            *(u16*)(Qp + row * 272 + k * 2) = f2bf(q * E1);
            *(u16*)(Qpp + row * 272 + k * 2) = f2bf(q * E1 * ebref);
            *(u16*)(Kp + row * 272 + k * 2) = f2bf(kk * Ei);
        }
    }
    __syncthreads();
    const int tt = wid & 1, vh = wid >> 1;
    f32x16 at[2];
#pragma unroll
    for (int st = 0; st < 2; ++st) {
#pragma unroll
        for (int rr = 0; rr < 16; ++rr) at[st][rr] = 0.f;
        if (st <= tt) {
#pragma unroll
            for (int ks = 0; ks < 8; ++ks) {
                const bf16x8 a = *(const bf16x8*)(Kp + (st * 32 + l31) * 272 + (ks * 16 + lh * 8) * 2);
                const bf16x8 bq = *(const bf16x8*)(Qp + (tt * 32 + l31) * 272 + (ks * 16 + lh * 8) * 2);
                at[st] = MFMA32(a, bq, at[st]);
            }
            if (st == tt) {
#pragma unroll
                for (int rr = 0; rr < 16; ++rr) if (crow(rr, lh) > l31) at[st][rr] = 0.f;
            }
        }
    }
    f32x16 o[2];
#pragma unroll
    for (int vt = 0; vt < 2; ++vt) {
#pragma unroll
        for (int rr = 0; rr < 16; ++rr) o[vt][rr] = 0.f;
        const int vrow = 64 * vh + 32 * vt + l31;
        const u16* srow = p.ST() + (size_t)item * 16384 + vrow * 128;
#pragma unroll
        for (int ks = 0; ks < 8; ++ks) {
            const bf16x8 a = *(const bf16x8*)(srow + ks * 16 + lh * 8);
            const bf16x8 bq = *(const bf16x8*)(Qpp + (tt * 32 + l31) * 272 + (ks * 16 + lh * 8) * 2);
            o[vt] = MFMA32(a, bq, o[vt]);
        }
        const u16* vr = p.viT() + ((size_t)(b * 512 + h * 128 + vrow)) * 8192 + c * 64;
#pragma unroll
        for (int st = 0; st < 2; ++st) {
            if (st <= tt) {
#pragma unroll
                for (int ks2 = 0; ks2 < 2; ++ks2) {
                    const uint2 lo = *(const uint2*)(vr + st * 32 + ks2 * 16 + lh * 4);
                    const uint2 hi = *(const uint2*)(vr + st * 32 + ks2 * 16 + 8 + lh * 4);
                    u32x4 av4; av4[0] = lo.x; av4[1] = lo.y; av4[2] = hi.x; av4[3] = hi.y;
                    o[vt] = MFMA32(__builtin_bit_cast(bf16x8, av4), packB(at[st], ks2), o[vt]);
                }
            }
        }
    }
    float ss = 0.f;
#pragma unroll
    for (int vt = 0; vt < 2; ++vt)
#pragma unroll
        for (int rr = 0; rr < 16; ++rr) ss += o[vt][rr] * o[vt][rr];
    ss += __shfl_xor(ss, 32);
    if (lh == 0) red[vh * 64 + tt * 32 + l31] = ss;
    __syncthreads();
    const float tot2 = red[tt * 32 + l31] + red[64 + tt * 32 + l31];
    const float rinv = rsqrtf(tot2 * (1.f / 128.f) + EPS);
    const size_t m = m0 + tt * 32 + l31;
#pragma unroll
    for (int vt = 0; vt < 2; ++vt)
#pragma unroll
        for (int g4 = 0; g4 < 4; ++g4) {
            const int vb = 64 * vh + 32 * vt + 8 * g4 + 4 * lh;
            const float4 gw = *(const float4*)(p.hgw + h * 128 + vb);
            const uint2 zz = *(const uint2*)(p.hz() + ((size_t)(b * 4 + h) * 8192 + (size_t)c * 64 + tt * 32 + l31) * 128 + vb);
            const float y0 = o[vt][g4 * 4 + 0] * rinv * gw.x * bflo(zz.x);
            const float y1 = o[vt][g4 * 4 + 1] * rinv * gw.y * bfhi(zz.x);
            const float y2 = o[vt][g4 * 4 + 2] * rinv * gw.z * bflo(zz.y);
            const float y3 = o[vt][g4 * 4 + 3] * rinv * gw.w * bfhi(zz.y);
            *(uint2*)(p.mixed() + m * 1024 + h * 128 + vb) = make_uint2(pack2(y0, y1), pack2(y2, y3));
        }
#pragma unroll
    for (int i = 0; i < 4; ++i) {
        const int e = tid + 256 * i, r = e >> 4, ch = (e & 15) + 16 * h;
        const float mx = fmaxf(cl0[i], fmaxf(cl1[i], cl2[i]));
        float w0 = __expf(cl0[i] - mx), w1 = __expf(cl1[i] - mx), w2 = __expf(cl2[i] - mx);
        const float inv = __builtin_amdgcn_rcpf(w0 + w1 + w2);
        w0 *= inv; w1 *= inv; w2 *= inv;
        u32x4 pk;
#pragma unroll
        for (int q = 0; q < 4; ++q) {
            const float y0 = (w0 * bflo(ca0[i][q]) + w1 * bflo(ca1[i][q]) + w2 * bflo(ca2[i][q])) * bflo(caz[i][q]);
            const float y1 = (w0 * bfhi(ca0[i][q]) + w1 * bfhi(ca1[i][q]) + w2 * bfhi(ca2[i][q])) * bfhi(caz[i][q]);
            pk[q] = pack2(y0, y1);
        }
        *(u32x4*)(p.mixed() + (m0 + r) * 1024 + 512 + ch * 8) = pk;
    }
    __syncthreads();
}

struct EpiOut {
    static constexpr bool PERM = false, AFTER_DRAIN = true;
    P p;
    DI void fused(pg8::f32x4 (&acc)[2][2][4][2], const pg8::Unit& u, int wr, int wc, int fr, int fq, PG8_LAS unsigned char* lds, int wid, int lane) const {
        PG8_LAS float* Pt = (PG8_LAS float*)lds;
        PG8_LAS float* Rt = (PG8_LAS float*)(lds + 4096);
        const int tid = threadIdx.x;
        const int rl0 = wr * 64 + fr, c0 = u.pn * 256 + wc * 32 + fq * 4;
#pragma unroll
        for (int ai = 0; ai < 2; ++ai)
#pragma unroll
            for (int m = 0; m < 4; ++m) {
                __builtin_amdgcn_sched_barrier(0);
                const int rl = rl0 + 128 * ai + 16 * m;
                const float* xr = p.x + ((size_t)u.pm * 256 + rl) * 1024 + c0;
                float ss = 0.f;
#pragma unroll
                for (int bj = 0; bj < 2; ++bj)
#pragma unroll
                    for (int n = 0; n < 2; ++n) {
                        const float4 xv = *(const float4*)(xr + 128 * bj + 16 * n);
                        pg8::f32x4& a = acc[ai][bj][m][n];
                        a[0] += xv.x; a[1] += xv.y; a[2] += xv.z; a[3] += xv.w;
                        ss = fmaf(a[0], a[0], ss); ss = fmaf(a[1], a[1], ss); ss = fmaf(a[2], a[2], ss); ss = fmaf(a[3], a[3], ss);
                    }
                ss += __shfl_xor(ss, 16); ss += __shfl_xor(ss, 32);
                if (fq == 0) Pt[rl * 4 + wc] = ss;
            }
        __syncthreads();
        if (tid < 256) (void)__hip_atomic_fetch_add(p.rowss() + u.pm * 256 + tid, (Pt[tid * 4] + Pt[tid * 4 + 1]) + (Pt[tid * 4 + 2] + Pt[tid * 4 + 3]), __ATOMIC_RELAXED, __HIP_MEMORY_SCOPE_AGENT);
        __threadfence();
        __syncthreads();
        if (tid == 0) {
            (void)__hip_atomic_fetch_add(p.pcnt() + u.pm, 1u, __ATOMIC_RELAXED, __HIP_MEMORY_SCOPE_AGENT);
            unsigned sp = 0;
            while (__hip_atomic_load(p.pcnt() + u.pm, __ATOMIC_RELAXED, __HIP_MEMORY_SCOPE_AGENT) < 4u) { __builtin_amdgcn_s_sleep(2); if (++sp > (1u << 22)) break; }
            __builtin_amdgcn_fence(__ATOMIC_ACQUIRE, "agent");
        }
        __syncthreads();
        if (tid < 256) Rt[tid] = rsqrtf(__hip_atomic_load(p.rowss() + u.pm * 256 + tid, __ATOMIC_RELAXED, __HIP_MEMORY_SCOPE_AGENT) * (1.f / 1024.f) + EPS);
        __syncthreads();
#pragma unroll
        for (int ai = 0; ai < 2; ++ai)
#pragma unroll
            for (int m = 0; m < 4; ++m) {
                __builtin_amdgcn_sched_barrier(0);
                const int rl = rl0 + 128 * ai + 16 * m;
                const float rinv = Rt[rl];
                float* orow = p.out + ((size_t)u.pm * 256 + rl) * 1024 + c0;
#pragma unroll
                for (int bj = 0; bj < 2; ++bj)
#pragma unroll
                    for (int n = 0; n < 2; ++n) {
                        const float4 fwv = *(const float4*)(p.fw + c0 + 128 * bj + 16 * n);
                        const pg8::f32x4& a = acc[ai][bj][m][n];
                        *(float4*)(orow + 128 * bj + 16 * n) = make_float4(a[0] * rinv * fwv.x, a[1] * rinv * fwv.y, a[2] * rinv * fwv.z, a[3] * rinv * fwv.w);
                    }
            }
    }
};

constexpr int VSMEM = 4 * 128 * 144;
constexpr int LDS_BYTES = 163840;

__global__ void __launch_bounds__(512, 2) fwd_kernel(P p) {
    extern __shared__ __attribute__((aligned(16))) unsigned char dynlds[];
    volatile unsigned* xbw = (volatile unsigned*)(dynlds + LDS_BYTES - 16);
    if (threadIdx.x < 4) xbw[threadIdx.x] = 0u;
    __syncthreads();
    const XcdBarrier gb = xcd_barrier_post(p.bar(), xbw);
    char* smem = (char*)dynlds + (threadIdx.x >> 8) * VSMEM;
    phase0(p, smem);
    xcd_barrier(gb);
    {
        pg8::Gemm g; g.A = p.xb(); g.Bt = p.winT(); g.M = NTOK; g.N = 4096; g.K = 1024;
        pg8::StaticOrder S; S.init(NTOK, 4096, gridDim.x, blockIdx.x);
        EpiIn E; E.p = p;
        pg8::gemm_phase<EpiIn, pg8::StaticOrder, false>((PG8_LAS unsigned char*)dynlds, g, S, E, nullptr);
    }
    xcd_barrier(gb);
    for (int it = VB; it < 1024; it += VGRID) pass1(p, smem, it);
    xcd_barrier(gb);
    pass2(p);
    if (VGRID == 512) {
        const int bi = VB;
        const int first = (bi < 256) ? bi * 5 : 1280 + (bi - 256) * 7, cnt = (bi < 256) ? 5 : 7;
        int par = 1;
        for (int i = 0; i < cnt; ++i) {
            const int item = first + i, nbi = (item & 1023) & ((64 >> ((item >> 10) * 2)) - 1);
            const bool reuse = (i > 0) && (nbi > 0);
            par = reuse ? (par ^ 1) : 1;
            attn_item(p, smem, item, reuse, par);
        }
    } else {
        for (int it = VB; it < 3072; it += VGRID) attn_item(p, smem, it, false, 1);
    }
    xcd_barrier(gb);
    for (int it = VB; it < 1024; it += VGRID) pass3(p, smem, it);
    xcd_barrier(gb);
    {
        pg8::Gemm g; g.A = p.mixed(); g.Bt = p.woutT(); g.M = NTOK; g.N = 1024; g.K = 1024;
        pg8::StaticOrder S; S.init(NTOK, 1024, gridDim.x, blockIdx.x);
        EpiOut E; E.p = p;
        pg8::gemm_phase<EpiOut, pg8::StaticOrder, false>((PG8_LAS unsigned char*)dynlds, g, S, E, nullptr);
    }
}

extern "C" void kernel_launch(void* const* d_in, const int* in_sizes, int n_in, void* d_out, int out_size, void* d_ws, size_t ws_size, hipStream_t stream) {
    static int grid_blocks = 0;
    if (!grid_blocks) {
        int per_cu = 0;
        (void)hipFuncSetAttribute((const void*)fwd_kernel, hipFuncAttributeMaxDynamicSharedMemorySize, LDS_BYTES);
        (void)hipOccupancyMaxActiveBlocksPerMultiprocessor(&per_cu, fwd_kernel, 512, LDS_BYTES);
        grid_blocks = 256;
    }
    char* ws = (char*)d_ws;
    P p{};
    p.x = (const float*)d_in[0]; p.norm_w = (const float*)d_in[1]; p.w_in = (const float*)d_in[2]; p.lbl = (const float*)d_in[3];
    p.hgw = (const float*)d_in[4]; p.w_out = (const float*)d_in[5]; p.fw = (const float*)d_in[6];
    p.out = (float*)d_out;
    p.ws = ws;
    (void)hipMemsetAsync(ws + OFF_BAR, 0, OFF_END - OFF_BAR, stream);
    void* args[] = {&p};
    hipError_t e = hipLaunchCooperativeKernel((void*)fwd_kernel, dim3(grid_blocks), dim3(512), args, LDS_BYTES, stream);
    if (e != hipSuccess) fprintf(stderr, "cooperative launch failed: %s (grid %d)\n", hipGetErrorString(e), grid_blocks);
}
```

```cpp
#include <hip/hip_runtime.h>
#include <cstdio>

typedef short bf16x8 __attribute__((ext_vector_type(8)));
typedef float f32x16 __attribute__((ext_vector_type(16)));
typedef __bf16 bf2_t __attribute__((ext_vector_type(2)));
typedef float f2_t __attribute__((ext_vector_type(2)));
typedef unsigned u32x4 __attribute__((ext_vector_type(4)));
typedef unsigned short u16;
typedef _Float16 h16;
typedef _Float16 h16x4 __attribute__((ext_vector_type(4)));

#define DI __device__ __forceinline__
#define VTID ((int)(threadIdx.x & 255u))
#define VB ((int)(blockIdx.x * 2u + (threadIdx.x >> 8)))
#define VGRID ((int)(gridDim.x * 2u))
#define MFMA32(a, b, c) __builtin_amdgcn_mfma_f32_32x32x16_bf16((a), (b), (c), 0, 0, 0)

constexpr int NTOK = 16384, DM = 1024, SEQ = 8192;
constexpr float EPS = 1e-6f;
constexpr float LOG2E = 1.4426950408889634f;

constexpr size_t MB = 1024 * 1024;
constexpr size_t OFF_XB = 0;
constexpr size_t OFF_RS = OFF_XB + 32 * MB;
constexpr size_t OFF_WINT = OFF_RS + 65536;
constexpr size_t OFF_WOUTT = OFF_WINT + 8 * MB;
constexpr size_t OFF_ROPE = OFF_WOUTT + 2 * MB;
constexpr size_t OFF_HQ = OFF_ROPE + 2 * MB;
constexpr size_t OFF_LF = OFF_HQ + 16 * MB;
constexpr size_t OFF_VIT = OFF_LF + 32 * MB;
constexpr size_t OFF_HZ = OFF_VIT + 16 * MB;
constexpr size_t OFF_AQ = OFF_HZ + 16 * MB;
constexpr size_t OFF_AK = OFF_AQ + 16 * MB;
constexpr size_t OFF_AV = OFF_AK + 16 * MB;
constexpr size_t OFF_AZ = OFF_AV + 16 * MB;
constexpr size_t OFF_ST = OFF_AZ + 16 * MB;
constexpr size_t OFF_DEC = OFF_ST + 32 * MB;
constexpr size_t OFF_AO2 = OFF_DEC + 512 * 1024;
constexpr size_t OFF_LSE = OFF_AO2 + 16 * MB;
constexpr size_t OFF_BAR = OFF_LSE + 3 * 16384 * 8 * 4;
constexpr size_t OFF_ROWSS = OFF_BAR + 16384;
constexpr size_t OFF_PCNT = OFF_ROWSS + 65536;
constexpr size_t OFF_END = OFF_PCNT + 1024;

struct P {
    const float* x; const float* norm_w; const float* w_in; const float* lbl; const float* hgw; const float* w_out; const float* fw;
    float* out; char* ws;
    DI u16* xb() const { return (u16*)(ws + OFF_XB); }
    DI float* rs() const { return (float*)(ws + OFF_RS); }
    DI u16* winT() const { return (u16*)(ws + OFF_WINT); }
    DI u16* woutT() const { return (u16*)(ws + OFF_WOUTT); }
    DI float* rope() const { return (float*)(ws + OFF_ROPE); }
    DI u16* hq() const { return (u16*)(ws + OFF_HQ); }
    DI h16* lf() const { return (h16*)(ws + OFF_LF); }
    DI u16* viT() const { return (u16*)(ws + OFF_VIT); }
    DI u16* hz() const { return (u16*)(ws + OFF_HZ); }
    DI u16* aq() const { return (u16*)(ws + OFF_AQ); }
    DI u16* ak() const { return (u16*)(ws + OFF_AK); }
    DI u16* av() const { return (u16*)(ws + OFF_AV); }
    DI u16* az() const { return (u16*)(ws + OFF_AZ); }
    DI u16* ST() const { return (u16*)(ws + OFF_ST); }
    DI float* dec() const { return (float*)(ws + OFF_DEC); }
    DI u16* ao0() const { return (u16*)(ws + OFF_XB); }
    DI u16* ao1() const { return (u16*)(ws + OFF_XB + 16 * MB); }
    DI u16* ao2() const { return (u16*)(ws + OFF_AO2); }
    DI float* lse() const { return (float*)(ws + OFF_LSE); }
    DI u16* mixed() const { return (u16*)(ws + OFF_AQ); }
    DI float* rowss() const { return (float*)(ws + OFF_ROWSS); }
    DI unsigned* pcnt() const { return (unsigned*)(ws + OFF_PCNT); }
    DI unsigned* bar() const { return (unsigned*)(ws + OFF_BAR); }
};

DI unsigned pack2(float a, float b) { f2_t v = {a, b}; return __builtin_bit_cast(unsigned, __builtin_convertvector(v, bf2_t)); }
DI u16 f2bf(float x) { return (u16)(pack2(x, 0.f) & 0xffffu); }
DI float bf2f(u16 v) { return __uint_as_float(((unsigned)v) << 16); }
DI float bflo(unsigned v) { return __uint_as_float(v << 16); }
DI float bfhi(unsigned v) { return __uint_as_float(v & 0xffff0000u); }
DI int crow(int reg, int h) { return (reg & 3) + 8 * (reg >> 2) + 4 * h; }
DI float silu(float v) { return v / (1.f + __expf(-v)); }
DI bf16x8 packB(const f32x16& x, int s) {
    u32x4 pk;
    pk[0] = pack2(x[8 * s + 0], x[8 * s + 1]); pk[1] = pack2(x[8 * s + 2], x[8 * s + 3]);
    pk[2] = pack2(x[8 * s + 4], x[8 * s + 5]); pk[3] = pack2(x[8 * s + 6], x[8 * s + 7]);
    return __builtin_bit_cast(bf16x8, pk);
}
DI float kfromlf(float v) { return (v > -0.02f) ? -v * (1.f + v * (0.5f + v * (1.f / 6.f))) : 1.f - __expf(v); }


#define XB_TMO      128
#define XB_XCNT(j)  (256  + 64 * (j))
#define XB_XSUB(j)  (1280 + 64 * (j))
#define XB_XGEN(j)  (2304 + 64 * (j))
#define XB_TOP      3328
#define XB_TOPGEN   3392
#define XCD_BAR_WORDS 3456
#define XB_SPIN_CAP (1u << 22)
#define LAS __attribute__((address_space(3)))
DI unsigned xb_ld(unsigned* p) { return __hip_atomic_load(p, __ATOMIC_RELAXED, __HIP_MEMORY_SCOPE_AGENT); }
DI unsigned xb_add(unsigned* p, unsigned v) { return __hip_atomic_fetch_add(p, v, __ATOMIC_RELAXED, __HIP_MEMORY_SCOPE_AGENT); }
DI unsigned xb_xcc_id() { return (unsigned)__builtin_amdgcn_s_getreg((3 << 11) | 20) & 0xFu; }
#define XB_SPIN(cond, bar) do { unsigned _sp = 0; while (cond) { __builtin_amdgcn_s_sleep(1); \
    if ((++_sp & 255u) == 0u) { if (xb_ld(&(bar)[XB_TMO])) break; if (_sp > XB_SPIN_CAP) { atomicAdd(&(bar)[XB_TMO], 1u); break; } } } } while (0)
struct XcdBarrier { unsigned* bar; unsigned x; volatile unsigned* st; };
DI XcdBarrier xcd_barrier_post(unsigned* bar, volatile unsigned* st) {
    XcdBarrier b; b.bar = bar; b.x = xb_xcc_id(); b.st = st;
    if (threadIdx.x == 0) (void)xb_add(&bar[XB_XCNT(b.x)], 1u);
    return b;
}
DI void xcd_barrier_complete(unsigned* bar, unsigned x, unsigned& nloc, unsigned& nx) {
    const unsigned G = gridDim.x * gridDim.y * gridDim.z;
    unsigned sum, cnt, mine, sp = 0u;
    for (;;) {
        sum = 0u; cnt = 0u; mine = 0u;
#pragma unroll
        for (unsigned j = 0; j < 16; ++j) { const unsigned c = xb_ld(&bar[XB_XCNT(j)]); sum += c; cnt += (c > 0u) ? 1u : 0u; mine = (j == x) ? c : mine; }
        if (sum == G) break;
        __builtin_amdgcn_s_sleep(1);
        if ((++sp & 255u) == 0u) { if (xb_ld(&bar[XB_TMO])) break; if (sp > XB_SPIN_CAP) { atomicAdd(&bar[XB_TMO], 1u); break; } }
    }
    nloc = mine > 0u ? mine : 1u; nx = cnt > 0u ? cnt : 1u;
}
DI void xcd_barrier(const XcdBarrier& b) {
    asm volatile("s_waitcnt vmcnt(0)" ::: "memory");
    __syncthreads();
    if (threadIdx.x == 0) {
        unsigned* bar = b.bar;
        __builtin_amdgcn_s_waitcnt(0);
        unsigned nloc = b.st[0], nx = b.st[1];
        if (nloc == 0u) { xcd_barrier_complete(bar, b.x, nloc, nx); b.st[0] = nloc; b.st[1] = nx; }
        const unsigned old = xb_add(&bar[XB_XSUB(b.x)], 1u);
        const unsigned gen = old / nloc;
        if (old + 1u == (gen + 1u) * nloc) {
            __builtin_amdgcn_fence(__ATOMIC_RELEASE, "agent");
            asm volatile("s_waitcnt vmcnt(0)" ::: "memory");
            const unsigned og = xb_add(&bar[XB_TOP], 1u);
            const unsigned tg = og / nx;
            if (og + 1u == (tg + 1u) * nx) xb_add(&bar[XB_TOPGEN], 1u);
            else XB_SPIN(xb_ld(&bar[XB_TOPGEN]) == tg, bar);
            __builtin_amdgcn_fence(__ATOMIC_ACQUIRE, "agent");
            xb_add(&bar[XB_XGEN(b.x)], 1u);
            asm volatile("s_waitcnt vmcnt(0)" ::: "memory");
        } else {
            XB_SPIN(xb_ld(&bar[XB_XGEN(b.x)]) == gen, bar);
            __builtin_amdgcn_fence(__ATOMIC_ACQUIRE, "agent");
            asm volatile("s_waitcnt vmcnt(0)" ::: "memory");
        }
    }
    __syncthreads();
}

constexpr int VSMEM_C = 4 * 128 * 144;
DI void vsync(char* smem, unsigned& gen) {
    __attribute__((address_space(3))) unsigned* ctr = (__attribute__((address_space(3))) unsigned*)(smem + VSMEM_C - 16);
    gen += 4u;
    __builtin_amdgcn_fence(__ATOMIC_RELEASE, "workgroup");
    if ((threadIdx.x & 63u) == 0u) (void)__hip_atomic_fetch_add(ctr, 1u, __ATOMIC_RELAXED, __HIP_MEMORY_SCOPE_WORKGROUP);
    unsigned sp = 0u;
    while (__hip_atomic_load(ctr, __ATOMIC_RELAXED, __HIP_MEMORY_SCOPE_WORKGROUP) < gen) { __builtin_amdgcn_s_sleep(1); if (++sp > (1u << 22)) break; }
    __builtin_amdgcn_fence(__ATOMIC_ACQUIRE, "workgroup");
}

DI void phase0(const P& p, char* smem) {
    int tid = VTID;
    asm volatile("" : "+v"(tid));
    const int lane = tid & 63, wid = tid >> 6;
    for (int row = VB * 4 + wid; row < NTOK; row += VGRID * 4) {
        const float4* xr = (const float4*)(p.x + (size_t)row * DM);
        float4 v[4]; float ss = 0.f;
#pragma unroll
        for (int i = 0; i < 4; ++i) { typedef float f4v __attribute__((ext_vector_type(4))); const f4v t4 = __builtin_nontemporal_load((const f4v*)(xr + lane + 64 * i)); v[i] = make_float4(t4[0], t4[1], t4[2], t4[3]); ss += v[i].x * v[i].x + v[i].y * v[i].y + v[i].z * v[i].z + v[i].w * v[i].w; }
#pragma unroll
        for (int o = 32; o >= 1; o >>= 1) ss += __shfl_xor(ss, o);
        uint2* xo = (uint2*)(p.xb() + (size_t)row * DM);
#pragma unroll
        for (int i = 0; i < 4; ++i) xo[lane + 64 * i] = make_uint2(pack2(v[i].x, v[i].y), pack2(v[i].z, v[i].w));
        if (lane == 0) p.rs()[row] = rsqrtf(ss * (1.f / 1024.f) + EPS);
    }
    float* tile = (float*)smem;
    for (int t = VB; t < 1024 + 256; t += VGRID) {
        const float* src; u16* dst; int ncols, td, tc; bool scale;
        if (t < 1024) { src = p.w_in; dst = p.winT(); ncols = 4096; td = t >> 6; tc = t & 63; scale = true; }
        else { const int t2 = t - 1024; src = p.w_out; dst = p.woutT(); ncols = 1024; td = t2 >> 4; tc = t2 & 15; scale = false; }
#pragma unroll
        for (int i = 0; i < 4; ++i) {
            const int r = (tid >> 4) + 16 * i, c4 = (tid & 15) * 4;
            float4 v = *(const float4*)(src + (size_t)(td * 64 + r) * ncols + tc * 64 + c4);
            const float s = scale ? p.norm_w[td * 64 + r] : 1.f;
            tile[r * 65 + c4 + 0] = v.x * s; tile[r * 65 + c4 + 1] = v.y * s; tile[r * 65 + c4 + 2] = v.z * s; tile[r * 65 + c4 + 3] = v.w * s;
        }
        __syncthreads();
#pragma unroll
        for (int u = 0; u < 2; ++u) {
            const int g = (tid & 3) + 4 * u, c = tid >> 2;
            float e[8];
#pragma unroll
            for (int j = 0; j < 8; ++j) e[j] = tile[(g * 8 + j) * 65 + c];
            u32x4 pk; pk[0] = pack2(e[0], e[1]); pk[1] = pack2(e[2], e[3]); pk[2] = pack2(e[4], e[5]); pk[3] = pack2(e[6], e[7]);
            int orow = tc * 64 + c;
            if (scale && orow >= 2048 && orow < 3072) { const int d = orow & 63; orow = (orow & ~63) + ((d & 31) << 1) + (d >> 5); }
            *(u32x4*)(dst + (size_t)orow * 1024 + td * 64 + g * 8) = pk;
        }
        __syncthreads();
    }
    for (int idx = VB * 256 + tid; idx < SEQ * 32; idx += VGRID * 256) {
        const int pos = idx >> 5, j = idx & 31;
        const float inv = (float)(1.0 / exp2((double)j * (13.287712379549449 / 32.0)));
        const float ang = (float)pos * inv;
        const double rev = (double)ang * 0.15915494309189535;
        const float fr = (float)(rev - floor(rev));
        p.rope()[idx] = __builtin_amdgcn_cosf(fr);
        p.rope()[SEQ * 32 + idx] = __builtin_amdgcn_sinf(fr);
    }
}

namespace pg8 {
#define PG8_LAS __attribute__((address_space(3)))
typedef unsigned short bf16_t;
typedef short bf16x8 __attribute__((ext_vector_type(8)));
typedef float f32x4 __attribute__((ext_vector_type(4)));
typedef unsigned u32x4 __attribute__((ext_vector_type(4)));
constexpr int BM = 256, BK = 64, HALF = 128, HTB = HALF * BK * 2  , STAGE_BYTES = 8 * HTB, NXCD = 8, WGM = 8;

__host__ __device__ __forceinline__ int lds_byte(int r, int c) { const int st = (r >> 4) * 2 + (c >> 5), rr = r & 15, cc = c & 31, ob = rr * 64 + cc * 2; return st * 1024 + (ob ^ (((ob >> 9) & 1) << 5)); }
__host__ __device__ __forceinline__ void stage_rc(int b, int& R, int& C) { const int st = b / 1024, sb = b % 1024, swz = sb ^ (((sb >> 9) & 1) << 5); R = (st >> 1) * 16 + swz / 64; C = (st & 1) * 32 + (swz % 64) / 2; }
__host__ __device__ __forceinline__ int perm32(int rho) { const int n = rho >> 4, i = rho & 15; return 8 * (i >> 2) + 4 * n + (i & 3); }

struct Unit { int pm, pn; };
struct Gemm { const bf16_t* A; const bf16_t* Bt; int M, N, K; };

struct StaticOrder {
    int nM, nN, nwg, G, c;
    __host__ __device__ void init(int M, int N, int G_, int c_) { nM = M / BM; nN = N / BM; nwg = nM * nN; G = G_; c = c_; }
    __host__ __device__ bool next(int i, Unit& u) const {
        const long L = (long)i * G + c; if (L >= nwg) return false;
        int wgid = (int)L; { const int q = nwg / NXCD, r = nwg % NXCD, xcd = wgid % NXCD, off = wgid / NXCD; wgid = (xcd < r ? xcd * (q + 1) : r * (q + 1) + (xcd - r) * q) + off; }
        const int nig = WGM * nN, gid = wgid / nig, fm = gid * WGM, gsz = (nM - fm) < WGM ? (nM - fm) : WGM;
        u.pm = fm + ((wgid % nig) % gsz); u.pn = (wgid % nig) / gsz; return true;
    }
    __device__ __forceinline__ void a_ready(const Unit&) const {}
    __device__ __forceinline__ void done(const Unit&) const {}
};
template <class Epi, class Sched, bool STAMP = false>
__device__ __forceinline__ void gemm_phase(PG8_LAS unsigned char* lds, const Gemm g, const Sched& S, const Epi& E, unsigned long long* stamps) {
    const int tid = threadIdx.x, wid = __builtin_amdgcn_readfirstlane(tid >> 6), lane = tid & 63, wr = wid >> 2, wc = wid & 3, fr = lane & 15, fq = lane >> 4;
    const int K = g.K, nt = K / BK;
    int ts_lo = 0, ts_hi = 0, nts = 0; const unsigned long long rt_entry = STAMP ? (unsigned long long)wall_clock64() : 0ull;
#define PG8_STAMP() do { if (STAMP && wid == 0 && nts < 64) { const unsigned long long _c = (unsigned long long)clock64(); \
        ts_lo = (lane == nts) ? (int)(unsigned)_c : ts_lo; ts_hi = (lane == nts) ? (int)(unsigned)(_c >> 32) : ts_hi; ++nts; } } while (0)
    PG8_STAMP();
    unsigned voffA[2], voffB[2];
#pragma unroll
    for (int i = 0; i < 2; ++i) { int R, C; stage_rc(tid * 16 + i * 8192, R, C); const int Rb = Epi::PERM ? ((R & ~31) + perm32(R & 31)) : R;
        voffA[i] = (unsigned)(R * K + C) * 2u; voffB[i] = (unsigned)(Rb * K + C) * 2u; }
    const size_t kstep = (size_t)(BK * 2);
    const size_t hstep = (size_t)HALF * K * 2;
    const size_t tstep = 2 * hstep;
    const unsigned ldsw = (unsigned)wid * 1024u;
    const int aoff = lds_byte(wr * 64 + fr, fq * 8), boff = lds_byte(wc * 32 + fr, fq * 8);
#define PG8_SA(b, h) (((b) * 2 + (h)) * HTB)
#define PG8_SB(b, h) ((4 + (b) * 2 + (h)) * HTB)
#define PG8_STAGE(bufoff, gbase, voff) do { _Pragma("unroll") for (int _i = 0; _i < 2; ++_i) \
        __builtin_amdgcn_global_load_lds((const unsigned*)((const char*)(gbase) + (voff)[_i]), (PG8_LAS unsigned*)(lds + (bufoff) + ldsw + _i * 8192), 16, 0, 0); } while (0)
#define PG8_LDA(dst, b, h) do { _Pragma("unroll") for (int m = 0; m < 4; ++m) _Pragma("unroll") for (int k = 0; k < 2; ++k) dst[m][k] = *(const PG8_LAS bf16x8*)(lds + PG8_SA(b, h) + aoff + m * 2048 + k * 1024); } while (0)
#define PG8_LDB(dst, b, h) do { _Pragma("unroll") for (int n = 0; n < 2; ++n) _Pragma("unroll") for (int k = 0; k < 2; ++k) dst[n][k] = *(const PG8_LAS bf16x8*)(lds + PG8_SB(b, h) + boff + n * 2048 + k * 1024); } while (0)
#define PG8_MMA(ai, bj, At, Bt) do { __builtin_amdgcn_s_setprio(1); _Pragma("unroll") for (int m = 0; m < 4; ++m) _Pragma("unroll") for (int n = 0; n < 2; ++n) _Pragma("unroll") for (int k = 0; k < 2; ++k) \
        acc[ai][bj][m][n] = __builtin_amdgcn_mfma_f32_16x16x32_bf16(Bt[n][k], At[m][k], acc[ai][bj][m][n], 0, 0, 0); __builtin_amdgcn_s_setprio(0); } while (0)
#define PG8_WAIT_V(n) asm volatile("s_waitcnt vmcnt(" #n ")" ::: "memory")
#define PG8_WAIT_L(n) asm volatile("s_waitcnt lgkmcnt(" #n ")" ::: "memory")
#define PG8_BAR __builtin_amdgcn_s_barrier()
#define PG8_SCHED __builtin_amdgcn_sched_barrier(0)
    Unit cur, nxt; int ui = 0;
    if (!S.next(0, cur)) return;
    f32x4 acc[2][2][4][2];
#pragma unroll
    for (int a = 0; a < 2; ++a)
#pragma unroll
        for (int b = 0; b < 2; ++b)
#pragma unroll
            for (int m = 0; m < 4; ++m)
#pragma unroll
                for (int n = 0; n < 2; ++n) acc[a][b][m][n] = (f32x4){0.f, 0.f, 0.f, 0.f};
    bf16x8 At[4][2], B0[2][2], B1[2][2];
    const char* cA = (const char*)g.A + (size_t)cur.pm * tstep; const char* cB = (const char*)g.Bt + (size_t)cur.pn * tstep;
    S.a_ready(cur);
    PG8_STAGE(PG8_SB(0, 0), cB, voffB); PG8_STAGE(PG8_SA(0, 0), cA, voffA); PG8_STAGE(PG8_SB(0, 1), cB + hstep, voffB); PG8_STAGE(PG8_SA(0, 1), cA + hstep, voffA);
    if (wr == 1) PG8_BAR;
    PG8_WAIT_V(4); PG8_BAR;
    PG8_STAGE(PG8_SB(1, 0), cB + kstep, voffB); PG8_STAGE(PG8_SA(1, 0), cA + kstep, voffA); PG8_STAGE(PG8_SB(1, 1), cB + hstep + kstep, voffB);
    PG8_WAIT_V(6); PG8_BAR;
    PG8_STAMP();
    for (;;) {
        const bool has_next = S.next(ui + 1, nxt);
        const char* nA = has_next ? (const char*)g.A + (size_t)nxt.pm * tstep : cA; const char* nB = has_next ? (const char*)g.Bt + (size_t)nxt.pn * tstep : cB;
        for (int t = 0; t < nt; t += 2) {
            const bool last = (t == nt - 2);
            const char* a1 = cA + (size_t)(t + 1) * kstep;
            const char* a2 = last ? nA : cA + (size_t)(t + 2) * kstep; const char* b2 = last ? nB : cB + (size_t)(t + 2) * kstep;
            const char* a3 = a2 + kstep; const char* b3 = b2 + kstep;
            if (last && has_next) S.a_ready(nxt);
            PG8_LDB(B0, 0, 0); PG8_SCHED; PG8_LDA(At, 0, 0); PG8_STAGE(PG8_SA(1, 1), a1 + hstep, voffA);
            PG8_WAIT_L(8); PG8_BAR; PG8_WAIT_L(0); PG8_MMA(0, 0, At, B0); PG8_BAR; PG8_SCHED;
            PG8_LDB(B1, 0, 1); PG8_STAGE(PG8_SB(0, 0), b2, voffB);
            PG8_BAR; PG8_WAIT_L(0); PG8_MMA(0, 1, At, B1); PG8_BAR;
            PG8_LDA(At, 0, 1); PG8_STAGE(PG8_SA(0, 0), a2, voffA);
            PG8_BAR; PG8_WAIT_L(0); PG8_MMA(1, 0, At, B0); PG8_BAR; PG8_SCHED;
            PG8_STAGE(PG8_SB(0, 1), b2 + hstep, voffB);
            PG8_WAIT_V(6); PG8_BAR; PG8_MMA(1, 1, At, B1); PG8_BAR;
            PG8_LDB(B0, 1, 0); PG8_SCHED; PG8_LDA(At, 1, 0); PG8_STAGE(PG8_SA(0, 1), a2 + hstep, voffA);
            PG8_WAIT_L(8); PG8_BAR; PG8_WAIT_L(0); PG8_MMA(0, 0, At, B0); PG8_BAR; PG8_SCHED;
            PG8_LDB(B1, 1, 1); PG8_STAGE(PG8_SB(1, 0), b3, voffB);
            PG8_BAR; PG8_WAIT_L(0); PG8_MMA(0, 1, At, B1); PG8_BAR;
            PG8_LDA(At, 1, 1); PG8_STAGE(PG8_SA(1, 0), a3, voffA);
            PG8_BAR; PG8_WAIT_L(0); PG8_MMA(1, 0, At, B0); PG8_BAR; PG8_SCHED;
            PG8_STAGE(PG8_SB(1, 1), b3 + hstep, voffB);
            PG8_WAIT_V(6); PG8_BAR; PG8_MMA(1, 1, At, B1); PG8_BAR;
        }
        PG8_STAMP();
        if constexpr (!Epi::AFTER_DRAIN) { E(acc, cur, wr, wc, fr, fq); S.done(cur); }
        PG8_STAMP();
        if (!has_next) break;
#pragma unroll
        for (int a = 0; a < 2; ++a)
#pragma unroll
            for (int b = 0; b < 2; ++b)
#pragma unroll
                for (int m = 0; m < 4; ++m)
#pragma unroll
                    for (int n = 0; n < 2; ++n) acc[a][b][m][n] = (f32x4){0.f, 0.f, 0.f, 0.f};
        cur = nxt; cA = nA; cB = nB; ++ui;
    }
    PG8_WAIT_V(0);
    if (wr == 0) PG8_BAR;
    PG8_BAR;
    if constexpr (Epi::AFTER_DRAIN) { E.fused(acc, cur, wr, wc, fr, fq, lds, wid, lane); S.done(cur); }
    PG8_STAMP();
    if (STAMP && wid == 0) { stamps[lane] = lane < nts ? (((unsigned long long)(unsigned)ts_hi << 32) | (unsigned)ts_lo) : 0ull;
        if (lane == 62) stamps[62] = rt_entry; if (lane == 63) stamps[63] = (unsigned long long)wall_clock64(); }
#undef PG8_STAMP
#undef PG8_SA
#undef PG8_SB
#undef PG8_STAGE
#undef PG8_LDA
#undef PG8_LDB
#undef PG8_MMA
#undef PG8_WAIT_V
#undef PG8_WAIT_L
#undef PG8_BAR
#undef PG8_SCHED
}
}


struct EpiIn {
    static constexpr bool PERM = true, AFTER_DRAIN = false;
    P p;
    template <int GRP> DI void run(const pg8::f32x4 (&acc)[2][2][4][2], const pg8::Unit& u, int wr, int wc, int fr, int fq) const {
        const int cg0 = (u.pn & 1) * 256 + wc * 32 + fq * 8;
        const int row0 = u.pm * 256 + wr * 64 + fr;
        float oml[2][8];
        if (GRP == 1) {
#pragma unroll
            for (int bj = 0; bj < 2; ++bj) {
                const float* l0 = p.lbl + cg0 + 128 * bj;
#pragma unroll
                for (int j = 0; j < 8; ++j) {
                    float lb = __builtin_amdgcn_rcpf(1.f + __builtin_amdgcn_exp2f((l0[512 + j] - l0[j]) * LOG2E));
                    lb = fminf(fmaxf(lb, 1e-6f), 1.f - 1e-6f);
                    oml[bj][j] = 1.f - lb;
                }
            }
        }
        float rsv[2][4];
#pragma unroll
        for (int ai = 0; ai < 2; ++ai)
#pragma unroll
            for (int m = 0; m < 4; ++m) rsv[ai][m] = p.rs()[row0 + 128 * ai + 16 * m];
#pragma unroll
        for (int ai = 0; ai < 2; ++ai)
#pragma unroll
            for (int m = 0; m < 4; ++m) {
                const int row = row0 + 128 * ai + 16 * m;
                const float rs = rsv[ai][m];
#pragma unroll
                for (int bj = 0; bj < 2; ++bj) {
                    const int cg = cg0 + 128 * bj;
                    float v[8];
#pragma unroll
                    for (int j = 0; j < 8; ++j) v[j] = acc[ai][bj][m][j >> 2][j & 3] * rs;
                    if (GRP == 2) {
                        const int b = row >> 13, t = row & 8191;
                        u16* dst = p.viT() + ((size_t)(b * 512 + cg)) * 8192 + t;
#pragma unroll
                        for (int j = 0; j < 8; ++j) dst[(size_t)j * 8192] = f2bf(v[j]);
                    } else if (GRP == 1) {
                        typedef _Float16 h16x8 __attribute__((ext_vector_type(8)));
                        h16x8 hv;
#pragma unroll
                        for (int j = 0; j < 8; ++j) hv[j] = (h16)(__builtin_amdgcn_logf(1.f - oml[bj][j] * __builtin_amdgcn_rcpf(1.f + __builtin_amdgcn_exp2f(v[j] * LOG2E))) * 0.6931471805599453f);
                        *(h16x8*)(p.lf() + ((size_t)((row >> 13) * 4 + (cg >> 7)) * 8192 + (row & 8191)) * 128 + (cg & 127)) = hv;
                    } else {
                        float o[8];
                        if (GRP == 0 || GRP == 3 || GRP == 7) {
#pragma unroll
                            for (int j = 0; j < 8; ++j) o[j] = v[j] * __builtin_amdgcn_rcpf(1.f + __builtin_amdgcn_exp2f(-v[j] * LOG2E));
                        } else if (GRP == 6) {
#pragma unroll
                            for (int j = 0; j < 8; ++j) o[j] = v[j];
                        } else {
                            const float sc = (GRP == 4) ? 0.125f : 1.f;
                            const int f0 = (cg & 63) >> 1, pos = row & 8191;
                            const float4 c4 = *(const float4*)(p.rope() + pos * 32 + f0), s4 = *(const float4*)(p.rope() + SEQ * 32 + pos * 32 + f0);
                            const float cs[4] = {c4.x, c4.y, c4.z, c4.w}, sn[4] = {s4.x, s4.y, s4.z, s4.w};
#pragma unroll
                            for (int i = 0; i < 4; ++i) {
                                o[2 * i] = (v[2 * i] * cs[i] - v[2 * i + 1] * sn[i]) * sc;
                                o[2 * i + 1] = (v[2 * i + 1] * cs[i] + v[2 * i] * sn[i]) * sc;
                            }
                        }
                        const size_t doff = (GRP == 4 || GRP == 5 || GRP == 6) ? ((size_t)((row >> 13) * 8 + (cg >> 6)) * 8192 + (row & 8191)) * 64 + (cg & 63)
                                                                                : ((size_t)((row >> 13) * 4 + (cg >> 7)) * 8192 + (row & 8191)) * 128 + (cg & 127);
                        u16* dst = ((GRP == 0) ? p.hq() : (GRP == 3) ? p.hz() : (GRP == 4) ? p.aq() : (GRP == 5) ? p.ak() : (GRP == 6) ? p.av() : p.az()) + doff;
                        u32x4 pk; pk[0] = pack2(o[0], o[1]); pk[1] = pack2(o[2], o[3]); pk[2] = pack2(o[4], o[5]); pk[3] = pack2(o[6], o[7]);
                        *(u32x4*)dst = pk;
                    }
                }
            }
    }
    DI void operator()(const pg8::f32x4 (&acc)[2][2][4][2], const pg8::Unit& u, int wr, int wc, int fr, int fq) const {
        switch (u.pn >> 1) {
            case 0: run<0>(acc, u, wr, wc, fr, fq); break;
            case 1: run<1>(acc, u, wr, wc, fr, fq); break;
            case 2: run<2>(acc, u, wr, wc, fr, fq); break;
            case 3: run<3>(acc, u, wr, wc, fr, fq); break;
            case 4: run<4>(acc, u, wr, wc, fr, fq); break;
            case 5: run<5>(acc, u, wr, wc, fr, fq); break;
            case 6: run<6>(acc, u, wr, wc, fr, fq); break;
            default: run<7>(acc, u, wr, wc, fr, fq); break;
        }
    }
};

DI void pass1(const P& p, char* smem, int item, unsigned& vgen) {
    int tid = VTID;
    asm volatile("" : "+v"(tid));
    const int lane = tid & 63, wid = tid >> 6, l31 = lane & 31, lh = lane >> 5;
    const int bh = item >> 7, c = item & 127, b = bh >> 2, h = bh & 3;
    const size_t m0 = (size_t)b * 8192 + c * 64;
    float* tot = (float*)smem;
    char* kdT = smem + 1024;
    const int k = tid & 127, half = tid >> 7;
    const h16* lfp = p.lf() + ((size_t)(b * 4 + h) * 8192 + c * 64 + half * 32) * 128 + k;
    float v[32]; float T = 0.f;
#pragma unroll
    for (int i = 0; i < 32; ++i) { v[i] = (float)lfp[(size_t)i * 128]; T += v[i]; }
    tot[half * 128 + k] = T;
    vsync(smem, vgen);
    const float other = tot[(half ^ 1) * 128 + k];
    float suf = (half == 0) ? other : 0.f;
    float kd[32];
#pragma unroll
    for (int i = 31; i >= 0; --i) { kd[i] = kfromlf(v[i]) * __expf(suf); suf += v[i]; }
#pragma unroll
    for (int q = 0; q < 4; ++q) {
        u32x4 pk;
        pk[0] = pack2(kd[8 * q + 0], kd[8 * q + 1]); pk[1] = pack2(kd[8 * q + 2], kd[8 * q + 3]);
        pk[2] = pack2(kd[8 * q + 4], kd[8 * q + 5]); pk[3] = pack2(kd[8 * q + 6], kd[8 * q + 7]);
        *(u32x4*)(kdT + k * 144 + half * 64 + q * 16) = pk;
    }
    if (half == 0) p.dec()[(size_t)item * 128 + k] = __expf(T + other);
    vsync(smem, vgen);
    const u16* vrow = p.viT() + ((size_t)(b * 512 + h * 128 + wid * 32 + l31)) * 8192 + c * 64;
    f32x16 acc[4];
#pragma unroll
    for (int n = 0; n < 4; ++n)
#pragma unroll
        for (int r = 0; r < 16; ++r) acc[n][r] = 0.f;
#pragma unroll
    for (int ks = 0; ks < 4; ++ks) {
        const bf16x8 a = *(const bf16x8*)(vrow + ks * 16 + lh * 8);
#pragma unroll
        for (int nt = 0; nt < 4; ++nt) {
            const bf16x8 bb = *(const bf16x8*)(kdT + (nt * 32 + l31) * 144 + (ks * 16 + lh * 8) * 2);
            acc[nt] = MFMA32(a, bb, acc[nt]);
        }
    }
    u16* so = p.ST() + (size_t)item * 16384;
#pragma unroll
    for (int nt = 0; nt < 4; ++nt)
#pragma unroll
        for (int r = 0; r < 16; ++r) so[(wid * 32 + crow(r, lh)) * 128 + nt * 32 + l31] = f2bf(acc[nt][r]);
    vsync(smem, vgen);
}

DI void pass2(const P& p) {
    int tid = VTID;
    asm volatile("" : "+v"(tid));
    for (int e = VB * 256 + tid; e < 65536; e += VGRID * 256) {
        const int bh = e >> 13, rem = e & 8191, k2 = (rem & 63) * 2;
        unsigned* st = (unsigned*)p.ST() + (size_t)bh * 128 * 8192 + rem;
        const float2* dc = (const float2*)(p.dec() + (size_t)bh * 128 * 128 + k2);
        float r0 = 0.f, r1 = 0.f;
        for (int c0 = 0; c0 < 128; c0 += 8) {
            unsigned s[8]; float2 d[8];
#pragma unroll
            for (int j = 0; j < 8; ++j) { s[j] = st[(size_t)(c0 + j) * 8192]; d[j] = dc[(c0 + j) * 64]; }
#pragma unroll
            for (int j = 0; j < 8; ++j) {
                st[(size_t)(c0 + j) * 8192] = pack2(r0, r1);
                r0 = d[j].x * r0 + bflo(s[j]); r1 = d[j].y * r1 + bfhi(s[j]);
            }
        }
    }
}

DI void attn_item(const P& p, char* smem, int item, bool reuse, int par, unsigned& vgen) {
    int tid = VTID;
    asm volatile("" : "+v"(tid));
    const int lane = tid & 63, wid = tid >> 6, l31 = lane & 31, lh = lane >> 5;
    const int pat = item >> 10, idx = item & 1023;
    const int dl = pat * 2, d = 1 << dl, nblk = 64 >> dl;
    const int nb = idx & (nblk - 1);
    int rest = idx >> (6 - dl);
    const int r = rest & (d - 1); rest >>= dl;
    const int hh = rest & 7, b = rest >> 3;
    char* Ks = smem;
    char* VT = smem + 256 * 144;
    const size_t tokbase = ((size_t)b * 8 + hh) * 8192;
    {
        const int c8 = tid & 7, kr = tid >> 3;
#pragma unroll
        for (int i = 0; i < 8; ++i) {
            const int lkey = kr + 32 * i;
            const int j = nb * 128 - 128 + lkey;
            const int key = (lkey & 127) + 128 * ((i >> 2) ^ par ^ 1);
            if (j >= 0 && !(reuse && i < 4)) {
                const size_t off = (tokbase + (size_t)j * d + r) * 64 + c8 * 8;
                const u32x4 kv = *(const u32x4*)(p.ak() + off);
                const u32x4 vv = *(const u32x4*)(p.av() + off);
                *(u32x4*)(Ks + key * 144 + c8 * 16) = kv;
#pragma unroll
                for (int e = 0; e < 4; ++e) {
                    *(u16*)(VT + (c8 * 8 + 2 * e) * 520 + key * 2) = (u16)(vv[e] & 0xffffu);
                    *(u16*)(VT + (c8 * 8 + 2 * e + 1) * 520 + key * 2) = (u16)(vv[e] >> 16);
                }
            }
        }
    }
    const int jq = nb * 128 + wid * 32 + l31;
    const size_t mq = tokbase + (size_t)jq * d + r;
    bf16x8 qf[4];
#pragma unroll
    for (int ks = 0; ks < 4; ++ks) qf[ks] = *(const bf16x8*)(p.aq() + mq * 64 + ks * 16 + lh * 8);
    vsync(smem, vgen);
    const int kt_lo = (nb == 0) ? 4 : 0;
    f32x16 st[5];
    float mx = -INFINITY;
#pragma unroll
    for (int i = 0; i < 5; ++i) {
        const int kt = wid + i;
        const int pkt = (kt & 3) + 4 * ((kt >> 2) ^ par ^ 1);
        if (kt >= kt_lo) {
#pragma unroll
            for (int rr = 0; rr < 16; ++rr) st[i][rr] = 0.f;
#pragma unroll
            for (int ks = 0; ks < 4; ++ks) {
                const bf16x8 a = *(const bf16x8*)(Ks + (pkt * 32 + l31) * 144 + (ks * 16 + lh * 8) * 2);
                st[i] = MFMA32(a, qf[ks], st[i]);
            }
#pragma unroll
            for (int rr = 0; rr < 16; ++rr) {
                const int dist = wid * 32 + l31 + 128 - (kt * 32 + crow(rr, lh));
                if (dist < 0 || dist > 128) st[i][rr] = -INFINITY;
                mx = fmaxf(mx, st[i][rr]);
            }
        } else {
#pragma unroll
            for (int rr = 0; rr < 16; ++rr) st[i][rr] = -INFINITY;
        }
    }
    mx = fmaxf(mx, __shfl_xor(mx, 32));
    float l = 0.f;
    const float mxs = mx * LOG2E;
#pragma unroll
    for (int i = 0; i < 5; ++i)
#pragma unroll
        for (int rr = 0; rr < 16; ++rr) { const float e = __builtin_amdgcn_exp2f(st[i][rr] * LOG2E - mxs); st[i][rr] = e; l += e; }
    l += __shfl_xor(l, 32);
    f32x16 o[2];
#pragma unroll
    for (int dt = 0; dt < 2; ++dt)
#pragma unroll
        for (int rr = 0; rr < 16; ++rr) o[dt][rr] = 0.f;
#pragma unroll
    for (int i = 0; i < 5; ++i) {
        const int kt = wid + i;
        const int pkt = (kt & 3) + 4 * ((kt >> 2) ^ par ^ 1);
        if (kt >= kt_lo) {
#pragma unroll
            for (int ks2 = 0; ks2 < 2; ++ks2) {
                const bf16x8 bq = packB(st[i], ks2);
#pragma unroll
                for (int dt = 0; dt < 2; ++dt) {
                    const char* ad = VT + (dt * 32 + l31) * 520 + (pkt * 32 + ks2 * 16 + lh * 4) * 2;
                    const uint2 lo = *(const uint2*)ad, hi = *(const uint2*)(ad + 16);
                    u32x4 av4; av4[0] = lo.x; av4[1] = lo.y; av4[2] = hi.x; av4[3] = hi.y;
                    o[dt] = MFMA32(__builtin_bit_cast(bf16x8, av4), bq, o[dt]);
                }
            }
        }
    }
    const float inv = 1.f / l;
    u16* op = (pat == 0 ? p.ao0() : (pat == 1 ? p.ao1() : p.ao2())) + mq * 64;
#pragma unroll
    for (int dt = 0; dt < 2; ++dt)
#pragma unroll
        for (int g4 = 0; g4 < 4; ++g4)
            *(uint2*)(op + dt * 32 + g4 * 8 + lh * 4) = make_uint2(pack2(o[dt][g4 * 4] * inv, o[dt][g4 * 4 + 1] * inv), pack2(o[dt][g4 * 4 + 2] * inv, o[dt][g4 * 4 + 3] * inv));
    if (lh == 0) p.lse()[((size_t)pat * NTOK + (size_t)b * 8192 + (size_t)jq * d + r) * 8 + hh] = mx + __logf(l);
    vsync(smem, vgen);
}

DI void pass3(const P& p, char* smem, int item, unsigned& vgen) {
    int tid = VTID;
    asm volatile("" : "+v"(tid));
    const int lane = tid & 63, wid = tid >> 6, l31 = lane & 31, lh = lane >> 5;
    const int bh = item >> 7, c = item & 127, b = bh >> 2, h = bh & 3;
    const size_t m0 = (size_t)b * 8192 + c * 64;
    float* tot = (float*)smem;
    float* red = (float*)(smem + 1024);
    char* Qp = smem + 2048;
    char* Qpp = Qp + 64 * 272;
    char* Kp = Qpp + 64 * 272;
    u32x4 ca0[4], ca1[4], ca2[4], caz[4]; float cl0[4], cl1[4], cl2[4];
#pragma unroll
    for (int i = 0; i < 4; ++i) {
        const int e = tid + 256 * i, r = e >> 4, ch = (e & 15) + 16 * h;
        const size_t m = m0 + r; const int hh = ch >> 3;
        const size_t ho = (((size_t)b * 8 + hh) * 8192 + (size_t)c * 64 + r) * 64 + (ch & 7) * 8;
        ca0[i] = *(const u32x4*)(p.ao0() + ho); ca1[i] = *(const u32x4*)(p.ao1() + ho); ca2[i] = *(const u32x4*)(p.ao2() + ho);
        caz[i] = *(const u32x4*)(p.az() + ((size_t)(b * 4 + h) * 8192 + (size_t)c * 64 + r) * 128 + (e & 15) * 8);
        cl0[i] = p.lse()[m * 8 + hh]; cl1[i] = p.lse()[((size_t)NTOK + m) * 8 + hh]; cl2[i] = p.lse()[((size_t)2 * NTOK + m) * 8 + hh];
    }
    {
        const int k = tid & 127, half = tid >> 7;
        const h16* lfp = p.lf() + ((size_t)(b * 4 + h) * 8192 + c * 64 + half * 32) * 128 + k;
        const u16* qp = p.hq() + ((size_t)(b * 4 + h) * 8192 + c * 64 + half * 32) * 128 + k;
        float v[32]; float T = 0.f;
#pragma unroll
        for (int i = 0; i < 32; ++i) { v[i] = (float)lfp[(size_t)i * 128]; T += v[i]; }
        tot[half * 128 + k] = T;
        vsync(smem, vgen);
        const float other = tot[(half ^ 1) * 128 + k];
        const float bref = (half == 0) ? T : other;
        const float ebref = __expf(bref);
        const float sub = (half == 0) ? T : 0.f;
        float pre = 0.f;
#pragma unroll
        for (int i = 0; i < 32; ++i) {
            pre += v[i];
            const float xx = pre - sub;
            const float E1 = __builtin_amdgcn_exp2f(xx * LOG2E), Ei = __builtin_amdgcn_exp2f(-xx * LOG2E);
            const float q = bf2f(qp[(size_t)i * 128]);
            const float kk = kfromlf(v[i]);
            const int row = half * 32 + i;
            *(u16*)(Qp + row * 272 + k * 2) = f2bf(q * E1);
            *(u16*)(Qpp + row * 272 + k * 2) = f2bf(q * E1 * ebref);
            *(u16*)(Kp + row * 272 + k * 2) = f2bf(kk * Ei);
        }
    }
    vsync(smem, vgen);
    const int tt = wid & 1, vh = wid >> 1;
    f32x16 at[2];
#pragma unroll
    for (int st = 0; st < 2; ++st) {
#pragma unroll
        for (int rr = 0; rr < 16; ++rr) at[st][rr] = 0.f;
        if (st <= tt) {
#pragma unroll
            for (int ks = 0; ks < 8; ++ks) {
                const bf16x8 a = *(const bf16x8*)(Kp + (st * 32 + l31) * 272 + (ks * 16 + lh * 8) * 2);
                const bf16x8 bq = *(const bf16x8*)(Qp + (tt * 32 + l31) * 272 + (ks * 16 + lh * 8) * 2);
                at[st] = MFMA32(a, bq, at[st]);
            }
            if (st == tt) {
#pragma unroll
                for (int rr = 0; rr < 16; ++rr) if (crow(rr, lh) > l31) at[st][rr] = 0.f;
            }
        }
    }
    f32x16 o[2];
#pragma unroll
    for (int vt = 0; vt < 2; ++vt) {
#pragma unroll
        for (int rr = 0; rr < 16; ++rr) o[vt][rr] = 0.f;
        const int vrow = 64 * vh + 32 * vt + l31;
        const u16* srow = p.ST() + (size_t)item * 16384 + vrow * 128;
#pragma unroll
        for (int ks = 0; ks < 8; ++ks) {
            const bf16x8 a = *(const bf16x8*)(srow + ks * 16 + lh * 8);
            const bf16x8 bq = *(const bf16x8*)(Qpp + (tt * 32 + l31) * 272 + (ks * 16 + lh * 8) * 2);
            o[vt] = MFMA32(a, bq, o[vt]);
        }
        const u16* vr = p.viT() + ((size_t)(b * 512 + h * 128 + vrow)) * 8192 + c * 64;
#pragma unroll
        for (int st = 0; st < 2; ++st) {
            if (st <= tt) {
#pragma unroll
                for (int ks2 = 0; ks2 < 2; ++ks2) {
                    const uint2 lo = *(const uint2*)(vr + st * 32 + ks2 * 16 + lh * 4);
                    const uint2 hi = *(const uint2*)(vr + st * 32 + ks2 * 16 + 8 + lh * 4);
                    u32x4 av4; av4[0] = lo.x; av4[1] = lo.y; av4[2] = hi.x; av4[3] = hi.y;
                    o[vt] = MFMA32(__builtin_bit_cast(bf16x8, av4), packB(at[st], ks2), o[vt]);
                }
            }
        }
    }
    float ss = 0.f;
#pragma unroll
    for (int vt = 0; vt < 2; ++vt)
#pragma unroll
        for (int rr = 0; rr < 16; ++rr) ss += o[vt][rr] * o[vt][rr];
    ss += __shfl_xor(ss, 32);
    if (lh == 0) red[vh * 64 + tt * 32 + l31] = ss;
    vsync(smem, vgen);
    const float tot2 = red[tt * 32 + l31] + red[64 + tt * 32 + l31];
    const float rinv = rsqrtf(tot2 * (1.f / 128.f) + EPS);
    const size_t m = m0 + tt * 32 + l31;
#pragma unroll
    for (int vt = 0; vt < 2; ++vt)
#pragma unroll
        for (int g4 = 0; g4 < 4; ++g4) {
            const int vb = 64 * vh + 32 * vt + 8 * g4 + 4 * lh;
            const float4 gw = *(const float4*)(p.hgw + h * 128 + vb);
            const uint2 zz = *(const uint2*)(p.hz() + ((size_t)(b * 4 + h) * 8192 + (size_t)c * 64 + tt * 32 + l31) * 128 + vb);
            const float y0 = o[vt][g4 * 4 + 0] * rinv * gw.x * bflo(zz.x);
            const float y1 = o[vt][g4 * 4 + 1] * rinv * gw.y * bfhi(zz.x);
            const float y2 = o[vt][g4 * 4 + 2] * rinv * gw.z * bflo(zz.y);
            const float y3 = o[vt][g4 * 4 + 3] * rinv * gw.w * bfhi(zz.y);
            *(uint2*)(p.mixed() + m * 1024 + h * 128 + vb) = make_uint2(pack2(y0, y1), pack2(y2, y3));
        }
#pragma unroll
    for (int i = 0; i < 4; ++i) {
        const int e = tid + 256 * i, r = e >> 4, ch = (e & 15) + 16 * h;
        const float mx = fmaxf(cl0[i], fmaxf(cl1[i], cl2[i]));
        float w0 = __expf(cl0[i] - mx), w1 = __expf(cl1[i] - mx), w2 = __expf(cl2[i] - mx);
        const float inv = __builtin_amdgcn_rcpf(w0 + w1 + w2);
        w0 *= inv; w1 *= inv; w2 *= inv;
        u32x4 pk;
#pragma unroll
        for (int q = 0; q < 4; ++q) {
            const float y0 = (w0 * bflo(ca0[i][q]) + w1 * bflo(ca1[i][q]) + w2 * bflo(ca2[i][q])) * bflo(caz[i][q]);
            const float y1 = (w0 * bfhi(ca0[i][q]) + w1 * bfhi(ca1[i][q]) + w2 * bfhi(ca2[i][q])) * bfhi(caz[i][q]);
            pk[q] = pack2(y0, y1);
        }
        *(u32x4*)(p.mixed() + (m0 + r) * 1024 + 512 + ch * 8) = pk;
    }
    vsync(smem, vgen);
}

struct EpiOut {
    static constexpr bool PERM = false, AFTER_DRAIN = true;
    P p;
    DI void fused(pg8::f32x4 (&acc)[2][2][4][2], const pg8::Unit& u, int wr, int wc, int fr, int fq, PG8_LAS unsigned char* lds, int wid, int lane) const {
        PG8_LAS float* Pt = (PG8_LAS float*)lds;
        PG8_LAS float* Rt = (PG8_LAS float*)(lds + 4096);
        const int tid = threadIdx.x;
        const int rl0 = wr * 64 + fr, c0 = u.pn * 256 + wc * 32 + fq * 4;
#pragma unroll
        for (int ai = 0; ai < 2; ++ai)
#pragma unroll
            for (int m = 0; m < 4; ++m) {
                __builtin_amdgcn_sched_barrier(0);
                const int rl = rl0 + 128 * ai + 16 * m;
                const float* xr = p.x + ((size_t)u.pm * 256 + rl) * 1024 + c0;
                float ss = 0.f;
#pragma unroll
                for (int bj = 0; bj < 2; ++bj)
#pragma unroll
                    for (int n = 0; n < 2; ++n) {
                        const float4 xv = *(const float4*)(xr + 128 * bj + 16 * n);
                        pg8::f32x4& a = acc[ai][bj][m][n];
                        a[0] += xv.x; a[1] += xv.y; a[2] += xv.z; a[3] += xv.w;
                        ss = fmaf(a[0], a[0], ss); ss = fmaf(a[1], a[1], ss); ss = fmaf(a[2], a[2], ss); ss = fmaf(a[3], a[3], ss);
                    }
                ss += __shfl_xor(ss, 16); ss += __shfl_xor(ss, 32);
                if (fq == 0) Pt[rl * 4 + wc] = ss;
            }
        __syncthreads();
        if (tid < 256) (void)__hip_atomic_fetch_add(p.rowss() + u.pm * 256 + tid, (Pt[tid * 4] + Pt[tid * 4 + 1]) + (Pt[tid * 4 + 2] + Pt[tid * 4 + 3]), __ATOMIC_RELAXED, __HIP_MEMORY_SCOPE_AGENT);
        __threadfence();
        __syncthreads();
        if (tid == 0) {
            (void)__hip_atomic_fetch_add(p.pcnt() + u.pm, 1u, __ATOMIC_RELAXED, __HIP_MEMORY_SCOPE_AGENT);
            unsigned sp = 0;
            while (__hip_atomic_load(p.pcnt() + u.pm, __ATOMIC_RELAXED, __HIP_MEMORY_SCOPE_AGENT) < 4u) { __builtin_amdgcn_s_sleep(2); if (++sp > (1u << 22)) break; }
            __builtin_amdgcn_fence(__ATOMIC_ACQUIRE, "agent");
        }
        __syncthreads();
        if (tid < 256) Rt[tid] = rsqrtf(__hip_atomic_load(p.rowss() + u.pm * 256 + tid, __ATOMIC_RELAXED, __HIP_MEMORY_SCOPE_AGENT) * (1.f / 1024.f) + EPS);
        __syncthreads();
#pragma unroll
        for (int ai = 0; ai < 2; ++ai)
#pragma unroll
            for (int m = 0; m < 4; ++m) {
                __builtin_amdgcn_sched_barrier(0);
                const int rl = rl0 + 128 * ai + 16 * m;
                const float rinv = Rt[rl];
                float* orow = p.out + ((size_t)u.pm * 256 + rl) * 1024 + c0;
#pragma unroll
                for (int bj = 0; bj < 2; ++bj)
#pragma unroll
                    for (int n = 0; n < 2; ++n) {
                        const float4 fwv = *(const float4*)(p.fw + c0 + 128 * bj + 16 * n);
                        const pg8::f32x4& a = acc[ai][bj][m][n];
                        *(float4*)(orow + 128 * bj + 16 * n) = make_float4(a[0] * rinv * fwv.x, a[1] * rinv * fwv.y, a[2] * rinv * fwv.z, a[3] * rinv * fwv.w);
                    }
            }
    }
};

constexpr int VSMEM = 4 * 128 * 144;
constexpr int LDS_BYTES = 163840;

__global__ void __launch_bounds__(512, 2) fwd_kernel(P p) {
    extern __shared__ __attribute__((aligned(16))) unsigned char dynlds[];
    volatile unsigned* xbw = (volatile unsigned*)(dynlds + LDS_BYTES - 16);
    if (threadIdx.x < 4) xbw[threadIdx.x] = 0u;
    __syncthreads();
    const XcdBarrier gb = xcd_barrier_post(p.bar(), xbw);
    char* smem = (char*)dynlds + (threadIdx.x >> 8) * VSMEM;
    phase0(p, smem);
    xcd_barrier(gb);
    {
        pg8::Gemm g; g.A = p.xb(); g.Bt = p.winT(); g.M = NTOK; g.N = 4096; g.K = 1024;
        pg8::StaticOrder S; S.init(NTOK, 4096, gridDim.x, blockIdx.x);
        EpiIn E; E.p = p;
        pg8::gemm_phase<EpiIn, pg8::StaticOrder, false>((PG8_LAS unsigned char*)dynlds, g, S, E, nullptr);
    }
    xcd_barrier(gb);
    unsigned vgen = 0u;
    if (VTID == 0) *(volatile unsigned*)(smem + VSMEM - 16) = 0u;
    __syncthreads();
    for (int it = VB; it < 1024; it += VGRID) pass1(p, smem, it, vgen);
    xcd_barrier(gb);
    pass2(p);
    if (VGRID == 512) {
        const int bi = VB;
        const int first = (bi < 256) ? bi * 5 : 1280 + (bi - 256) * 7, cnt = (bi < 256) ? 5 : 7;
        int par = 1;
        for (int i = 0; i < cnt; ++i) {
            const int item = first + i, nbi = (item & 1023) & ((64 >> ((item >> 10) * 2)) - 1);
            const bool reuse = (i > 0) && (nbi > 0);
            par = reuse ? (par ^ 1) : 1;
            attn_item(p, smem, item, reuse, par, vgen);
        }
    } else {
        for (int it = VB; it < 3072; it += VGRID) attn_item(p, smem, it, false, 1, vgen);
    }
    xcd_barrier(gb);
    for (int it = VB; it < 1024; it += VGRID) pass3(p, smem, it, vgen);
    xcd_barrier(gb);
    {
        pg8::Gemm g; g.A = p.mixed(); g.Bt = p.woutT(); g.M = NTOK; g.N = 1024; g.K = 1024;
        pg8::StaticOrder S; S.init(NTOK, 1024, gridDim.x, blockIdx.x);
        EpiOut E; E.p = p;
        pg8::gemm_phase<EpiOut, pg8::StaticOrder, false>((PG8_LAS unsigned char*)dynlds, g, S, E, nullptr);
    }
}

extern "C" void kernel_launch(void* const* d_in, const int* in_sizes, int n_in, void* d_out, int out_size, void* d_ws, size_t ws_size, hipStream_t stream) {
    static int grid_blocks = 0;
    if (!grid_blocks) {
        int per_cu = 0;
        (void)hipFuncSetAttribute((const void*)fwd_kernel, hipFuncAttributeMaxDynamicSharedMemorySize, LDS_BYTES);
        (void)hipOccupancyMaxActiveBlocksPerMultiprocessor(&per_cu, fwd_kernel, 512, LDS_BYTES);
        grid_blocks = 256;
    }
    char* ws = (char*)d_ws;
    P p{};
    p.x = (const float*)d_in[0]; p.norm_w = (const float*)d_in[1]; p.w_in = (const float*)d_in[2]; p.lbl = (const float*)d_in[3];
    p.hgw = (const float*)d_in[4]; p.w_out = (const float*)d_in[5]; p.fw = (const float*)d_in[6];
    p.out = (float*)d_out;
    p.ws = ws;
    (void)hipMemsetAsync(ws + OFF_BAR, 0, OFF_END - OFF_BAR, stream);
    void* args[] = {&p};
    hipError_t e = hipLaunchCooperativeKernel((void*)fwd_kernel, dim3(grid_blocks), dim3(512), args, LDS_BYTES, stream);
    if (e != hipSuccess) fprintf(stderr, "cooperative launch failed: %s (grid %d)\n", hipGetErrorString(e), grid_blocks);
}
```

```cpp
#include <hip/hip_runtime.h>
#include <cstdio>

typedef short bf16x8 __attribute__((ext_vector_type(8)));
typedef float f32x16 __attribute__((ext_vector_type(16)));
typedef __bf16 bf2_t __attribute__((ext_vector_type(2)));
typedef float f2_t __attribute__((ext_vector_type(2)));
typedef unsigned u32x4 __attribute__((ext_vector_type(4)));
typedef unsigned short u16;
typedef _Float16 h16;
typedef _Float16 h16x4 __attribute__((ext_vector_type(4)));

#define DI __device__ __forceinline__
#define VTID ((int)(threadIdx.x & 255u))
#define VB ((int)(blockIdx.x * 2u + (threadIdx.x >> 8)))
#define VGRID ((int)(gridDim.x * 2u))
#define MFMA32(a, b, c) __builtin_amdgcn_mfma_f32_32x32x16_bf16((a), (b), (c), 0, 0, 0)

constexpr int NTOK = 16384, DM = 1024, SEQ = 8192;
constexpr float EPS = 1e-6f;
constexpr float LOG2E = 1.4426950408889634f;

constexpr size_t MB = 1024 * 1024;
constexpr size_t OFF_XB = 0;
constexpr size_t OFF_RS = OFF_XB + 32 * MB;
constexpr size_t OFF_WINT = OFF_RS + 65536;
constexpr size_t OFF_WOUTT = OFF_WINT + 8 * MB;
constexpr size_t OFF_ROPE = OFF_WOUTT + 2 * MB;
constexpr size_t OFF_HQ = OFF_ROPE + 2 * MB;
constexpr size_t OFF_LF = OFF_HQ + 16 * MB;
constexpr size_t OFF_VIT = OFF_LF + 32 * MB;
constexpr size_t OFF_HZ = OFF_VIT + 16 * MB;
constexpr size_t OFF_AQ = OFF_HZ + 16 * MB;
constexpr size_t OFF_AK = OFF_AQ + 16 * MB;
constexpr size_t OFF_AV = OFF_AK + 16 * MB;
constexpr size_t OFF_AZ = OFF_AV + 16 * MB;
constexpr size_t OFF_ST = OFF_AZ + 16 * MB;
constexpr size_t OFF_DEC = OFF_ST + 32 * MB;
constexpr size_t OFF_AO2 = OFF_DEC + 512 * 1024;
constexpr size_t OFF_LSE = OFF_AO2 + 16 * MB;
constexpr size_t OFF_BAR = OFF_LSE + 3 * 16384 * 8 * 4;
constexpr size_t OFF_ROWSS = OFF_BAR + 16384;
constexpr size_t OFF_PCNT = OFF_ROWSS + 65536;
constexpr size_t OFF_END = OFF_PCNT + 1024;

struct P {
    const float* x; const float* norm_w; const float* w_in; const float* lbl; const float* hgw; const float* w_out; const float* fw;
    float* out; char* ws;
    DI u16* xb() const { return (u16*)(ws + OFF_XB); }
    DI float* rs() const { return (float*)(ws + OFF_RS); }
    DI u16* winT() const { return (u16*)(ws + OFF_WINT); }
    DI u16* woutT() const { return (u16*)(ws + OFF_WOUTT); }
    DI float* rope() const { return (float*)(ws + OFF_ROPE); }
    DI u16* hq() const { return (u16*)(ws + OFF_HQ); }
    DI h16* lf() const { return (h16*)(ws + OFF_LF); }
    DI u16* viT() const { return (u16*)(ws + OFF_VIT); }
    DI u16* hz() const { return (u16*)(ws + OFF_HZ); }
    DI u16* aq() const { return (u16*)(ws + OFF_AQ); }
    DI u16* ak() const { return (u16*)(ws + OFF_AK); }
    DI u16* av() const { return (u16*)(ws + OFF_AV); }
    DI u16* az() const { return (u16*)(ws + OFF_AZ); }
    DI u16* ST() const { return (u16*)(ws + OFF_ST); }
    DI float* dec() const { return (float*)(ws + OFF_DEC); }
    DI u16* ao0() const { return (u16*)(ws + OFF_XB); }
    DI u16* ao1() const { return (u16*)(ws + OFF_XB + 16 * MB); }
    DI u16* ao2() const { return (u16*)(ws + OFF_AO2); }
    DI float* lse() const { return (float*)(ws + OFF_LSE); }
    DI u16* mixed() const { return (u16*)(ws + OFF_AQ); }
    DI float* rowss() const { return (float*)(ws + OFF_ROWSS); }
    DI unsigned* pcnt() const { return (unsigned*)(ws + OFF_PCNT); }
    DI unsigned* bar() const { return (unsigned*)(ws + OFF_BAR); }
};

DI unsigned pack2(float a, float b) { f2_t v = {a, b}; return __builtin_bit_cast(unsigned, __builtin_convertvector(v, bf2_t)); }
DI u16 f2bf(float x) { return (u16)(pack2(x, 0.f) & 0xffffu); }
DI float bf2f(u16 v) { return __uint_as_float(((unsigned)v) << 16); }
DI float bflo(unsigned v) { return __uint_as_float(v << 16); }
DI float bfhi(unsigned v) { return __uint_as_float(v & 0xffff0000u); }
DI int crow(int reg, int h) { return (reg & 3) + 8 * (reg >> 2) + 4 * h; }
DI float silu(float v) { return v / (1.f + __expf(-v)); }
DI bf16x8 packB(const f32x16& x, int s) {
    u32x4 pk;
    pk[0] = pack2(x[8 * s + 0], x[8 * s + 1]); pk[1] = pack2(x[8 * s + 2], x[8 * s + 3]);
    pk[2] = pack2(x[8 * s + 4], x[8 * s + 5]); pk[3] = pack2(x[8 * s + 6], x[8 * s + 7]);
    return __builtin_bit_cast(bf16x8, pk);
}
DI float kfromlf(float v) { return (v > -0.02f) ? -v * (1.f + v * (0.5f + v * (1.f / 6.f))) : 1.f - __expf(v); }


#define XB_TMO      128
#define XB_XCNT(j)  (256  + 64 * (j))
#define XB_XSUB(j)  (1280 + 64 * (j))
#define XB_XGEN(j)  (2304 + 64 * (j))
#define XB_TOP      3328
#define XB_TOPGEN   3392
#define XCD_BAR_WORDS 3456
#define XB_SPIN_CAP (1u << 22)
#define LAS __attribute__((address_space(3)))
DI unsigned xb_ld(unsigned* p) { return __hip_atomic_load(p, __ATOMIC_RELAXED, __HIP_MEMORY_SCOPE_AGENT); }
DI unsigned xb_add(unsigned* p, unsigned v) { return __hip_atomic_fetch_add(p, v, __ATOMIC_RELAXED, __HIP_MEMORY_SCOPE_AGENT); }
DI unsigned xb_xcc_id() { return (unsigned)__builtin_amdgcn_s_getreg((3 << 11) | 20) & 0xFu; }
#define XB_SPIN(cond, bar) do { unsigned _sp = 0; while (cond) { __builtin_amdgcn_s_sleep(1); \
    if ((++_sp & 255u) == 0u) { if (xb_ld(&(bar)[XB_TMO])) break; if (_sp > XB_SPIN_CAP) { atomicAdd(&(bar)[XB_TMO], 1u); break; } } } } while (0)
struct XcdBarrier { unsigned* bar; unsigned x; volatile unsigned* st; };
DI XcdBarrier xcd_barrier_post(unsigned* bar, volatile unsigned* st) {
    XcdBarrier b; b.bar = bar; b.x = xb_xcc_id(); b.st = st;
    if (threadIdx.x == 0) (void)xb_add(&bar[XB_XCNT(b.x)], 1u);
    return b;
}
DI void xcd_barrier_complete(unsigned* bar, unsigned x, unsigned& nloc, unsigned& nx) {
    const unsigned G = gridDim.x * gridDim.y * gridDim.z;
    unsigned sum, cnt, mine, sp = 0u;
    for (;;) {
        sum = 0u; cnt = 0u; mine = 0u;
#pragma unroll
        for (unsigned j = 0; j < 16; ++j) { const unsigned c = xb_ld(&bar[XB_XCNT(j)]); sum += c; cnt += (c > 0u) ? 1u : 0u; mine = (j == x) ? c : mine; }
        if (sum == G) break;
        __builtin_amdgcn_s_sleep(1);
        if ((++sp & 255u) == 0u) { if (xb_ld(&bar[XB_TMO])) break; if (sp > XB_SPIN_CAP) { atomicAdd(&bar[XB_TMO], 1u); break; } }
    }
    nloc = mine > 0u ? mine : 1u; nx = cnt > 0u ? cnt : 1u;
}
DI void xcd_barrier(const XcdBarrier& b) {
    asm volatile("s_waitcnt vmcnt(0)" ::: "memory");
    __syncthreads();
    if (threadIdx.x == 0) {
        unsigned* bar = b.bar;
        __builtin_amdgcn_s_waitcnt(0);
        unsigned nloc = b.st[0], nx = b.st[1];
        if (nloc == 0u) { xcd_barrier_complete(bar, b.x, nloc, nx); b.st[0] = nloc; b.st[1] = nx; }
        const unsigned old = xb_add(&bar[XB_XSUB(b.x)], 1u);
        const unsigned gen = old / nloc;
        if (old + 1u == (gen + 1u) * nloc) {
            __builtin_amdgcn_fence(__ATOMIC_RELEASE, "agent");
            asm volatile("s_waitcnt vmcnt(0)" ::: "memory");
            const unsigned og = xb_add(&bar[XB_TOP], 1u);
            const unsigned tg = og / nx;
            if (og + 1u == (tg + 1u) * nx) xb_add(&bar[XB_TOPGEN], 1u);
            else XB_SPIN(xb_ld(&bar[XB_TOPGEN]) == tg, bar);
            __builtin_amdgcn_fence(__ATOMIC_ACQUIRE, "agent");
            xb_add(&bar[XB_XGEN(b.x)], 1u);
            asm volatile("s_waitcnt vmcnt(0)" ::: "memory");
        } else {
            XB_SPIN(xb_ld(&bar[XB_XGEN(b.x)]) == gen, bar);
            __builtin_amdgcn_fence(__ATOMIC_ACQUIRE, "agent");
            asm volatile("s_waitcnt vmcnt(0)" ::: "memory");
        }
    }
    __syncthreads();
}

constexpr int VSMEM_C = 4 * 128 * 144;
DI void vsync(char* smem, unsigned& gen) {
    __attribute__((address_space(3))) unsigned* ctr = (__attribute__((address_space(3))) unsigned*)(smem + VSMEM_C - 16);
    gen += 4u;
    __builtin_amdgcn_fence(__ATOMIC_RELEASE, "workgroup");
    if ((threadIdx.x & 63u) == 0u) (void)__hip_atomic_fetch_add(ctr, 1u, __ATOMIC_RELAXED, __HIP_MEMORY_SCOPE_WORKGROUP);
    unsigned sp = 0u;
    while (__hip_atomic_load(ctr, __ATOMIC_RELAXED, __HIP_MEMORY_SCOPE_WORKGROUP) < gen) { __builtin_amdgcn_s_sleep(1); if (++sp > (1u << 22)) break; }
    __builtin_amdgcn_fence(__ATOMIC_ACQUIRE, "workgroup");
}

DI void phase0(const P& p, char* smem) {
    int tid = VTID;
    asm volatile("" : "+v"(tid));
    const int lane = tid & 63, wid = tid >> 6;
    for (int row = VB * 4 + wid; row < NTOK; row += VGRID * 4) {
        const float4* xr = (const float4*)(p.x + (size_t)row * DM);
        float4 v[4]; float ss = 0.f;
#pragma unroll
        for (int i = 0; i < 4; ++i) { typedef float f4v __attribute__((ext_vector_type(4))); const f4v t4 = __builtin_nontemporal_load((const f4v*)(xr + lane + 64 * i)); v[i] = make_float4(t4[0], t4[1], t4[2], t4[3]); ss += v[i].x * v[i].x + v[i].y * v[i].y + v[i].z * v[i].z + v[i].w * v[i].w; }
#pragma unroll
        for (int o = 32; o >= 1; o >>= 1) ss += __shfl_xor(ss, o);
        uint2* xo = (uint2*)(p.xb() + (size_t)row * DM);
#pragma unroll
        for (int i = 0; i < 4; ++i) xo[lane + 64 * i] = make_uint2(pack2(v[i].x, v[i].y), pack2(v[i].z, v[i].w));
        if (lane == 0) p.rs()[row] = rsqrtf(ss * (1.f / 1024.f) + EPS);
    }
    float* tile = (float*)smem;
    for (int t = VB; t < 1024 + 256; t += VGRID) {
        const float* src; u16* dst; int ncols, td, tc; bool scale;
        if (t < 1024) { src = p.w_in; dst = p.winT(); ncols = 4096; td = t >> 6; tc = t & 63; scale = true; }
        else { const int t2 = t - 1024; src = p.w_out; dst = p.woutT(); ncols = 1024; td = t2 >> 4; tc = t2 & 15; scale = false; }
#pragma unroll
        for (int i = 0; i < 4; ++i) {
            const int r = (tid >> 4) + 16 * i, c4 = (tid & 15) * 4;
            float4 v = *(const float4*)(src + (size_t)(td * 64 + r) * ncols + tc * 64 + c4);
            const float s = scale ? p.norm_w[td * 64 + r] : 1.f;
            tile[r * 65 + c4 + 0] = v.x * s; tile[r * 65 + c4 + 1] = v.y * s; tile[r * 65 + c4 + 2] = v.z * s; tile[r * 65 + c4 + 3] = v.w * s;
        }
        __syncthreads();
#pragma unroll
        for (int u = 0; u < 2; ++u) {
            const int g = (tid & 3) + 4 * u, c = tid >> 2;
            float e[8];
#pragma unroll
            for (int j = 0; j < 8; ++j) e[j] = tile[(g * 8 + j) * 65 + c];
            u32x4 pk; pk[0] = pack2(e[0], e[1]); pk[1] = pack2(e[2], e[3]); pk[2] = pack2(e[4], e[5]); pk[3] = pack2(e[6], e[7]);
            int orow = tc * 64 + c;
            if (scale && orow >= 2048 && orow < 3072) { const int d = orow & 63; orow = (orow & ~63) + ((d & 31) << 1) + (d >> 5); }
            *(u32x4*)(dst + (size_t)orow * 1024 + td * 64 + g * 8) = pk;
        }
        __syncthreads();
    }
    for (int idx = VB * 256 + tid; idx < SEQ * 32; idx += VGRID * 256) {
        const int pos = idx >> 5, j = idx & 31;
        const float inv = (float)(1.0 / exp2((double)j * (13.287712379549449 / 32.0)));
        const float ang = (float)pos * inv;
        const double rev = (double)ang * 0.15915494309189535;
        const float fr = (float)(rev - floor(rev));
        p.rope()[idx] = __builtin_amdgcn_cosf(fr);
        p.rope()[SEQ * 32 + idx] = __builtin_amdgcn_sinf(fr);
    }
}

namespace pg8 {
#define PG8_LAS __attribute__((address_space(3)))
typedef unsigned short bf16_t;
typedef short bf16x8 __attribute__((ext_vector_type(8)));
typedef float f32x4 __attribute__((ext_vector_type(4)));
typedef unsigned u32x4 __attribute__((ext_vector_type(4)));
constexpr int BM = 256, BK = 64, HALF = 128, HTB = HALF * BK * 2  , STAGE_BYTES = 8 * HTB, NXCD = 8, WGM = 8;

__host__ __device__ __forceinline__ int lds_byte(int r, int c) { const int st = (r >> 4) * 2 + (c >> 5), rr = r & 15, cc = c & 31, ob = rr * 64 + cc * 2; return st * 1024 + (ob ^ (((ob >> 9) & 1) << 5)); }
__host__ __device__ __forceinline__ void stage_rc(int b, int& R, int& C) { const int st = b / 1024, sb = b % 1024, swz = sb ^ (((sb >> 9) & 1) << 5); R = (st >> 1) * 16 + swz / 64; C = (st & 1) * 32 + (swz % 64) / 2; }
__host__ __device__ __forceinline__ int perm32(int rho) { const int n = rho >> 4, i = rho & 15; return 8 * (i >> 2) + 4 * n + (i & 3); }

struct Unit { int pm, pn; };
struct Gemm { const bf16_t* A; const bf16_t* Bt; int M, N, K; };

struct StaticOrder {
    int nM, nN, nwg, G, c;
    __host__ __device__ void init(int M, int N, int G_, int c_) { nM = M / BM; nN = N / BM; nwg = nM * nN; G = G_; c = c_; }
    __host__ __device__ bool next(int i, Unit& u) const {
        const long L = (long)i * G + c; if (L >= nwg) return false;
        int wgid = (int)L; { const int q = nwg / NXCD, r = nwg % NXCD, xcd = wgid % NXCD, off = wgid / NXCD; wgid = (xcd < r ? xcd * (q + 1) : r * (q + 1) + (xcd - r) * q) + off; }
        const int nig = WGM * nN, gid = wgid / nig, fm = gid * WGM, gsz = (nM - fm) < WGM ? (nM - fm) : WGM;
        u.pm = fm + ((wgid % nig) % gsz); u.pn = (wgid % nig) / gsz; return true;
    }
    __device__ __forceinline__ void a_ready(const Unit&) const {}
    __device__ __forceinline__ void done(const Unit&) const {}
};
template <class Epi, class Sched, bool STAMP = false>
__device__ __forceinline__ void gemm_phase(PG8_LAS unsigned char* lds, const Gemm g, const Sched& S, const Epi& E, unsigned long long* stamps) {
    const int tid = threadIdx.x, wid = __builtin_amdgcn_readfirstlane(tid >> 6), lane = tid & 63, wr = wid >> 2, wc = wid & 3, fr = lane & 15, fq = lane >> 4;
    const int K = g.K, nt = K / BK;
    int ts_lo = 0, ts_hi = 0, nts = 0; const unsigned long long rt_entry = STAMP ? (unsigned long long)wall_clock64() : 0ull;
#define PG8_STAMP() do { if (STAMP && wid == 0 && nts < 64) { const unsigned long long _c = (unsigned long long)clock64(); \
        ts_lo = (lane == nts) ? (int)(unsigned)_c : ts_lo; ts_hi = (lane == nts) ? (int)(unsigned)(_c >> 32) : ts_hi; ++nts; } } while (0)
    PG8_STAMP();
    unsigned voffA[2], voffB[2];
#pragma unroll
    for (int i = 0; i < 2; ++i) { int R, C; stage_rc(tid * 16 + i * 8192, R, C); const int Rb = Epi::PERM ? ((R & ~31) + perm32(R & 31)) : R;
        voffA[i] = (unsigned)(R * K + C) * 2u; voffB[i] = (unsigned)(Rb * K + C) * 2u; }
    const size_t kstep = (size_t)(BK * 2);
    const size_t hstep = (size_t)HALF * K * 2;
    const size_t tstep = 2 * hstep;
    const unsigned ldsw = (unsigned)wid * 1024u;
    const int aoff = lds_byte(wr * 64 + fr, fq * 8), boff = lds_byte(wc * 32 + fr, fq * 8);
#define PG8_SA(b, h) (((b) * 2 + (h)) * HTB)
#define PG8_SB(b, h) ((4 + (b) * 2 + (h)) * HTB)
#define PG8_STAGE(bufoff, gbase, voff) do { _Pragma("unroll") for (int _i = 0; _i < 2; ++_i) \
        __builtin_amdgcn_global_load_lds((const unsigned*)((const char*)(gbase) + (voff)[_i]), (PG8_LAS unsigned*)(lds + (bufoff) + ldsw + _i * 8192), 16, 0, 0); } while (0)
#define PG8_LDA(dst, b, h) do { _Pragma("unroll") for (int m = 0; m < 4; ++m) _Pragma("unroll") for (int k = 0; k < 2; ++k) dst[m][k] = *(const PG8_LAS bf16x8*)(lds + PG8_SA(b, h) + aoff + m * 2048 + k * 1024); } while (0)
#define PG8_LDB(dst, b, h) do { _Pragma("unroll") for (int n = 0; n < 2; ++n) _Pragma("unroll") for (int k = 0; k < 2; ++k) dst[n][k] = *(const PG8_LAS bf16x8*)(lds + PG8_SB(b, h) + boff + n * 2048 + k * 1024); } while (0)
#define PG8_MMA(ai, bj, At, Bt) do { __builtin_amdgcn_s_setprio(1); _Pragma("unroll") for (int m = 0; m < 4; ++m) _Pragma("unroll") for (int n = 0; n < 2; ++n) _Pragma("unroll") for (int k = 0; k < 2; ++k) \
        acc[ai][bj][m][n] = __builtin_amdgcn_mfma_f32_16x16x32_bf16(Bt[n][k], At[m][k], acc[ai][bj][m][n], 0, 0, 0); __builtin_amdgcn_s_setprio(0); } while (0)
#define PG8_WAIT_V(n) asm volatile("s_waitcnt vmcnt(" #n ")" ::: "memory")
#define PG8_WAIT_L(n) asm volatile("s_waitcnt lgkmcnt(" #n ")" ::: "memory")
#define PG8_BAR __builtin_amdgcn_s_barrier()
#define PG8_SCHED __builtin_amdgcn_sched_barrier(0)
    Unit cur, nxt; int ui = 0;
    if (!S.next(0, cur)) return;
    f32x4 acc[2][2][4][2];
#pragma unroll
    for (int a = 0; a < 2; ++a)
#pragma unroll
        for (int b = 0; b < 2; ++b)
#pragma unroll
            for (int m = 0; m < 4; ++m)
#pragma unroll
                for (int n = 0; n < 2; ++n) acc[a][b][m][n] = (f32x4){0.f, 0.f, 0.f, 0.f};
    bf16x8 At[4][2], B0[2][2], B1[2][2];
    const char* cA = (const char*)g.A + (size_t)cur.pm * tstep; const char* cB = (const char*)g.Bt + (size_t)cur.pn * tstep;
    S.a_ready(cur);
    PG8_STAGE(PG8_SB(0, 0), cB, voffB); PG8_STAGE(PG8_SA(0, 0), cA, voffA); PG8_STAGE(PG8_SB(0, 1), cB + hstep, voffB); PG8_STAGE(PG8_SA(0, 1), cA + hstep, voffA);
    if (wr == 1) PG8_BAR;
    PG8_WAIT_V(4); PG8_BAR;
    PG8_STAGE(PG8_SB(1, 0), cB + kstep, voffB); PG8_STAGE(PG8_SA(1, 0), cA + kstep, voffA); PG8_STAGE(PG8_SB(1, 1), cB + hstep + kstep, voffB);
    PG8_WAIT_V(6); PG8_BAR;
    PG8_STAMP();
    for (;;) {
        const bool has_next = S.next(ui + 1, nxt);
        const char* nA = has_next ? (const char*)g.A + (size_t)nxt.pm * tstep : cA; const char* nB = has_next ? (const char*)g.Bt + (size_t)nxt.pn * tstep : cB;
        for (int t = 0; t < nt; t += 2) {
            const bool last = (t == nt - 2);
            const char* a1 = cA + (size_t)(t + 1) * kstep;
            const char* a2 = last ? nA : cA + (size_t)(t + 2) * kstep; const char* b2 = last ? nB : cB + (size_t)(t + 2) * kstep;
            const char* a3 = a2 + kstep; const char* b3 = b2 + kstep;
            if (last && has_next) S.a_ready(nxt);
            PG8_LDB(B0, 0, 0); PG8_SCHED; PG8_LDA(At, 0, 0); PG8_STAGE(PG8_SA(1, 1), a1 + hstep, voffA);
            PG8_WAIT_L(8); PG8_BAR; PG8_WAIT_L(0); PG8_MMA(0, 0, At, B0); PG8_BAR; PG8_SCHED;
            PG8_LDB(B1, 0, 1); PG8_STAGE(PG8_SB(0, 0), b2, voffB);
            PG8_BAR; PG8_WAIT_L(0); PG8_MMA(0, 1, At, B1); PG8_BAR;
            PG8_LDA(At, 0, 1); PG8_STAGE(PG8_SA(0, 0), a2, voffA);
            PG8_BAR; PG8_WAIT_L(0); PG8_MMA(1, 0, At, B0); PG8_BAR; PG8_SCHED;
            PG8_STAGE(PG8_SB(0, 1), b2 + hstep, voffB);
            PG8_WAIT_V(6); PG8_BAR; PG8_MMA(1, 1, At, B1); PG8_BAR;
            PG8_LDB(B0, 1, 0); PG8_SCHED; PG8_LDA(At, 1, 0); PG8_STAGE(PG8_SA(0, 1), a2 + hstep, voffA);
            PG8_WAIT_L(8); PG8_BAR; PG8_WAIT_L(0); PG8_MMA(0, 0, At, B0); PG8_BAR; PG8_SCHED;
            PG8_LDB(B1, 1, 1); PG8_STAGE(PG8_SB(1, 0), b3, voffB);
            PG8_BAR; PG8_WAIT_L(0); PG8_MMA(0, 1, At, B1); PG8_BAR;
            PG8_LDA(At, 1, 1); PG8_STAGE(PG8_SA(1, 0), a3, voffA);
            PG8_BAR; PG8_WAIT_L(0); PG8_MMA(1, 0, At, B0); PG8_BAR; PG8_SCHED;
            PG8_STAGE(PG8_SB(1, 1), b3 + hstep, voffB);
            PG8_WAIT_V(6); PG8_BAR; PG8_MMA(1, 1, At, B1); PG8_BAR;
        }
        PG8_STAMP();
        if constexpr (!Epi::AFTER_DRAIN) { E(acc, cur, wr, wc, fr, fq); S.done(cur); }
        PG8_STAMP();
        if (!has_next) break;
#pragma unroll
        for (int a = 0; a < 2; ++a)
#pragma unroll
            for (int b = 0; b < 2; ++b)
#pragma unroll
                for (int m = 0; m < 4; ++m)
#pragma unroll
                    for (int n = 0; n < 2; ++n) acc[a][b][m][n] = (f32x4){0.f, 0.f, 0.f, 0.f};
        cur = nxt; cA = nA; cB = nB; ++ui;
    }
    PG8_WAIT_V(0);
    if (wr == 0) PG8_BAR;
    PG8_BAR;
    if constexpr (Epi::AFTER_DRAIN) { E.fused(acc, cur, wr, wc, fr, fq, lds, wid, lane); S.done(cur); }
    PG8_STAMP();
    if (STAMP && wid == 0) { stamps[lane] = lane < nts ? (((unsigned long long)(unsigned)ts_hi << 32) | (unsigned)ts_lo) : 0ull;
        if (lane == 62) stamps[62] = rt_entry; if (lane == 63) stamps[63] = (unsigned long long)wall_clock64(); }
#undef PG8_STAMP
#undef PG8_SA
#undef PG8_SB
#undef PG8_STAGE
#undef PG8_LDA
#undef PG8_LDB
#undef PG8_MMA
#undef PG8_WAIT_V
#undef PG8_WAIT_L
#undef PG8_BAR
#undef PG8_SCHED
}
}


struct EpiIn {
    static constexpr bool PERM = true, AFTER_DRAIN = false;
    P p;
    template <int GRP> DI void run(const pg8::f32x4 (&acc)[2][2][4][2], const pg8::Unit& u, int wr, int wc, int fr, int fq) const {
        const int cg0 = (u.pn & 1) * 256 + wc * 32 + fq * 8;
        const int row0 = u.pm * 256 + wr * 64 + fr;
        float oml[2][8];
        if (GRP == 1) {
#pragma unroll
            for (int bj = 0; bj < 2; ++bj) {
                const float* l0 = p.lbl + cg0 + 128 * bj;
#pragma unroll
                for (int j = 0; j < 8; ++j) {
                    float lb = __builtin_amdgcn_rcpf(1.f + __builtin_amdgcn_exp2f((l0[512 + j] - l0[j]) * LOG2E));
                    lb = fminf(fmaxf(lb, 1e-6f), 1.f - 1e-6f);
                    oml[bj][j] = 1.f - lb;
                }
            }
        }
        float rsv[2][4];
#pragma unroll
        for (int ai = 0; ai < 2; ++ai)
#pragma unroll
            for (int m = 0; m < 4; ++m) rsv[ai][m] = p.rs()[row0 + 128 * ai + 16 * m];
#pragma unroll
        for (int ai = 0; ai < 2; ++ai)
#pragma unroll
            for (int m = 0; m < 4; ++m) {
                const int row = row0 + 128 * ai + 16 * m;
                const float rs = rsv[ai][m];
#pragma unroll
                for (int bj = 0; bj < 2; ++bj) {
                    const int cg = cg0 + 128 * bj;
                    float v[8];
#pragma unroll
                    for (int j = 0; j < 8; ++j) v[j] = acc[ai][bj][m][j >> 2][j & 3] * rs;
                    if (GRP == 2) {
                        const int b = row >> 13, t = row & 8191;
                        u16* dst = p.viT() + ((size_t)(b * 512 + cg)) * 8192 + t;
#pragma unroll
                        for (int j = 0; j < 8; ++j) dst[(size_t)j * 8192] = f2bf(v[j]);
                    } else if (GRP == 1) {
                        typedef _Float16 h16x8 __attribute__((ext_vector_type(8)));
                        h16x8 hv;
#pragma unroll
                        for (int j = 0; j < 8; ++j) hv[j] = (h16)(__builtin_amdgcn_logf(1.f - oml[bj][j] * __builtin_amdgcn_rcpf(1.f + __builtin_amdgcn_exp2f(v[j] * LOG2E))) * 0.6931471805599453f);
                        *(h16x8*)(p.lf() + ((size_t)((row >> 13) * 4 + (cg >> 7)) * 8192 + (row & 8191)) * 128 + (cg & 127)) = hv;
                    } else {
                        float o[8];
                        if (GRP == 0 || GRP == 3 || GRP == 7) {
#pragma unroll
                            for (int j = 0; j < 8; ++j) o[j] = v[j] * __builtin_amdgcn_rcpf(1.f + __builtin_amdgcn_exp2f(-v[j] * LOG2E));
                        } else if (GRP == 6) {
#pragma unroll
                            for (int j = 0; j < 8; ++j) o[j] = v[j];
                        } else {
                            const float sc = (GRP == 4) ? 0.125f : 1.f;
                            const int f0 = (cg & 63) >> 1, pos = row & 8191;
                            const float4 c4 = *(const float4*)(p.rope() + pos * 32 + f0), s4 = *(const float4*)(p.rope() + SEQ * 32 + pos * 32 + f0);
                            const float cs[4] = {c4.x, c4.y, c4.z, c4.w}, sn[4] = {s4.x, s4.y, s4.z, s4.w};
#pragma unroll
                            for (int i = 0; i < 4; ++i) {
                                o[2 * i] = (v[2 * i] * cs[i] - v[2 * i + 1] * sn[i]) * sc;
                                o[2 * i + 1] = (v[2 * i + 1] * cs[i] + v[2 * i] * sn[i]) * sc;
                            }
                        }
                        const size_t doff = (GRP == 4 || GRP == 5 || GRP == 6) ? ((size_t)((row >> 13) * 8 + (cg >> 6)) * 8192 + (row & 8191)) * 64 + (cg & 63)
                                                                                : ((size_t)((row >> 13) * 4 + (cg >> 7)) * 8192 + (row & 8191)) * 128 + (cg & 127);
                        u16* dst = ((GRP == 0) ? p.hq() : (GRP == 3) ? p.hz() : (GRP == 4) ? p.aq() : (GRP == 5) ? p.ak() : (GRP == 6) ? p.av() : p.az()) + doff;
                        u32x4 pk; pk[0] = pack2(o[0], o[1]); pk[1] = pack2(o[2], o[3]); pk[2] = pack2(o[4], o[5]); pk[3] = pack2(o[6], o[7]);
                        *(u32x4*)dst = pk;
                    }
                }
            }
    }
    DI void operator()(const pg8::f32x4 (&acc)[2][2][4][2], const pg8::Unit& u, int wr, int wc, int fr, int fq) const {
        switch (u.pn >> 1) {
            case 0: run<0>(acc, u, wr, wc, fr, fq); break;
            case 1: run<1>(acc, u, wr, wc, fr, fq); break;
            case 2: run<2>(acc, u, wr, wc, fr, fq); break;
            case 3: run<3>(acc, u, wr, wc, fr, fq); break;
            case 4: run<4>(acc, u, wr, wc, fr, fq); break;
            case 5: run<5>(acc, u, wr, wc, fr, fq); break;
            case 6: run<6>(acc, u, wr, wc, fr, fq); break;
            default: run<7>(acc, u, wr, wc, fr, fq); break;
        }
    }
};

DI void pass1(const P& p, char* smem, int item, unsigned& vgen) {
    int tid = VTID;
    asm volatile("" : "+v"(tid));
    const int lane = tid & 63, wid = tid >> 6, l31 = lane & 31, lh = lane >> 5;
    const int bh = item >> 7, c = item & 127, b = bh >> 2, h = bh & 3;
    const size_t m0 = (size_t)b * 8192 + c * 64;
    float* tot = (float*)smem;
    char* kdT = smem + 1024;
    const int k = tid & 127, half = tid >> 7;
    const h16* lfp = p.lf() + ((size_t)(b * 4 + h) * 8192 + c * 64 + half * 32) * 128 + k;
    float v[32]; float T = 0.f;
#pragma unroll
    for (int i = 0; i < 32; ++i) { v[i] = (float)lfp[(size_t)i * 128]; T += v[i]; }
    tot[half * 128 + k] = T;
    vsync(smem, vgen);
    const float other = tot[(half ^ 1) * 128 + k];
    float suf = (half == 0) ? other : 0.f;
    float kd[32];
#pragma unroll
    for (int i = 31; i >= 0; --i) { kd[i] = kfromlf(v[i]) * __expf(suf); suf += v[i]; }
#pragma unroll
    for (int q = 0; q < 4; ++q) {
        u32x4 pk;
        pk[0] = pack2(kd[8 * q + 0], kd[8 * q + 1]); pk[1] = pack2(kd[8 * q + 2], kd[8 * q + 3]);
        pk[2] = pack2(kd[8 * q + 4], kd[8 * q + 5]); pk[3] = pack2(kd[8 * q + 6], kd[8 * q + 7]);
        *(u32x4*)(kdT + k * 144 + half * 64 + q * 16) = pk;
    }
    if (half == 0) p.dec()[(size_t)item * 128 + k] = __expf(T + other);
    vsync(smem, vgen);
    const u16* vrow = p.viT() + ((size_t)(b * 512 + h * 128 + wid * 32 + l31)) * 8192 + c * 64;
    f32x16 acc[4];
#pragma unroll
    for (int n = 0; n < 4; ++n)
#pragma unroll
        for (int r = 0; r < 16; ++r) acc[n][r] = 0.f;
#pragma unroll
    for (int ks = 0; ks < 4; ++ks) {
        const bf16x8 a = *(const bf16x8*)(vrow + ks * 16 + lh * 8);
#pragma unroll
        for (int nt = 0; nt < 4; ++nt) {
            const bf16x8 bb = *(const bf16x8*)(kdT + (nt * 32 + l31) * 144 + (ks * 16 + lh * 8) * 2);
            acc[nt] = MFMA32(a, bb, acc[nt]);
        }
    }
    u16* so = p.ST() + (size_t)item * 16384;
#pragma unroll
    for (int nt = 0; nt < 4; ++nt)
#pragma unroll
        for (int r = 0; r < 16; ++r) so[(wid * 32 + crow(r, lh)) * 128 + nt * 32 + l31] = f2bf(acc[nt][r]);
    vsync(smem, vgen);
}

DI void pass2(const P& p) {
    int tid = VTID;
    asm volatile("" : "+v"(tid));
    if ((threadIdx.x >> 8) == 0u)
    for (int e = (int)blockIdx.x * 256 + tid; e < 65536; e += (int)gridDim.x * 256) {
        const int bh = e >> 13, rem = e & 8191, k2 = (rem & 63) * 2;
        unsigned* st = (unsigned*)p.ST() + (size_t)bh * 128 * 8192 + rem;
        const float2* dc = (const float2*)(p.dec() + (size_t)bh * 128 * 128 + k2);
        float r0 = 0.f, r1 = 0.f;
        for (int c0 = 0; c0 < 128; c0 += 8) {
            unsigned s[8]; float2 d[8];
#pragma unroll
            for (int j = 0; j < 8; ++j) { s[j] = st[(size_t)(c0 + j) * 8192]; d[j] = dc[(c0 + j) * 64]; }
#pragma unroll
            for (int j = 0; j < 8; ++j) {
                st[(size_t)(c0 + j) * 8192] = pack2(r0, r1);
                r0 = d[j].x * r0 + bflo(s[j]); r1 = d[j].y * r1 + bfhi(s[j]);
            }
        }
    }
}

DI void attn_item(const P& p, char* smem, int item, bool reuse, int par, unsigned& vgen) {
    int tid = VTID;
    asm volatile("" : "+v"(tid));
    const int lane = tid & 63, wid = tid >> 6, l31 = lane & 31, lh = lane >> 5;
    const int pat = item >> 10, idx = item & 1023;
    const int dl = pat * 2, d = 1 << dl, nblk = 64 >> dl;
    const int nb = idx & (nblk - 1);
    int rest = idx >> (6 - dl);
    const int r = rest & (d - 1); rest >>= dl;
    const int hh = rest & 7, b = rest >> 3;
    char* Ks = smem;
    char* VT = smem + 256 * 144;
    const size_t tokbase = ((size_t)b * 8 + hh) * 8192;
    {
        const int c8 = tid & 7, kr = tid >> 3;
#pragma unroll
        for (int i = 0; i < 8; ++i) {
            const int lkey = kr + 32 * i;
            const int j = nb * 128 - 128 + lkey;
            const int key = (lkey & 127) + 128 * ((i >> 2) ^ par ^ 1);
            if (j >= 0 && !(reuse && i < 4)) {
                const size_t off = (tokbase + (size_t)j * d + r) * 64 + c8 * 8;
                const u32x4 kv = *(const u32x4*)(p.ak() + off);
                const u32x4 vv = *(const u32x4*)(p.av() + off);
                *(u32x4*)(Ks + key * 144 + c8 * 16) = kv;
#pragma unroll
                for (int e = 0; e < 4; ++e) {
                    *(u16*)(VT + (c8 * 8 + 2 * e) * 520 + key * 2) = (u16)(vv[e] & 0xffffu);
                    *(u16*)(VT + (c8 * 8 + 2 * e + 1) * 520 + key * 2) = (u16)(vv[e] >> 16);
                }
            }
        }
    }
    const int jq = nb * 128 + wid * 32 + l31;
    const size_t mq = tokbase + (size_t)jq * d + r;
    bf16x8 qf[4];
#pragma unroll
    for (int ks = 0; ks < 4; ++ks) qf[ks] = *(const bf16x8*)(p.aq() + mq * 64 + ks * 16 + lh * 8);
    vsync(smem, vgen);
    const int kt_lo = (nb == 0) ? 4 : 0;
    f32x16 st[5];
    float mx = -INFINITY;
#pragma unroll
    for (int i = 0; i < 5; ++i) {
        const int kt = wid + i;
        const int pkt = (kt & 3) + 4 * ((kt >> 2) ^ par ^ 1);
        if (kt >= kt_lo) {
#pragma unroll
            for (int rr = 0; rr < 16; ++rr) st[i][rr] = 0.f;
#pragma unroll
            for (int ks = 0; ks < 4; ++ks) {
                const bf16x8 a = *(const bf16x8*)(Ks + (pkt * 32 + l31) * 144 + (ks * 16 + lh * 8) * 2);
                st[i] = MFMA32(a, qf[ks], st[i]);
            }
#pragma unroll
            for (int rr = 0; rr < 16; ++rr) {
                const int dist = wid * 32 + l31 + 128 - (kt * 32 + crow(rr, lh));
                if (dist < 0 || dist > 128) st[i][rr] = -INFINITY;
                mx = fmaxf(mx, st[i][rr]);
            }
        } else {
#pragma unroll
            for (int rr = 0; rr < 16; ++rr) st[i][rr] = -INFINITY;
        }
    }
    mx = fmaxf(mx, __shfl_xor(mx, 32));
    float l = 0.f;
    const float mxs = mx * LOG2E;
#pragma unroll
    for (int i = 0; i < 5; ++i)
#pragma unroll
        for (int rr = 0; rr < 16; ++rr) { const float e = __builtin_amdgcn_exp2f(st[i][rr] * LOG2E - mxs); st[i][rr] = e; l += e; }
    l += __shfl_xor(l, 32);
    f32x16 o[2];
#pragma unroll
    for (int dt = 0; dt < 2; ++dt)
#pragma unroll
        for (int rr = 0; rr < 16; ++rr) o[dt][rr] = 0.f;
#pragma unroll
    for (int i = 0; i < 5; ++i) {
        const int kt = wid + i;
        const int pkt = (kt & 3) + 4 * ((kt >> 2) ^ par ^ 1);
        if (kt >= kt_lo) {
#pragma unroll
            for (int ks2 = 0; ks2 < 2; ++ks2) {
                const bf16x8 bq = packB(st[i], ks2);
#pragma unroll
                for (int dt = 0; dt < 2; ++dt) {
                    const char* ad = VT + (dt * 32 + l31) * 520 + (pkt * 32 + ks2 * 16 + lh * 4) * 2;
                    const uint2 lo = *(const uint2*)ad, hi = *(const uint2*)(ad + 16);
                    u32x4 av4; av4[0] = lo.x; av4[1] = lo.y; av4[2] = hi.x; av4[3] = hi.y;
                    o[dt] = MFMA32(__builtin_bit_cast(bf16x8, av4), bq, o[dt]);
                }
            }
        }
    }
    const float inv = 1.f / l;
    u16* op = (pat == 0 ? p.ao0() : (pat == 1 ? p.ao1() : p.ao2())) + mq * 64;
#pragma unroll
    for (int dt = 0; dt < 2; ++dt)
#pragma unroll
        for (int g4 = 0; g4 < 4; ++g4)
            *(uint2*)(op + dt * 32 + g4 * 8 + lh * 4) = make_uint2(pack2(o[dt][g4 * 4] * inv, o[dt][g4 * 4 + 1] * inv), pack2(o[dt][g4 * 4 + 2] * inv, o[dt][g4 * 4 + 3] * inv));
    if (lh == 0) p.lse()[((size_t)pat * NTOK + (size_t)b * 8192 + (size_t)jq * d + r) * 8 + hh] = mx + __logf(l);
    vsync(smem, vgen);
}

DI void pass3(const P& p, char* smem, int item, unsigned& vgen) {
    int tid = VTID;
    asm volatile("" : "+v"(tid));
    const int lane = tid & 63, wid = tid >> 6, l31 = lane & 31, lh = lane >> 5;
    const int bh = item >> 7, c = item & 127, b = bh >> 2, h = bh & 3;
    const size_t m0 = (size_t)b * 8192 + c * 64;
    float* tot = (float*)smem;
    float* red = (float*)(smem + 1024);
    char* Qp = smem + 2048;
    char* Qpp = Qp + 64 * 272;
    char* Kp = Qpp + 64 * 272;
    u32x4 ca0[4], ca1[4], ca2[4], caz[4]; float cl0[4], cl1[4], cl2[4];
#pragma unroll
    for (int i = 0; i < 4; ++i) {
        const int e = tid + 256 * i, r = e >> 4, ch = (e & 15) + 16 * h;
        const size_t m = m0 + r; const int hh = ch >> 3;
        const size_t ho = (((size_t)b * 8 + hh) * 8192 + (size_t)c * 64 + r) * 64 + (ch & 7) * 8;
        ca0[i] = *(const u32x4*)(p.ao0() + ho); ca1[i] = *(const u32x4*)(p.ao1() + ho); ca2[i] = *(const u32x4*)(p.ao2() + ho);
        caz[i] = *(const u32x4*)(p.az() + ((size_t)(b * 4 + h) * 8192 + (size_t)c * 64 + r) * 128 + (e & 15) * 8);
        cl0[i] = p.lse()[m * 8 + hh]; cl1[i] = p.lse()[((size_t)NTOK + m) * 8 + hh]; cl2[i] = p.lse()[((size_t)2 * NTOK + m) * 8 + hh];
    }
    {
        const int k = tid & 127, half = tid >> 7;
        const h16* lfp = p.lf() + ((size_t)(b * 4 + h) * 8192 + c * 64 + half * 32) * 128 + k;
        const u16* qp = p.hq() + ((size_t)(b * 4 + h) * 8192 + c * 64 + half * 32) * 128 + k;
        float v[32]; float T = 0.f;
#pragma unroll
        for (int i = 0; i < 32; ++i) { v[i] = (float)lfp[(size_t)i * 128]; T += v[i]; }
        tot[half * 128 + k] = T;
        vsync(smem, vgen);
        const float other = tot[(half ^ 1) * 128 + k];
        const float bref = (half == 0) ? T : other;
        const float ebref = __expf(bref);
        const float sub = (half == 0) ? T : 0.f;
        float pre = 0.f;
#pragma unroll
        for (int i = 0; i < 32; ++i) {
            pre += v[i];
            const float xx = pre - sub;
            const float E1 = __builtin_amdgcn_exp2f(xx * LOG2E), Ei = __builtin_amdgcn_exp2f(-xx * LOG2E);
            const float q = bf2f(qp[(size_t)i * 128]);
            const float kk = kfromlf(v[i]);
            const int row = half * 32 + i;
            *(u16*)(Qp + row * 272 + k * 2) = f2bf(q * E1);
            *(u16*)(Qpp + row * 272 + k * 2) = f2bf(q * E1 * ebref);
            *(u16*)(Kp + row * 272 + k * 2) = f2bf(kk * Ei);
        }
    }
    vsync(smem, vgen);
    const int tt = wid & 1, vh = wid >> 1;
    f32x16 at[2];
#pragma unroll
    for (int st = 0; st < 2; ++st) {
#pragma unroll
        for (int rr = 0; rr < 16; ++rr) at[st][rr] = 0.f;
        if (st <= tt) {
#pragma unroll
            for (int ks = 0; ks < 8; ++ks) {
                const bf16x8 a = *(const bf16x8*)(Kp + (st * 32 + l31) * 272 + (ks * 16 + lh * 8) * 2);
                const bf16x8 bq = *(const bf16x8*)(Qp + (tt * 32 + l31) * 272 + (ks * 16 + lh * 8) * 2);
                at[st] = MFMA32(a, bq, at[st]);
            }
            if (st == tt) {
#pragma unroll
                for (int rr = 0; rr < 16; ++rr) if (crow(rr, lh) > l31) at[st][rr] = 0.f;
            }
        }
    }
    f32x16 o[2];
#pragma unroll
    for (int vt = 0; vt < 2; ++vt) {
#pragma unroll
        for (int rr = 0; rr < 16; ++rr) o[vt][rr] = 0.f;
        const int vrow = 64 * vh + 32 * vt + l31;
        const u16* srow = p.ST() + (size_t)item * 16384 + vrow * 128;
#pragma unroll
        for (int ks = 0; ks < 8; ++ks) {
            const bf16x8 a = *(const bf16x8*)(srow + ks * 16 + lh * 8);
            const bf16x8 bq = *(const bf16x8*)(Qpp + (tt * 32 + l31) * 272 + (ks * 16 + lh * 8) * 2);
            o[vt] = MFMA32(a, bq, o[vt]);
        }
        const u16* vr = p.viT() + ((size_t)(b * 512 + h * 128 + vrow)) * 8192 + c * 64;
#pragma unroll
        for (int st = 0; st < 2; ++st) {
            if (st <= tt) {
#pragma unroll
                for (int ks2 = 0; ks2 < 2; ++ks2) {
                    const uint2 lo = *(const uint2*)(vr + st * 32 + ks2 * 16 + lh * 4);
                    const uint2 hi = *(const uint2*)(vr + st * 32 + ks2 * 16 + 8 + lh * 4);
                    u32x4 av4; av4[0] = lo.x; av4[1] = lo.y; av4[2] = hi.x; av4[3] = hi.y;
                    o[vt] = MFMA32(__builtin_bit_cast(bf16x8, av4), packB(at[st], ks2), o[vt]);
                }
            }
        }
    }
    float ss = 0.f;
#pragma unroll
    for (int vt = 0; vt < 2; ++vt)
#pragma unroll
        for (int rr = 0; rr < 16; ++rr) ss += o[vt][rr] * o[vt][rr];
    ss += __shfl_xor(ss, 32);
    if (lh == 0) red[vh * 64 + tt * 32 + l31] = ss;
    vsync(smem, vgen);
    const float tot2 = red[tt * 32 + l31] + red[64 + tt * 32 + l31];
    const float rinv = rsqrtf(tot2 * (1.f / 128.f) + EPS);
    const size_t m = m0 + tt * 32 + l31;
#pragma unroll
    for (int vt = 0; vt < 2; ++vt)
#pragma unroll
        for (int g4 = 0; g4 < 4; ++g4) {
            const int vb = 64 * vh + 32 * vt + 8 * g4 + 4 * lh;
            const float4 gw = *(const float4*)(p.hgw + h * 128 + vb);
            const uint2 zz = *(const uint2*)(p.hz() + ((size_t)(b * 4 + h) * 8192 + (size_t)c * 64 + tt * 32 + l31) * 128 + vb);
            const float y0 = o[vt][g4 * 4 + 0] * rinv * gw.x * bflo(zz.x);
            const float y1 = o[vt][g4 * 4 + 1] * rinv * gw.y * bfhi(zz.x);
            const float y2 = o[vt][g4 * 4 + 2] * rinv * gw.z * bflo(zz.y);
            const float y3 = o[vt][g4 * 4 + 3] * rinv * gw.w * bfhi(zz.y);
            *(uint2*)(p.mixed() + m * 1024 + h * 128 + vb) = make_uint2(pack2(y0, y1), pack2(y2, y3));
        }
#pragma unroll
    for (int i = 0; i < 4; ++i) {
        const int e = tid + 256 * i, r = e >> 4, ch = (e & 15) + 16 * h;
        const float mx = fmaxf(cl0[i], fmaxf(cl1[i], cl2[i]));
        float w0 = __expf(cl0[i] - mx), w1 = __expf(cl1[i] - mx), w2 = __expf(cl2[i] - mx);
        const float inv = __builtin_amdgcn_rcpf(w0 + w1 + w2);
        w0 *= inv; w1 *= inv; w2 *= inv;
        u32x4 pk;
#pragma unroll
        for (int q = 0; q < 4; ++q) {
            const float y0 = (w0 * bflo(ca0[i][q]) + w1 * bflo(ca1[i][q]) + w2 * bflo(ca2[i][q])) * bflo(caz[i][q]);
            const float y1 = (w0 * bfhi(ca0[i][q]) + w1 * bfhi(ca1[i][q]) + w2 * bfhi(ca2[i][q])) * bfhi(caz[i][q]);
            pk[q] = pack2(y0, y1);
        }
        *(u32x4*)(p.mixed() + (m0 + r) * 1024 + 512 + ch * 8) = pk;
    }
    vsync(smem, vgen);
}

struct EpiOut {
    static constexpr bool PERM = false, AFTER_DRAIN = true;
    P p;
    DI void fused(pg8::f32x4 (&acc)[2][2][4][2], const pg8::Unit& u, int wr, int wc, int fr, int fq, PG8_LAS unsigned char* lds, int wid, int lane) const {
        PG8_LAS float* Pt = (PG8_LAS float*)lds;
        PG8_LAS float* Rt = (PG8_LAS float*)(lds + 4096);
        const int tid = threadIdx.x;
        const int rl0 = wr * 64 + fr, c0 = u.pn * 256 + wc * 32 + fq * 4;
#pragma unroll
        for (int ai = 0; ai < 2; ++ai)
#pragma unroll
            for (int m = 0; m < 4; ++m) {
                __builtin_amdgcn_sched_barrier(0);
                const int rl = rl0 + 128 * ai + 16 * m;
                const float* xr = p.x + ((size_t)u.pm * 256 + rl) * 1024 + c0;
                float ss = 0.f;
#pragma unroll
                for (int bj = 0; bj < 2; ++bj)
#pragma unroll
                    for (int n = 0; n < 2; ++n) {
                        const float4 xv = *(const float4*)(xr + 128 * bj + 16 * n);
                        pg8::f32x4& a = acc[ai][bj][m][n];
                        a[0] += xv.x; a[1] += xv.y; a[2] += xv.z; a[3] += xv.w;
                        ss = fmaf(a[0], a[0], ss); ss = fmaf(a[1], a[1], ss); ss = fmaf(a[2], a[2], ss); ss = fmaf(a[3], a[3], ss);
                    }
                ss += __shfl_xor(ss, 16); ss += __shfl_xor(ss, 32);
                if (fq == 0) Pt[rl * 4 + wc] = ss;
            }
        __syncthreads();
        if (tid < 256) (void)__hip_atomic_fetch_add(p.rowss() + u.pm * 256 + tid, (Pt[tid * 4] + Pt[tid * 4 + 1]) + (Pt[tid * 4 + 2] + Pt[tid * 4 + 3]), __ATOMIC_RELAXED, __HIP_MEMORY_SCOPE_AGENT);
        __threadfence();
        __syncthreads();
        if (tid == 0) {
            (void)__hip_atomic_fetch_add(p.pcnt() + u.pm, 1u, __ATOMIC_RELAXED, __HIP_MEMORY_SCOPE_AGENT);
            unsigned sp = 0;
            while (__hip_atomic_load(p.pcnt() + u.pm, __ATOMIC_RELAXED, __HIP_MEMORY_SCOPE_AGENT) < 4u) { __builtin_amdgcn_s_sleep(2); if (++sp > (1u << 22)) break; }
            __builtin_amdgcn_fence(__ATOMIC_ACQUIRE, "agent");
        }
        __syncthreads();
        if (tid < 256) Rt[tid] = rsqrtf(__hip_atomic_load(p.rowss() + u.pm * 256 + tid, __ATOMIC_RELAXED, __HIP_MEMORY_SCOPE_AGENT) * (1.f / 1024.f) + EPS);
        __syncthreads();
#pragma unroll
        for (int ai = 0; ai < 2; ++ai)
#pragma unroll
            for (int m = 0; m < 4; ++m) {
                __builtin_amdgcn_sched_barrier(0);
                const int rl = rl0 + 128 * ai + 16 * m;
                const float rinv = Rt[rl];
                float* orow = p.out + ((size_t)u.pm * 256 + rl) * 1024 + c0;
#pragma unroll
                for (int bj = 0; bj < 2; ++bj)
#pragma unroll
                    for (int n = 0; n < 2; ++n) {
                        const float4 fwv = *(const float4*)(p.fw + c0 + 128 * bj + 16 * n);
                        const pg8::f32x4& a = acc[ai][bj][m][n];
                        *(float4*)(orow + 128 * bj + 16 * n) = make_float4(a[0] * rinv * fwv.x, a[1] * rinv * fwv.y, a[2] * rinv * fwv.z, a[3] * rinv * fwv.w);
                    }
            }
    }
};

constexpr int VSMEM = 4 * 128 * 144;
constexpr int LDS_BYTES = 163840;

__global__ void __launch_bounds__(512, 2) fwd_kernel(P p) {
    extern __shared__ __attribute__((aligned(16))) unsigned char dynlds[];
    volatile unsigned* xbw = (volatile unsigned*)(dynlds + LDS_BYTES - 16);
    if (threadIdx.x < 4) xbw[threadIdx.x] = 0u;
    __syncthreads();
    const XcdBarrier gb = xcd_barrier_post(p.bar(), xbw);
    char* smem = (char*)dynlds + (threadIdx.x >> 8) * VSMEM;
    phase0(p, smem);
    xcd_barrier(gb);
    {
        pg8::Gemm g; g.A = p.xb(); g.Bt = p.winT(); g.M = NTOK; g.N = 4096; g.K = 1024;
        pg8::StaticOrder S; S.init(NTOK, 4096, gridDim.x, blockIdx.x);
        EpiIn E; E.p = p;
        pg8::gemm_phase<EpiIn, pg8::StaticOrder, false>((PG8_LAS unsigned char*)dynlds, g, S, E, nullptr);
    }
    xcd_barrier(gb);
    unsigned vgen = 0u;
    if (VTID == 0) *(volatile unsigned*)(smem + VSMEM - 16) = 0u;
    __syncthreads();
    for (int it = VB; it < 1024; it += VGRID) pass1(p, smem, it, vgen);
    xcd_barrier(gb);
    pass2(p);
    if (VGRID == 512) {
        const int bi = VB;
        const int hb = (int)(threadIdx.x >> 8), wg = (int)blockIdx.x;
        const int first = (hb == 0) ? wg * 5 : 1280 + wg * 7, cnt = (hb == 0) ? 5 : 7;
        int par = 1;
        for (int i = 0; i < cnt; ++i) {
            const int item = first + i, nbi = (item & 1023) & ((64 >> ((item >> 10) * 2)) - 1);
            const bool reuse = (i > 0) && (nbi > 0);
            par = reuse ? (par ^ 1) : 1;
            attn_item(p, smem, item, reuse, par, vgen);
        }
    } else {
        for (int it = VB; it < 3072; it += VGRID) attn_item(p, smem, it, false, 1, vgen);
    }
    xcd_barrier(gb);
    for (int it = VB; it < 1024; it += VGRID) pass3(p, smem, it, vgen);
    xcd_barrier(gb);
    {
        pg8::Gemm g; g.A = p.mixed(); g.Bt = p.woutT(); g.M = NTOK; g.N = 1024; g.K = 1024;
        pg8::StaticOrder S; S.init(NTOK, 1024, gridDim.x, blockIdx.x);
        EpiOut E; E.p = p;
        pg8::gemm_phase<EpiOut, pg8::StaticOrder, false>((PG8_LAS unsigned char*)dynlds, g, S, E, nullptr);
    }
}

extern "C" void kernel_launch(void* const* d_in, const int* in_sizes, int n_in, void* d_out, int out_size, void* d_ws, size_t ws_size, hipStream_t stream) {
    static int grid_blocks = 0;
    if (!grid_blocks) {
        int per_cu = 0;
        (void)hipFuncSetAttribute((const void*)fwd_kernel, hipFuncAttributeMaxDynamicSharedMemorySize, LDS_BYTES);
        (void)hipOccupancyMaxActiveBlocksPerMultiprocessor(&per_cu, fwd_kernel, 512, LDS_BYTES);
        grid_blocks = 256;
    }
    char* ws = (char*)d_ws;
    P p{};
    p.x = (const float*)d_in[0]; p.norm_w = (const float*)d_in[1]; p.w_in = (const float*)d_in[2]; p.lbl = (const float*)d_in[3];
    p.hgw = (const float*)d_in[4]; p.w_out = (const float*)d_in[5]; p.fw = (const float*)d_in[6];
    p.out = (float*)d_out;
    p.ws = ws;
    (void)hipMemsetAsync(ws + OFF_BAR, 0, OFF_END - OFF_BAR, stream);
    void* args[] = {&p};
    hipError_t e = hipLaunchCooperativeKernel((void*)fwd_kernel, dim3(grid_blocks), dim3(512), args, LDS_BYTES, stream);
    if (e != hipSuccess) fprintf(stderr, "cooperative launch failed: %s (grid %d)\n", hipGetErrorString(e), grid_blocks);
}
```

```cpp
#include <hip/hip_runtime.h>
#include <cstdio>

typedef short bf16x8 __attribute__((ext_vector_type(8)));
typedef float f32x16 __attribute__((ext_vector_type(16)));
typedef __bf16 bf2_t __attribute__((ext_vector_type(2)));
typedef float f2_t __attribute__((ext_vector_type(2)));
typedef unsigned u32x4 __attribute__((ext_vector_type(4)));
typedef unsigned short u16;
typedef _Float16 h16;
typedef _Float16 h16x4 __attribute__((ext_vector_type(4)));

#define DI __device__ __forceinline__
#define VTID ((int)(threadIdx.x & 255u))
#define VB ((int)(blockIdx.x * 2u + (threadIdx.x >> 8)))
#define VGRID ((int)(gridDim.x * 2u))
#define MFMA32(a, b, c) __builtin_amdgcn_mfma_f32_32x32x16_bf16((a), (b), (c), 0, 0, 0)

constexpr int NTOK = 16384, DM = 1024, SEQ = 8192;
constexpr float EPS = 1e-6f;
constexpr float LOG2E = 1.4426950408889634f;

constexpr size_t MB = 1024 * 1024;
constexpr size_t OFF_XB = 0;
constexpr size_t OFF_RS = OFF_XB + 32 * MB;
constexpr size_t OFF_WINT = OFF_RS + 65536;
constexpr size_t OFF_WOUTT = OFF_WINT + 8 * MB;
constexpr size_t OFF_ROPE = OFF_WOUTT + 2 * MB;
constexpr size_t OFF_HQ = OFF_ROPE + 2 * MB;
constexpr size_t OFF_LF = OFF_HQ + 16 * MB;
constexpr size_t OFF_VIT = OFF_LF + 32 * MB;
constexpr size_t OFF_HZ = OFF_VIT + 16 * MB;
constexpr size_t OFF_AQ = OFF_HZ + 16 * MB;
constexpr size_t OFF_AK = OFF_AQ + 16 * MB;
constexpr size_t OFF_AV = OFF_AK + 16 * MB;
constexpr size_t OFF_AZ = OFF_AV + 16 * MB;
constexpr size_t OFF_ST = OFF_AZ + 16 * MB;
constexpr size_t OFF_DEC = OFF_ST + 32 * MB;
constexpr size_t OFF_AO2 = OFF_DEC + 512 * 1024;
constexpr size_t OFF_LSE = OFF_AO2 + 16 * MB;
constexpr size_t OFF_BAR = OFF_LSE + 3 * 16384 * 8 * 4;
constexpr size_t OFF_ROWSS = OFF_BAR + 16384;
constexpr size_t OFF_PCNT = OFF_ROWSS + 65536;
constexpr size_t OFF_END = OFF_PCNT + 1024;

struct P {
    const float* x; const float* norm_w; const float* w_in; const float* lbl; const float* hgw; const float* w_out; const float* fw;
    float* out; char* ws;
    DI u16* xb() const { return (u16*)(ws + OFF_XB); }
    DI float* rs() const { return (float*)(ws + OFF_RS); }
    DI u16* winT() const { return (u16*)(ws + OFF_WINT); }
    DI u16* woutT() const { return (u16*)(ws + OFF_WOUTT); }
    DI float* rope() const { return (float*)(ws + OFF_ROPE); }
    DI u16* hq() const { return (u16*)(ws + OFF_HQ); }
    DI h16* lf() const { return (h16*)(ws + OFF_LF); }
    DI u16* viT() const { return (u16*)(ws + OFF_VIT); }
    DI u16* hz() const { return (u16*)(ws + OFF_HZ); }
    DI u16* aq() const { return (u16*)(ws + OFF_AQ); }
    DI u16* ak() const { return (u16*)(ws + OFF_AK); }
    DI u16* av() const { return (u16*)(ws + OFF_AV); }
    DI u16* az() const { return (u16*)(ws + OFF_AZ); }
    DI u16* ST() const { return (u16*)(ws + OFF_ST); }
    DI float* dec() const { return (float*)(ws + OFF_DEC); }
    DI u16* ao0() const { return (u16*)(ws + OFF_XB); }
    DI u16* ao1() const { return (u16*)(ws + OFF_XB + 16 * MB); }
    DI u16* ao2() const { return (u16*)(ws + OFF_AO2); }
    DI float* lse() const { return (float*)(ws + OFF_LSE); }
    DI u16* mixed() const { return (u16*)(ws + OFF_AQ); }
    DI float* rowss() const { return (float*)(ws + OFF_ROWSS); }
    DI unsigned* pcnt() const { return (unsigned*)(ws + OFF_PCNT); }
    DI unsigned* bar() const { return (unsigned*)(ws + OFF_BAR); }
};

DI unsigned pack2(float a, float b) { f2_t v = {a, b}; return __builtin_bit_cast(unsigned, __builtin_convertvector(v, bf2_t)); }
DI u16 f2bf(float x) { return (u16)(pack2(x, 0.f) & 0xffffu); }
DI float bf2f(u16 v) { return __uint_as_float(((unsigned)v) << 16); }
DI float bflo(unsigned v) { return __uint_as_float(v << 16); }
DI float bfhi(unsigned v) { return __uint_as_float(v & 0xffff0000u); }
DI int crow(int reg, int h) { return (reg & 3) + 8 * (reg >> 2) + 4 * h; }
DI float silu(float v) { return v / (1.f + __expf(-v)); }
DI bf16x8 packB(const f32x16& x, int s) {
    u32x4 pk;
    pk[0] = pack2(x[8 * s + 0], x[8 * s + 1]); pk[1] = pack2(x[8 * s + 2], x[8 * s + 3]);
    pk[2] = pack2(x[8 * s + 4], x[8 * s + 5]); pk[3] = pack2(x[8 * s + 6], x[8 * s + 7]);
    return __builtin_bit_cast(bf16x8, pk);
}
DI float kfromlf(float v) { return (v > -0.02f) ? -v * (1.f + v * (0.5f + v * (1.f / 6.f))) : 1.f - __expf(v); }


#define XB_TMO      128
#define XB_XCNT(j)  (256  + 64 * (j))
#define XB_XSUB(j)  (1280 + 64 * (j))
#define XB_XGEN(j)  (2304 + 64 * (j))
#define XB_TOP      3328
#define XB_TOPGEN   3392
#define XCD_BAR_WORDS 3456
#define XB_SPIN_CAP (1u << 22)
#define LAS __attribute__((address_space(3)))
DI unsigned xb_ld(unsigned* p) { return __hip_atomic_load(p, __ATOMIC_RELAXED, __HIP_MEMORY_SCOPE_AGENT); }
DI unsigned xb_add(unsigned* p, unsigned v) { return __hip_atomic_fetch_add(p, v, __ATOMIC_RELAXED, __HIP_MEMORY_SCOPE_AGENT); }
DI unsigned xb_xcc_id() { return (unsigned)__builtin_amdgcn_s_getreg((3 << 11) | 20) & 0xFu; }
#define XB_SPIN(cond, bar) do { unsigned _sp = 0; while (cond) { __builtin_amdgcn_s_sleep(1); \
    if ((++_sp & 255u) == 0u) { if (xb_ld(&(bar)[XB_TMO])) break; if (_sp > XB_SPIN_CAP) { atomicAdd(&(bar)[XB_TMO], 1u); break; } } } } while (0)
struct XcdBarrier { unsigned* bar; unsigned x; volatile unsigned* st; };
DI XcdBarrier xcd_barrier_post(unsigned* bar, volatile unsigned* st) {
    XcdBarrier b; b.bar = bar; b.x = xb_xcc_id(); b.st = st;
    if (threadIdx.x == 0) (void)xb_add(&bar[XB_XCNT(b.x)], 1u);
    return b;
}
DI void xcd_barrier_complete(unsigned* bar, unsigned x, unsigned& nloc, unsigned& nx) {
    const unsigned G = gridDim.x * gridDim.y * gridDim.z;
    unsigned sum, cnt, mine, sp = 0u;
    for (;;) {
        sum = 0u; cnt = 0u; mine = 0u;
#pragma unroll
        for (unsigned j = 0; j < 16; ++j) { const unsigned c = xb_ld(&bar[XB_XCNT(j)]); sum += c; cnt += (c > 0u) ? 1u : 0u; mine = (j == x) ? c : mine; }
        if (sum == G) break;
        __builtin_amdgcn_s_sleep(1);
        if ((++sp & 255u) == 0u) { if (xb_ld(&bar[XB_TMO])) break; if (sp > XB_SPIN_CAP) { atomicAdd(&bar[XB_TMO], 1u); break; } }
    }
    nloc = mine > 0u ? mine : 1u; nx = cnt > 0u ? cnt : 1u;
}
DI void xcd_barrier(const XcdBarrier& b) {
    asm volatile("s_waitcnt vmcnt(0)" ::: "memory");
    __syncthreads();
    if (threadIdx.x == 0) {
        unsigned* bar = b.bar;
        __builtin_amdgcn_s_waitcnt(0);
        unsigned nloc = b.st[0], nx = b.st[1];
        if (nloc == 0u) { xcd_barrier_complete(bar, b.x, nloc, nx); b.st[0] = nloc; b.st[1] = nx; }
        const unsigned old = xb_add(&bar[XB_XSUB(b.x)], 1u);
        const unsigned gen = old / nloc;
        if (old + 1u == (gen + 1u) * nloc) {
            __builtin_amdgcn_fence(__ATOMIC_RELEASE, "agent");
            asm volatile("s_waitcnt vmcnt(0)" ::: "memory");
            const unsigned og = xb_add(&bar[XB_TOP], 1u);
            const unsigned tg = og / nx;
            if (og + 1u == (tg + 1u) * nx) xb_add(&bar[XB_TOPGEN], 1u);
            else XB_SPIN(xb_ld(&bar[XB_TOPGEN]) == tg, bar);
            __builtin_amdgcn_fence(__ATOMIC_ACQUIRE, "agent");
            xb_add(&bar[XB_XGEN(b.x)], 1u);
            asm volatile("s_waitcnt vmcnt(0)" ::: "memory");
        } else {
            XB_SPIN(xb_ld(&bar[XB_XGEN(b.x)]) == gen, bar);
            __builtin_amdgcn_fence(__ATOMIC_ACQUIRE, "agent");
            asm volatile("s_waitcnt vmcnt(0)" ::: "memory");
        }
    }
    __syncthreads();
}

constexpr int VSMEM_C = 4 * 128 * 144;
DI void vsync(char* smem, unsigned& gen) {
    __attribute__((address_space(3))) unsigned* ctr = (__attribute__((address_space(3))) unsigned*)(smem + VSMEM_C - 16);
    gen += 4u;
    __builtin_amdgcn_fence(__ATOMIC_RELEASE, "workgroup");
    if ((threadIdx.x & 63u) == 0u) (void)__hip_atomic_fetch_add(ctr, 1u, __ATOMIC_RELAXED, __HIP_MEMORY_SCOPE_WORKGROUP);
    unsigned sp = 0u;
    while (__hip_atomic_load(ctr, __ATOMIC_RELAXED, __HIP_MEMORY_SCOPE_WORKGROUP) < gen) { __builtin_amdgcn_s_sleep(1); if (++sp > (1u << 22)) break; }
    __builtin_amdgcn_fence(__ATOMIC_ACQUIRE, "workgroup");
}

DI void phase0(const P& p, char* smem) {
    int tid = VTID;
    asm volatile("" : "+v"(tid));
    const int lane = tid & 63, wid = tid >> 6;
    for (int row = VB * 4 + wid; row < NTOK; row += VGRID * 4) {
        const float4* xr = (const float4*)(p.x + (size_t)row * DM);
        float4 v[4]; float ss = 0.f;
#pragma unroll
        for (int i = 0; i < 4; ++i) { typedef float f4v __attribute__((ext_vector_type(4))); const f4v t4 = __builtin_nontemporal_load((const f4v*)(xr + lane + 64 * i)); v[i] = make_float4(t4[0], t4[1], t4[2], t4[3]); ss += v[i].x * v[i].x + v[i].y * v[i].y + v[i].z * v[i].z + v[i].w * v[i].w; }
#pragma unroll
        for (int o = 32; o >= 1; o >>= 1) ss += __shfl_xor(ss, o);
        uint2* xo = (uint2*)(p.xb() + (size_t)row * DM);
#pragma unroll
        for (int i = 0; i < 4; ++i) xo[lane + 64 * i] = make_uint2(pack2(v[i].x, v[i].y), pack2(v[i].z, v[i].w));
        if (lane == 0) p.rs()[row] = rsqrtf(ss * (1.f / 1024.f) + EPS);
    }
    float* tile = (float*)smem;
    for (int t = VB; t < 1024 + 256; t += VGRID) {
        const float* src; u16* dst; int ncols, td, tc; bool scale;
        if (t < 1024) { src = p.w_in; dst = p.winT(); ncols = 4096; td = t >> 6; tc = t & 63; scale = true; }
        else { const int t2 = t - 1024; src = p.w_out; dst = p.woutT(); ncols = 1024; td = t2 >> 4; tc = t2 & 15; scale = false; }
#pragma unroll
        for (int i = 0; i < 4; ++i) {
            const int r = (tid >> 4) + 16 * i, c4 = (tid & 15) * 4;
            float4 v = *(const float4*)(src + (size_t)(td * 64 + r) * ncols + tc * 64 + c4);
            const float s = scale ? p.norm_w[td * 64 + r] : 1.f;
            tile[r * 65 + c4 + 0] = v.x * s; tile[r * 65 + c4 + 1] = v.y * s; tile[r * 65 + c4 + 2] = v.z * s; tile[r * 65 + c4 + 3] = v.w * s;
        }
        __syncthreads();
#pragma unroll
        for (int u = 0; u < 2; ++u) {
            const int g = (tid & 3) + 4 * u, c = tid >> 2;
            float e[8];
#pragma unroll
            for (int j = 0; j < 8; ++j) e[j] = tile[(g * 8 + j) * 65 + c];
            u32x4 pk; pk[0] = pack2(e[0], e[1]); pk[1] = pack2(e[2], e[3]); pk[2] = pack2(e[4], e[5]); pk[3] = pack2(e[6], e[7]);
            int orow = tc * 64 + c;
            if (scale && orow >= 2048 && orow < 3072) { const int d = orow & 63; orow = (orow & ~63) + ((d & 31) << 1) + (d >> 5); }
            *(u32x4*)(dst + (size_t)orow * 1024 + td * 64 + g * 8) = pk;
        }
        __syncthreads();
    }
    for (int idx = VB * 256 + tid; idx < SEQ * 32; idx += VGRID * 256) {
        const int pos = idx >> 5, j = idx & 31;
        const float inv = (float)(1.0 / exp2((double)j * (13.287712379549449 / 32.0)));
        const float ang = (float)pos * inv;
        const double rev = (double)ang * 0.15915494309189535;
        const float fr = (float)(rev - floor(rev));
        p.rope()[idx] = __builtin_amdgcn_cosf(fr);
        p.rope()[SEQ * 32 + idx] = __builtin_amdgcn_sinf(fr);
    }
}

namespace pg8 {
#define PG8_LAS __attribute__((address_space(3)))
typedef unsigned short bf16_t;
typedef short bf16x8 __attribute__((ext_vector_type(8)));
typedef float f32x4 __attribute__((ext_vector_type(4)));
typedef unsigned u32x4 __attribute__((ext_vector_type(4)));
constexpr int BM = 256, BK = 64, HALF = 128, HTB = HALF * BK * 2  , STAGE_BYTES = 8 * HTB, NXCD = 8, WGM = 8;

__host__ __device__ __forceinline__ int lds_byte(int r, int c) { const int st = (r >> 4) * 2 + (c >> 5), rr = r & 15, cc = c & 31, ob = rr * 64 + cc * 2; return st * 1024 + (ob ^ (((ob >> 9) & 1) << 5)); }
__host__ __device__ __forceinline__ void stage_rc(int b, int& R, int& C) { const int st = b / 1024, sb = b % 1024, swz = sb ^ (((sb >> 9) & 1) << 5); R = (st >> 1) * 16 + swz / 64; C = (st & 1) * 32 + (swz % 64) / 2; }
__host__ __device__ __forceinline__ int perm32(int rho) { const int n = rho >> 4, i = rho & 15; return 8 * (i >> 2) + 4 * n + (i & 3); }

struct Unit { int pm, pn; };
struct Gemm { const bf16_t* A; const bf16_t* Bt; int M, N, K; };

struct StaticOrder {
    int nM, nN, nwg, G, c;
    __host__ __device__ void init(int M, int N, int G_, int c_) { nM = M / BM; nN = N / BM; nwg = nM * nN; G = G_; c = c_; }
    __host__ __device__ bool next(int i, Unit& u) const {
        const long L = (long)i * G + c; if (L >= nwg) return false;
        int wgid = (int)L; { const int q = nwg / NXCD, r = nwg % NXCD, xcd = wgid % NXCD, off = wgid / NXCD; wgid = (xcd < r ? xcd * (q + 1) : r * (q + 1) + (xcd - r) * q) + off; }
        const int nig = WGM * nN, gid = wgid / nig, fm = gid * WGM, gsz = (nM - fm) < WGM ? (nM - fm) : WGM;
        u.pm = fm + ((wgid % nig) % gsz); u.pn = (wgid % nig) / gsz; return true;
    }
    __device__ __forceinline__ void a_ready(const Unit&) const {}
    __device__ __forceinline__ void done(const Unit&) const {}
};
template <class Epi, class Sched, bool STAMP = false>
__device__ __forceinline__ void gemm_phase(PG8_LAS unsigned char* lds, const Gemm g, const Sched& S, const Epi& E, unsigned long long* stamps) {
    const int tid = threadIdx.x, wid = __builtin_amdgcn_readfirstlane(tid >> 6), lane = tid & 63, wr = wid >> 2, wc = wid & 3, fr = lane & 15, fq = lane >> 4;
    const int K = g.K, nt = K / BK;
    int ts_lo = 0, ts_hi = 0, nts = 0; const unsigned long long rt_entry = STAMP ? (unsigned long long)wall_clock64() : 0ull;
#define PG8_STAMP() do { if (STAMP && wid == 0 && nts < 64) { const unsigned long long _c = (unsigned long long)clock64(); \
        ts_lo = (lane == nts) ? (int)(unsigned)_c : ts_lo; ts_hi = (lane == nts) ? (int)(unsigned)(_c >> 32) : ts_hi; ++nts; } } while (0)
    PG8_STAMP();
    unsigned voffA[2], voffB[2];
#pragma unroll
    for (int i = 0; i < 2; ++i) { int R, C; stage_rc(tid * 16 + i * 8192, R, C); const int Rb = Epi::PERM ? ((R & ~31) + perm32(R & 31)) : R;
        voffA[i] = (unsigned)(R * K + C) * 2u; voffB[i] = (unsigned)(Rb * K + C) * 2u; }
    const size_t kstep = (size_t)(BK * 2);
    const size_t hstep = (size_t)HALF * K * 2;
    const size_t tstep = 2 * hstep;
    const unsigned ldsw = (unsigned)wid * 1024u;
    const int aoff = lds_byte(wr * 64 + fr, fq * 8), boff = lds_byte(wc * 32 + fr, fq * 8);
#define PG8_SA(b, h) (((b) * 2 + (h)) * HTB)
#define PG8_SB(b, h) ((4 + (b) * 2 + (h)) * HTB)
#define PG8_STAGE(bufoff, gbase, voff) do { _Pragma("unroll") for (int _i = 0; _i < 2; ++_i) \
        __builtin_amdgcn_global_load_lds((const unsigned*)((const char*)(gbase) + (voff)[_i]), (PG8_LAS unsigned*)(lds + (bufoff) + ldsw + _i * 8192), 16, 0, 0); } while (0)
#define PG8_LDA(dst, b, h) do { _Pragma("unroll") for (int m = 0; m < 4; ++m) _Pragma("unroll") for (int k = 0; k < 2; ++k) dst[m][k] = *(const PG8_LAS bf16x8*)(lds + PG8_SA(b, h) + aoff + m * 2048 + k * 1024); } while (0)
#define PG8_LDB(dst, b, h) do { _Pragma("unroll") for (int n = 0; n < 2; ++n) _Pragma("unroll") for (int k = 0; k < 2; ++k) dst[n][k] = *(const PG8_LAS bf16x8*)(lds + PG8_SB(b, h) + boff + n * 2048 + k * 1024); } while (0)
#define PG8_MMA(ai, bj, At, Bt) do { __builtin_amdgcn_s_setprio(1); _Pragma("unroll") for (int m = 0; m < 4; ++m) _Pragma("unroll") for (int n = 0; n < 2; ++n) _Pragma("unroll") for (int k = 0; k < 2; ++k) \
        acc[ai][bj][m][n] = __builtin_amdgcn_mfma_f32_16x16x32_bf16(Bt[n][k], At[m][k], acc[ai][bj][m][n], 0, 0, 0); __builtin_amdgcn_s_setprio(0); } while (0)
#define PG8_WAIT_V(n) asm volatile("s_waitcnt vmcnt(" #n ")" ::: "memory")
#define PG8_WAIT_L(n) asm volatile("s_waitcnt lgkmcnt(" #n ")" ::: "memory")
#define PG8_BAR __builtin_amdgcn_s_barrier()
#define PG8_SCHED __builtin_amdgcn_sched_barrier(0)
    Unit cur, nxt; int ui = 0;
    if (!S.next(0, cur)) return;
    f32x4 acc[2][2][4][2];
#pragma unroll
    for (int a = 0; a < 2; ++a)
#pragma unroll
        for (int b = 0; b < 2; ++b)
#pragma unroll
            for (int m = 0; m < 4; ++m)
#pragma unroll
                for (int n = 0; n < 2; ++n) acc[a][b][m][n] = (f32x4){0.f, 0.f, 0.f, 0.f};
    bf16x8 At[4][2], B0[2][2], B1[2][2];
    const char* cA = (const char*)g.A + (size_t)cur.pm * tstep; const char* cB = (const char*)g.Bt + (size_t)cur.pn * tstep;
    S.a_ready(cur);
    PG8_STAGE(PG8_SB(0, 0), cB, voffB); PG8_STAGE(PG8_SA(0, 0), cA, voffA); PG8_STAGE(PG8_SB(0, 1), cB + hstep, voffB); PG8_STAGE(PG8_SA(0, 1), cA + hstep, voffA);
    if (wr == 1) PG8_BAR;
    PG8_WAIT_V(4); PG8_BAR;
    PG8_STAGE(PG8_SB(1, 0), cB + kstep, voffB); PG8_STAGE(PG8_SA(1, 0), cA + kstep, voffA); PG8_STAGE(PG8_SB(1, 1), cB + hstep + kstep, voffB);
    PG8_WAIT_V(6); PG8_BAR;
    PG8_STAMP();
    for (;;) {
        const bool has_next = S.next(ui + 1, nxt);
        const char* nA = has_next ? (const char*)g.A + (size_t)nxt.pm * tstep : cA; const char* nB = has_next ? (const char*)g.Bt + (size_t)nxt.pn * tstep : cB;
        for (int t = 0; t < nt; t += 2) {
            const bool last = (t == nt - 2);
            const char* a1 = cA + (size_t)(t + 1) * kstep;
            const char* a2 = last ? nA : cA + (size_t)(t + 2) * kstep; const char* b2 = last ? nB : cB + (size_t)(t + 2) * kstep;
            const char* a3 = a2 + kstep; const char* b3 = b2 + kstep;
            if (last && has_next) S.a_ready(nxt);
            PG8_LDB(B0, 0, 0); PG8_SCHED; PG8_LDA(At, 0, 0); PG8_STAGE(PG8_SA(1, 1), a1 + hstep, voffA);
            PG8_WAIT_L(8); PG8_BAR; PG8_WAIT_L(0); PG8_MMA(0, 0, At, B0); PG8_BAR; PG8_SCHED;
            PG8_LDB(B1, 0, 1); PG8_STAGE(PG8_SB(0, 0), b2, voffB);
            PG8_BAR; PG8_WAIT_L(0); PG8_MMA(0, 1, At, B1); PG8_BAR;
            PG8_LDA(At, 0, 1); PG8_STAGE(PG8_SA(0, 0), a2, voffA);
            PG8_BAR; PG8_WAIT_L(0); PG8_MMA(1, 0, At, B0); PG8_BAR; PG8_SCHED;
            PG8_STAGE(PG8_SB(0, 1), b2 + hstep, voffB);
            PG8_WAIT_V(6); PG8_BAR; PG8_MMA(1, 1, At, B1); PG8_BAR;
            PG8_LDB(B0, 1, 0); PG8_SCHED; PG8_LDA(At, 1, 0); PG8_STAGE(PG8_SA(0, 1), a2 + hstep, voffA);
            PG8_WAIT_L(8); PG8_BAR; PG8_WAIT_L(0); PG8_MMA(0, 0, At, B0); PG8_BAR; PG8_SCHED;
            PG8_LDB(B1, 1, 1); PG8_STAGE(PG8_SB(1, 0), b3, voffB);
            PG8_BAR; PG8_WAIT_L(0); PG8_MMA(0, 1, At, B1); PG8_BAR;
            PG8_LDA(At, 1, 1); PG8_STAGE(PG8_SA(1, 0), a3, voffA);
            PG8_BAR; PG8_WAIT_L(0); PG8_MMA(1, 0, At, B0); PG8_BAR; PG8_SCHED;
            PG8_STAGE(PG8_SB(1, 1), b3 + hstep, voffB);
            PG8_WAIT_V(6); PG8_BAR; PG8_MMA(1, 1, At, B1); PG8_BAR;
        }
        PG8_STAMP();
        if constexpr (!Epi::AFTER_DRAIN) { E(acc, cur, wr, wc, fr, fq); S.done(cur); }
        PG8_STAMP();
        if (!has_next) break;
#pragma unroll
        for (int a = 0; a < 2; ++a)
#pragma unroll
            for (int b = 0; b < 2; ++b)
#pragma unroll
                for (int m = 0; m < 4; ++m)
#pragma unroll
                    for (int n = 0; n < 2; ++n) acc[a][b][m][n] = (f32x4){0.f, 0.f, 0.f, 0.f};
        cur = nxt; cA = nA; cB = nB; ++ui;
    }
    PG8_WAIT_V(0);
    if (wr == 0) PG8_BAR;
    PG8_BAR;
    if constexpr (Epi::AFTER_DRAIN) { E.fused(acc, cur, wr, wc, fr, fq, lds, wid, lane); S.done(cur); }
    PG8_STAMP();
    if (STAMP && wid == 0) { stamps[lane] = lane < nts ? (((unsigned long long)(unsigned)ts_hi << 32) | (unsigned)ts_lo) : 0ull;
        if (lane == 62) stamps[62] = rt_entry; if (lane == 63) stamps[63] = (unsigned long long)wall_clock64(); }
#undef PG8_STAMP
#undef PG8_SA
#undef PG8_SB
#undef PG8_STAGE
#undef PG8_LDA
#undef PG8_LDB
#undef PG8_MMA
#undef PG8_WAIT_V
#undef PG8_WAIT_L
#undef PG8_BAR
#undef PG8_SCHED
}
}


struct EpiIn {
    static constexpr bool PERM = true, AFTER_DRAIN = false;
    P p;
    template <int GRP> DI void run(const pg8::f32x4 (&acc)[2][2][4][2], const pg8::Unit& u, int wr, int wc, int fr, int fq) const {
        const int cg0 = (u.pn & 1) * 256 + wc * 32 + fq * 8;
        const int row0 = u.pm * 256 + wr * 64 + fr;
        float oml[2][8];
        if (GRP == 1) {
#pragma unroll
            for (int bj = 0; bj < 2; ++bj) {
                const float* l0 = p.lbl + cg0 + 128 * bj;
#pragma unroll
                for (int j = 0; j < 8; ++j) {
                    float lb = __builtin_amdgcn_rcpf(1.f + __builtin_amdgcn_exp2f((l0[512 + j] - l0[j]) * LOG2E));
                    lb = fminf(fmaxf(lb, 1e-6f), 1.f - 1e-6f);
                    oml[bj][j] = 1.f - lb;
                }
            }
        }
        float rsv[2][4];
#pragma unroll
        for (int ai = 0; ai < 2; ++ai)
#pragma unroll
            for (int m = 0; m < 4; ++m) rsv[ai][m] = p.rs()[row0 + 128 * ai + 16 * m];
#pragma unroll
        for (int ai = 0; ai < 2; ++ai)
#pragma unroll
            for (int m = 0; m < 4; ++m) {
                const int row = row0 + 128 * ai + 16 * m;
                const float rs = rsv[ai][m];
#pragma unroll
                for (int bj = 0; bj < 2; ++bj) {
                    const int cg = cg0 + 128 * bj;
                    float v[8];
#pragma unroll
                    for (int j = 0; j < 8; ++j) v[j] = acc[ai][bj][m][j >> 2][j & 3] * rs;
                    if (GRP == 2) {
                        const int b = row >> 13, t = row & 8191;
                        u16* dst = p.viT() + ((size_t)(b * 512 + cg)) * 8192 + t;
#pragma unroll
                        for (int j = 0; j < 8; ++j) dst[(size_t)j * 8192] = f2bf(v[j]);
                    } else if (GRP == 1) {
                        typedef _Float16 h16x8 __attribute__((ext_vector_type(8)));
                        h16x8 hv;
#pragma unroll
                        for (int j = 0; j < 8; ++j) hv[j] = (h16)(__builtin_amdgcn_logf(1.f - oml[bj][j] * __builtin_amdgcn_rcpf(1.f + __builtin_amdgcn_exp2f(v[j] * LOG2E))) * 0.6931471805599453f);
                        *(h16x8*)(p.lf() + ((size_t)((row >> 13) * 4 + (cg >> 7)) * 8192 + (row & 8191)) * 128 + (cg & 127)) = hv;
                    } else {
                        float o[8];
                        if (GRP == 0 || GRP == 3 || GRP == 7) {
#pragma unroll
                            for (int j = 0; j < 8; ++j) o[j] = v[j] * __builtin_amdgcn_rcpf(1.f + __builtin_amdgcn_exp2f(-v[j] * LOG2E));
                        } else if (GRP == 6) {
#pragma unroll
                            for (int j = 0; j < 8; ++j) o[j] = v[j];
                        } else {
                            const float sc = (GRP == 4) ? 0.125f : 1.f;
                            const int f0 = (cg & 63) >> 1, pos = row & 8191;
                            const float4 c4 = *(const float4*)(p.rope() + pos * 32 + f0), s4 = *(const float4*)(p.rope() + SEQ * 32 + pos * 32 + f0);
                            const float cs[4] = {c4.x, c4.y, c4.z, c4.w}, sn[4] = {s4.x, s4.y, s4.z, s4.w};
#pragma unroll
                            for (int i = 0; i < 4; ++i) {
                                o[2 * i] = (v[2 * i] * cs[i] - v[2 * i + 1] * sn[i]) * sc;
                                o[2 * i + 1] = (v[2 * i + 1] * cs[i] + v[2 * i] * sn[i]) * sc;
                            }
                        }
                        const size_t doff = (GRP == 4 || GRP == 5 || GRP == 6) ? ((size_t)((row >> 13) * 8 + (cg >> 6)) * 8192 + (row & 8191)) * 64 + (cg & 63)
                                                                                : ((size_t)((row >> 13) * 4 + (cg >> 7)) * 8192 + (row & 8191)) * 128 + (cg & 127);
                        u16* dst = ((GRP == 0) ? p.hq() : (GRP == 3) ? p.hz() : (GRP == 4) ? p.aq() : (GRP == 5) ? p.ak() : (GRP == 6) ? p.av() : p.az()) + doff;
                        u32x4 pk; pk[0] = pack2(o[0], o[1]); pk[1] = pack2(o[2], o[3]); pk[2] = pack2(o[4], o[5]); pk[3] = pack2(o[6], o[7]);
                        *(u32x4*)dst = pk;
                    }
                }
            }
    }
    DI void operator()(const pg8::f32x4 (&acc)[2][2][4][2], const pg8::Unit& u, int wr, int wc, int fr, int fq) const {
        switch (u.pn >> 1) {
            case 0: run<0>(acc, u, wr, wc, fr, fq); break;
            case 1: run<1>(acc, u, wr, wc, fr, fq); break;
            case 2: run<2>(acc, u, wr, wc, fr, fq); break;
            case 3: run<3>(acc, u, wr, wc, fr, fq); break;
            case 4: run<4>(acc, u, wr, wc, fr, fq); break;
            case 5: run<5>(acc, u, wr, wc, fr, fq); break;
            case 6: run<6>(acc, u, wr, wc, fr, fq); break;
            default: run<7>(acc, u, wr, wc, fr, fq); break;
        }
    }
};

DI void pass1(const P& p, char* smem, int item, unsigned& vgen) {
    int tid = VTID;
    asm volatile("" : "+v"(tid));
    const int lane = tid & 63, wid = tid >> 6, l31 = lane & 31, lh = lane >> 5;
    const int bh = item >> 7, c = item & 127, b = bh >> 2, h = bh & 3;
    const size_t m0 = (size_t)b * 8192 + c * 64;
    float* tot = (float*)smem;
    char* kdT = smem + 1024;
    const int k = tid & 127, half = tid >> 7;
    const h16* lfp = p.lf() + ((size_t)(b * 4 + h) * 8192 + c * 64 + half * 32) * 128 + k;
    float v[32]; float T = 0.f;
#pragma unroll
    for (int i = 0; i < 32; ++i) { v[i] = (float)lfp[(size_t)i * 128]; T += v[i]; }
    tot[half * 128 + k] = T;
    vsync(smem, vgen);
    const float other = tot[(half ^ 1) * 128 + k];
    float suf = (half == 0) ? other : 0.f;
    float kd[32];
#pragma unroll
    for (int i = 31; i >= 0; --i) { kd[i] = kfromlf(v[i]) * __expf(suf); suf += v[i]; }
#pragma unroll
    for (int q = 0; q < 4; ++q) {
        u32x4 pk;
        pk[0] = pack2(kd[8 * q + 0], kd[8 * q + 1]); pk[1] = pack2(kd[8 * q + 2], kd[8 * q + 3]);
        pk[2] = pack2(kd[8 * q + 4], kd[8 * q + 5]); pk[3] = pack2(kd[8 * q + 6], kd[8 * q + 7]);
        *(u32x4*)(kdT + k * 144 + half * 64 + q * 16) = pk;
    }
    if (half == 0) p.dec()[(size_t)item * 128 + k] = __expf(T + other);
    vsync(smem, vgen);
    const u16* vrow = p.viT() + ((size_t)(b * 512 + h * 128 + wid * 32 + l31)) * 8192 + c * 64;
    f32x16 acc[4];
#pragma unroll
    for (int n = 0; n < 4; ++n)
#pragma unroll
        for (int r = 0; r < 16; ++r) acc[n][r] = 0.f;
#pragma unroll
    for (int ks = 0; ks < 4; ++ks) {
        const bf16x8 a = *(const bf16x8*)(vrow + ks * 16 + lh * 8);
#pragma unroll
        for (int nt = 0; nt < 4; ++nt) {
            const bf16x8 bb = *(const bf16x8*)(kdT + (nt * 32 + l31) * 144 + (ks * 16 + lh * 8) * 2);
            acc[nt] = MFMA32(a, bb, acc[nt]);
        }
    }
    u16* so = p.ST() + (size_t)item * 16384;
#pragma unroll
    for (int nt = 0; nt < 4; ++nt)
#pragma unroll
        for (int r = 0; r < 16; ++r) so[(wid * 32 + crow(r, lh)) * 128 + nt * 32 + l31] = f2bf(acc[nt][r]);
    vsync(smem, vgen);
}

DI void pass2(const P& p) {
    int tid = VTID;
    asm volatile("" : "+v"(tid));
    if ((threadIdx.x >> 8) == 0u)
    for (int e = (int)blockIdx.x * 256 + tid; e < 65536; e += (int)gridDim.x * 256) {
        const int bh = e >> 13, rem = e & 8191, k2 = (rem & 63) * 2;
        unsigned* st = (unsigned*)p.ST() + (size_t)bh * 128 * 8192 + rem;
        const float2* dc = (const float2*)(p.dec() + (size_t)bh * 128 * 128 + k2);
        float r0 = 0.f, r1 = 0.f;
        for (int c0 = 0; c0 < 128; c0 += 8) {
            unsigned s[8]; float2 d[8];
#pragma unroll
            for (int j = 0; j < 8; ++j) { s[j] = st[(size_t)(c0 + j) * 8192]; d[j] = dc[(c0 + j) * 64]; }
#pragma unroll
            for (int j = 0; j < 8; ++j) {
                st[(size_t)(c0 + j) * 8192] = pack2(r0, r1);
                r0 = d[j].x * r0 + bflo(s[j]); r1 = d[j].y * r1 + bfhi(s[j]);
            }
        }
    }
}

DI void attn_item(const P& p, char* smem, int item, bool reuse, int par, unsigned& vgen) {
    int tid = VTID;
    asm volatile("" : "+v"(tid));
    const int lane = tid & 63, wid = tid >> 6, l31 = lane & 31, lh = lane >> 5;
    const int pat = item >> 10, idx = item & 1023;
    const int dl = pat * 2, d = 1 << dl, nblk = 64 >> dl;
    const int nb = idx & (nblk - 1);
    int rest = idx >> (6 - dl);
    const int r = rest & (d - 1); rest >>= dl;
    const int hh = rest & 7, b = rest >> 3;
    char* Ks = smem;
    char* VT = smem + 256 * 144;
    const size_t tokbase = ((size_t)b * 8 + hh) * 8192;
    {
        const int c8 = tid & 7, kr = tid >> 3;
#pragma unroll
        for (int i = 0; i < 8; ++i) {
            const int lkey = kr + 32 * i;
            const int j = nb * 128 - 128 + lkey;
            const int key = (lkey & 127) + 128 * ((i >> 2) ^ par ^ 1);
            if (j >= 0 && !(reuse && i < 4)) {
                const size_t off = (tokbase + (size_t)j * d + r) * 64 + c8 * 8;
                const u32x4 kv = *(const u32x4*)(p.ak() + off);
                const u32x4 vv = *(const u32x4*)(p.av() + off);
                *(u32x4*)(Ks + key * 144 + c8 * 16) = kv;
#pragma unroll
                for (int e = 0; e < 4; ++e) {
                    *(u16*)(VT + (c8 * 8 + 2 * e) * 520 + key * 2) = (u16)(vv[e] & 0xffffu);
                    *(u16*)(VT + (c8 * 8 + 2 * e + 1) * 520 + key * 2) = (u16)(vv[e] >> 16);
                }
            }
        }
    }
    const int jq = nb * 128 + wid * 32 + l31;
    const size_t mq = tokbase + (size_t)jq * d + r;
    bf16x8 qf[4];
#pragma unroll
    for (int ks = 0; ks < 4; ++ks) qf[ks] = *(const bf16x8*)(p.aq() + mq * 64 + ks * 16 + lh * 8);
    vsync(smem, vgen);
    const int kt_lo = (nb == 0) ? 4 : 0;
    f32x16 st[5];
    float mx = -INFINITY;
#pragma unroll
    for (int i = 0; i < 5; ++i) {
        const int kt = wid + i;
        const int pkt = (kt & 3) + 4 * ((kt >> 2) ^ par ^ 1);
        if (kt >= kt_lo) {
#pragma unroll
            for (int rr = 0; rr < 16; ++rr) st[i][rr] = 0.f;
#pragma unroll
            for (int ks = 0; ks < 4; ++ks) {
                const bf16x8 a = *(const bf16x8*)(Ks + (pkt * 32 + l31) * 144 + (ks * 16 + lh * 8) * 2);
                st[i] = MFMA32(a, qf[ks], st[i]);
            }
#pragma unroll
            for (int rr = 0; rr < 16; ++rr) {
                if (i == 0 && crow(rr, lh) < l31) st[i][rr] = -INFINITY;
                if (i == 4 && crow(rr, lh) > l31) st[i][rr] = -INFINITY;
                mx = fmaxf(mx, st[i][rr]);
            }
        } else {
#pragma unroll
            for (int rr = 0; rr < 16; ++rr) st[i][rr] = -INFINITY;
        }
    }
    mx = fmaxf(mx, __shfl_xor(mx, 32));
    const float mxs = mx * LOG2E;
#pragma unroll
    for (int i = 0; i < 5; ++i)
#pragma unroll
        for (int rr = 0; rr < 16; ++rr) st[i][rr] = __builtin_amdgcn_exp2f(st[i][rr] * LOG2E - mxs);
    f32x16 o[2], lsum;
#pragma unroll
    for (int rr = 0; rr < 16; ++rr) { o[0][rr] = 0.f; o[1][rr] = 0.f; lsum[rr] = 0.f; }
    u32x4 ones4; ones4[0] = ones4[1] = ones4[2] = ones4[3] = 0x3f803f80u;
    const bf16x8 ones = __builtin_bit_cast(bf16x8, ones4);
#pragma unroll
    for (int i = 0; i < 5; ++i) {
        const int kt = wid + i;
        const int pkt = (kt & 3) + 4 * ((kt >> 2) ^ par ^ 1);
        if (kt >= kt_lo) {
#pragma unroll
            for (int ks2 = 0; ks2 < 2; ++ks2) {
                const bf16x8 bq = packB(st[i], ks2);
                lsum = MFMA32(ones, bq, lsum);
#pragma unroll
                for (int dt = 0; dt < 2; ++dt) {
                    const char* ad = VT + (dt * 32 + l31) * 520 + (pkt * 32 + ks2 * 16 + lh * 4) * 2;
                    const uint2 lo = *(const uint2*)ad, hi = *(const uint2*)(ad + 16);
                    u32x4 av4; av4[0] = lo.x; av4[1] = lo.y; av4[2] = hi.x; av4[3] = hi.y;
                    o[dt] = MFMA32(__builtin_bit_cast(bf16x8, av4), bq, o[dt]);
                }
            }
        }
    }
    const float l = lsum[0];
    const float inv = __builtin_amdgcn_rcpf(l);
    u16* op = (pat == 0 ? p.ao0() : (pat == 1 ? p.ao1() : p.ao2())) + mq * 64;
#pragma unroll
    for (int dt = 0; dt < 2; ++dt)
#pragma unroll
        for (int g4 = 0; g4 < 4; ++g4)
            *(uint2*)(op + dt * 32 + g4 * 8 + lh * 4) = make_uint2(pack2(o[dt][g4 * 4] * inv, o[dt][g4 * 4 + 1] * inv), pack2(o[dt][g4 * 4 + 2] * inv, o[dt][g4 * 4 + 3] * inv));
    if (lh == 0) p.lse()[((size_t)pat * NTOK + (size_t)b * 8192 + (size_t)jq * d + r) * 8 + hh] = mx + __logf(l);
    vsync(smem, vgen);
}

DI void pass3(const P& p, char* smem, int item, unsigned& vgen) {
    int tid = VTID;
    asm volatile("" : "+v"(tid));
    const int lane = tid & 63, wid = tid >> 6, l31 = lane & 31, lh = lane >> 5;
    const int bh = item >> 7, c = item & 127, b = bh >> 2, h = bh & 3;
    const size_t m0 = (size_t)b * 8192 + c * 64;
    float* tot = (float*)smem;
    float* red = (float*)(smem + 1024);
    char* Qp = smem + 2048;
    char* Qpp = Qp + 64 * 272;
    char* Kp = Qpp + 64 * 272;
    u32x4 ca0[4], ca1[4], ca2[4], caz[4]; float cl0[4], cl1[4], cl2[4];
#pragma unroll
    for (int i = 0; i < 4; ++i) {
        const int e = tid + 256 * i, r = e >> 4, ch = (e & 15) + 16 * h;
        const size_t m = m0 + r; const int hh = ch >> 3;
        const size_t ho = (((size_t)b * 8 + hh) * 8192 + (size_t)c * 64 + r) * 64 + (ch & 7) * 8;
        ca0[i] = *(const u32x4*)(p.ao0() + ho); ca1[i] = *(const u32x4*)(p.ao1() + ho); ca2[i] = *(const u32x4*)(p.ao2() + ho);
        caz[i] = *(const u32x4*)(p.az() + ((size_t)(b * 4 + h) * 8192 + (size_t)c * 64 + r) * 128 + (e & 15) * 8);
        cl0[i] = p.lse()[m * 8 + hh]; cl1[i] = p.lse()[((size_t)NTOK + m) * 8 + hh]; cl2[i] = p.lse()[((size_t)2 * NTOK + m) * 8 + hh];
    }
    {
        const int k = tid & 127, half = tid >> 7;
        const h16* lfp = p.lf() + ((size_t)(b * 4 + h) * 8192 + c * 64 + half * 32) * 128 + k;
        const u16* qp = p.hq() + ((size_t)(b * 4 + h) * 8192 + c * 64 + half * 32) * 128 + k;
        float v[32]; float T = 0.f;
#pragma unroll
        for (int i = 0; i < 32; ++i) { v[i] = (float)lfp[(size_t)i * 128]; T += v[i]; }
        tot[half * 128 + k] = T;
        vsync(smem, vgen);
        const float other = tot[(half ^ 1) * 128 + k];
        const float bref = (half == 0) ? T : other;
        const float ebref = __expf(bref);
        const float sub = (half == 0) ? T : 0.f;
        float pre = 0.f;
#pragma unroll
        for (int i = 0; i < 32; ++i) {
            pre += v[i];
            const float xx = pre - sub;
            const float E1 = __builtin_amdgcn_exp2f(xx * LOG2E), Ei = __builtin_amdgcn_exp2f(-xx * LOG2E);
            const float q = bf2f(qp[(size_t)i * 128]);
            const float kk = kfromlf(v[i]);
            const int row = half * 32 + i;
            *(u16*)(Qp + row * 272 + k * 2) = f2bf(q * E1);
            *(u16*)(Qpp + row * 272 + k * 2) = f2bf(q * E1 * ebref);
            *(u16*)(Kp + row * 272 + k * 2) = f2bf(kk * Ei);
        }
    }
    vsync(smem, vgen);
    const int tt = wid & 1, vh = wid >> 1;
    f32x16 at[2];
#pragma unroll
    for (int st = 0; st < 2; ++st) {
#pragma unroll
        for (int rr = 0; rr < 16; ++rr) at[st][rr] = 0.f;
        if (st <= tt) {
#pragma unroll
            for (int ks = 0; ks < 8; ++ks) {
                const bf16x8 a = *(const bf16x8*)(Kp + (st * 32 + l31) * 272 + (ks * 16 + lh * 8) * 2);
                const bf16x8 bq = *(const bf16x8*)(Qp + (tt * 32 + l31) * 272 + (ks * 16 + lh * 8) * 2);
                at[st] = MFMA32(a, bq, at[st]);
            }
            if (st == tt) {
#pragma unroll
                for (int rr = 0; rr < 16; ++rr) if (crow(rr, lh) > l31) at[st][rr] = 0.f;
            }
        }
    }
    f32x16 o[2];
#pragma unroll
    for (int vt = 0; vt < 2; ++vt) {
#pragma unroll
        for (int rr = 0; rr < 16; ++rr) o[vt][rr] = 0.f;
        const int vrow = 64 * vh + 32 * vt + l31;
        const u16* srow = p.ST() + (size_t)item * 16384 + vrow * 128;
#pragma unroll
        for (int ks = 0; ks < 8; ++ks) {
            const bf16x8 a = *(const bf16x8*)(srow + ks * 16 + lh * 8);
            const bf16x8 bq = *(const bf16x8*)(Qpp + (tt * 32 + l31) * 272 + (ks * 16 + lh * 8) * 2);
            o[vt] = MFMA32(a, bq, o[vt]);
        }
        const u16* vr = p.viT() + ((size_t)(b * 512 + h * 128 + vrow)) * 8192 + c * 64;
#pragma unroll
        for (int st = 0; st < 2; ++st) {
            if (st <= tt) {
#pragma unroll
                for (int ks2 = 0; ks2 < 2; ++ks2) {
                    const uint2 lo = *(const uint2*)(vr + st * 32 + ks2 * 16 + lh * 4);
                    const uint2 hi = *(const uint2*)(vr + st * 32 + ks2 * 16 + 8 + lh * 4);
                    u32x4 av4; av4[0] = lo.x; av4[1] = lo.y; av4[2] = hi.x; av4[3] = hi.y;
                    o[vt] = MFMA32(__builtin_bit_cast(bf16x8, av4), packB(at[st], ks2), o[vt]);
                }
            }
        }
    }
    float ss = 0.f;
#pragma unroll
    for (int vt = 0; vt < 2; ++vt)
#pragma unroll
        for (int rr = 0; rr < 16; ++rr) ss += o[vt][rr] * o[vt][rr];
    ss += __shfl_xor(ss, 32);
    if (lh == 0) red[vh * 64 + tt * 32 + l31] = ss;
    vsync(smem, vgen);
    const float tot2 = red[tt * 32 + l31] + red[64 + tt * 32 + l31];
    const float rinv = rsqrtf(tot2 * (1.f / 128.f) + EPS);
    const size_t m = m0 + tt * 32 + l31;
#pragma unroll
    for (int vt = 0; vt < 2; ++vt)
#pragma unroll
        for (int g4 = 0; g4 < 4; ++g4) {
            const int vb = 64 * vh + 32 * vt + 8 * g4 + 4 * lh;
            const float4 gw = *(const float4*)(p.hgw + h * 128 + vb);
            const uint2 zz = *(const uint2*)(p.hz() + ((size_t)(b * 4 + h) * 8192 + (size_t)c * 64 + tt * 32 + l31) * 128 + vb);
            const float y0 = o[vt][g4 * 4 + 0] * rinv * gw.x * bflo(zz.x);
            const float y1 = o[vt][g4 * 4 + 1] * rinv * gw.y * bfhi(zz.x);
            const float y2 = o[vt][g4 * 4 + 2] * rinv * gw.z * bflo(zz.y);
            const float y3 = o[vt][g4 * 4 + 3] * rinv * gw.w * bfhi(zz.y);
            *(uint2*)(p.mixed() + m * 1024 + h * 128 + vb) = make_uint2(pack2(y0, y1), pack2(y2, y3));
        }
#pragma unroll
    for (int i = 0; i < 4; ++i) {
        const int e = tid + 256 * i, r = e >> 4, ch = (e & 15) + 16 * h;
        const float mx = fmaxf(cl0[i], fmaxf(cl1[i], cl2[i]));
        float w0 = __expf(cl0[i] - mx), w1 = __expf(cl1[i] - mx), w2 = __expf(cl2[i] - mx);
        const float inv = __builtin_amdgcn_rcpf(w0 + w1 + w2);
        w0 *= inv; w1 *= inv; w2 *= inv;
        u32x4 pk;
#pragma unroll
        for (int q = 0; q < 4; ++q) {
            const float y0 = (w0 * bflo(ca0[i][q]) + w1 * bflo(ca1[i][q]) + w2 * bflo(ca2[i][q])) * bflo(caz[i][q]);
            const float y1 = (w0 * bfhi(ca0[i][q]) + w1 * bfhi(ca1[i][q]) + w2 * bfhi(ca2[i][q])) * bfhi(caz[i][q]);
            pk[q] = pack2(y0, y1);
        }
        *(u32x4*)(p.mixed() + (m0 + r) * 1024 + 512 + ch * 8) = pk;
    }
    vsync(smem, vgen);
}

struct EpiOut {
    static constexpr bool PERM = false, AFTER_DRAIN = true;
    P p;
    DI void fused(pg8::f32x4 (&acc)[2][2][4][2], const pg8::Unit& u, int wr, int wc, int fr, int fq, PG8_LAS unsigned char* lds, int wid, int lane) const {
        PG8_LAS float* Pt = (PG8_LAS float*)lds;
        PG8_LAS float* Rt = (PG8_LAS float*)(lds + 4096);
        const int tid = threadIdx.x;
        const int rl0 = wr * 64 + fr, c0 = u.pn * 256 + wc * 32 + fq * 4;
#pragma unroll
        for (int ai = 0; ai < 2; ++ai)
#pragma unroll
            for (int m = 0; m < 4; ++m) {
                __builtin_amdgcn_sched_barrier(0);
                const int rl = rl0 + 128 * ai + 16 * m;
                const float* xr = p.x + ((size_t)u.pm * 256 + rl) * 1024 + c0;
                float ss = 0.f;
#pragma unroll
                for (int bj = 0; bj < 2; ++bj)
#pragma unroll
                    for (int n = 0; n < 2; ++n) {
                        const float4 xv = *(const float4*)(xr + 128 * bj + 16 * n);
                        pg8::f32x4& a = acc[ai][bj][m][n];
                        a[0] += xv.x; a[1] += xv.y; a[2] += xv.z; a[3] += xv.w;
                        ss = fmaf(a[0], a[0], ss); ss = fmaf(a[1], a[1], ss); ss = fmaf(a[2], a[2], ss); ss = fmaf(a[3], a[3], ss);
                    }
                ss += __shfl_xor(ss, 16); ss += __shfl_xor(ss, 32);
                if (fq == 0) Pt[rl * 4 + wc] = ss;
            }
        __syncthreads();
        if (tid < 256) (void)__hip_atomic_fetch_add(p.rowss() + u.pm * 256 + tid, (Pt[tid * 4] + Pt[tid * 4 + 1]) + (Pt[tid * 4 + 2] + Pt[tid * 4 + 3]), __ATOMIC_RELAXED, __HIP_MEMORY_SCOPE_AGENT);
        __threadfence();
        __syncthreads();
        if (tid == 0) {
            (void)__hip_atomic_fetch_add(p.pcnt() + u.pm, 1u, __ATOMIC_RELAXED, __HIP_MEMORY_SCOPE_AGENT);
            unsigned sp = 0;
            while (__hip_atomic_load(p.pcnt() + u.pm, __ATOMIC_RELAXED, __HIP_MEMORY_SCOPE_AGENT) < 4u) { __builtin_amdgcn_s_sleep(2); if (++sp > (1u << 22)) break; }
            __builtin_amdgcn_fence(__ATOMIC_ACQUIRE, "agent");
        }
        __syncthreads();
        if (tid < 256) Rt[tid] = rsqrtf(__hip_atomic_load(p.rowss() + u.pm * 256 + tid, __ATOMIC_RELAXED, __HIP_MEMORY_SCOPE_AGENT) * (1.f / 1024.f) + EPS);
        __syncthreads();
#pragma unroll
        for (int ai = 0; ai < 2; ++ai)
#pragma unroll
            for (int m = 0; m < 4; ++m) {
                __builtin_amdgcn_sched_barrier(0);
                const int rl = rl0 + 128 * ai + 16 * m;
                const float rinv = Rt[rl];
                float* orow = p.out + ((size_t)u.pm * 256 + rl) * 1024 + c0;
#pragma unroll
                for (int bj = 0; bj < 2; ++bj)
#pragma unroll
                    for (int n = 0; n < 2; ++n) {
                        const float4 fwv = *(const float4*)(p.fw + c0 + 128 * bj + 16 * n);
                        const pg8::f32x4& a = acc[ai][bj][m][n];
                        *(float4*)(orow + 128 * bj + 16 * n) = make_float4(a[0] * rinv * fwv.x, a[1] * rinv * fwv.y, a[2] * rinv * fwv.z, a[3] * rinv * fwv.w);
                    }
            }
    }
};

constexpr int VSMEM = 4 * 128 * 144;
constexpr int LDS_BYTES = 163840;

__global__ void __launch_bounds__(512, 2) fwd_kernel(P p) {
    extern __shared__ __attribute__((aligned(16))) unsigned char dynlds[];
    volatile unsigned* xbw = (volatile unsigned*)(dynlds + LDS_BYTES - 16);
    if (threadIdx.x < 4) xbw[threadIdx.x] = 0u;
    __syncthreads();
    const XcdBarrier gb = xcd_barrier_post(p.bar(), xbw);
    char* smem = (char*)dynlds + (threadIdx.x >> 8) * VSMEM;
    phase0(p, smem);
    xcd_barrier(gb);
    {
        pg8::Gemm g; g.A = p.xb(); g.Bt = p.winT(); g.M = NTOK; g.N = 4096; g.K = 1024;
        pg8::StaticOrder S; S.init(NTOK, 4096, gridDim.x, blockIdx.x);
        EpiIn E; E.p = p;
        pg8::gemm_phase<EpiIn, pg8::StaticOrder, false>((PG8_LAS unsigned char*)dynlds, g, S, E, nullptr);
    }
    xcd_barrier(gb);
    unsigned vgen = 0u;
    if (VTID == 0) *(volatile unsigned*)(smem + VSMEM - 16) = 0u;
    __syncthreads();
    for (int it = VB; it < 1024; it += VGRID) pass1(p, smem, it, vgen);
    xcd_barrier(gb);
    pass2(p);
    if (VGRID == 512) {
        const int bi = VB;
        const int hb = (int)(threadIdx.x >> 8), wg = (int)blockIdx.x;
        const int first = (hb == 0) ? wg * 5 : 1280 + wg * 7, cnt = (hb == 0) ? 5 : 7;
        int par = 1;
        for (int i = 0; i < cnt; ++i) {
            const int item = first + i, nbi = (item & 1023) & ((64 >> ((item >> 10) * 2)) - 1);
            const bool reuse = (i > 0) && (nbi > 0);
            par = reuse ? (par ^ 1) : 1;
            attn_item(p, smem, item, reuse, par, vgen);
        }
    } else {
        for (int it = VB; it < 3072; it += VGRID) attn_item(p, smem, it, false, 1, vgen);
    }
    xcd_barrier(gb);
    for (int it = VB; it < 1024; it += VGRID) pass3(p, smem, it, vgen);
    xcd_barrier(gb);
    {
        pg8::Gemm g; g.A = p.mixed(); g.Bt = p.woutT(); g.M = NTOK; g.N = 1024; g.K = 1024;
        pg8::StaticOrder S; S.init(NTOK, 1024, gridDim.x, blockIdx.x);
        EpiOut E; E.p = p;
        pg8::gemm_phase<EpiOut, pg8::StaticOrder, false>((PG8_LAS unsigned char*)dynlds, g, S, E, nullptr);
    }
}

extern "C" void kernel_launch(void* const* d_in, const int* in_sizes, int n_in, void* d_out, int out_size, void* d_ws, size_t ws_size, hipStream_t stream) {
    static int grid_blocks = 0;
    if (!grid_blocks) {
        int per_cu = 0;
        (void)hipFuncSetAttribute((const void*)fwd_kernel, hipFuncAttributeMaxDynamicSharedMemorySize, LDS_BYTES);
        (void)hipOccupancyMaxActiveBlocksPerMultiprocessor(&per_cu, fwd_kernel, 512, LDS_BYTES);
        grid_blocks = 256;
    }
    char* ws = (char*)d_ws;
    P p{};
    p.x = (const float*)d_in[0]; p.norm_w = (const float*)d_in[1]; p.w_in = (const float*)d_in[2]; p.lbl = (const float*)d_in[3];
    p.hgw = (const float*)d_in[4]; p.w_out = (const float*)d_in[5]; p.fw = (const float*)d_in[6];
    p.out = (float*)d_out;
    p.ws = ws;
    (void)hipMemsetAsync(ws + OFF_BAR, 0, OFF_END - OFF_BAR, stream);
    void* args[] = {&p};
    hipError_t e = hipLaunchCooperativeKernel((void*)fwd_kernel, dim3(grid_blocks), dim3(512), args, LDS_BYTES, stream);
    if (e != hipSuccess) fprintf(stderr, "cooperative launch failed: %s (grid %d)\n", hipGetErrorString(e), grid_blocks);
}
```

```cpp
#include <hip/hip_runtime.h>
#include <cstdio>

typedef short bf16x8 __attribute__((ext_vector_type(8)));
typedef float f32x16 __attribute__((ext_vector_type(16)));
typedef __bf16 bf2_t __attribute__((ext_vector_type(2)));
typedef float f2_t __attribute__((ext_vector_type(2)));
typedef unsigned u32x4 __attribute__((ext_vector_type(4)));
typedef unsigned short u16;
typedef _Float16 h16;
typedef _Float16 h16x4 __attribute__((ext_vector_type(4)));

#define DI __device__ __forceinline__
#define VTID ((int)(threadIdx.x & 255u))
#define VB ((int)(blockIdx.x * 2u + (threadIdx.x >> 8)))
#define VGRID ((int)(gridDim.x * 2u))
#define MFMA32(a, b, c) __builtin_amdgcn_mfma_f32_32x32x16_bf16((a), (b), (c), 0, 0, 0)

constexpr int NTOK = 16384, DM = 1024, SEQ = 8192;
constexpr float EPS = 1e-6f;
constexpr float LOG2E = 1.4426950408889634f;

constexpr size_t MB = 1024 * 1024;
constexpr size_t OFF_XB = 0;
constexpr size_t OFF_RS = OFF_XB + 32 * MB;
constexpr size_t OFF_WINT = OFF_RS + 65536;
constexpr size_t OFF_WOUTT = OFF_WINT + 8 * MB;
constexpr size_t OFF_ROPE = OFF_WOUTT + 2 * MB;
constexpr size_t OFF_HQ = OFF_ROPE + 2 * MB;
constexpr size_t OFF_LF = OFF_HQ + 16 * MB;
constexpr size_t OFF_VIT = OFF_LF + 32 * MB;
constexpr size_t OFF_HZ = OFF_VIT + 16 * MB;
constexpr size_t OFF_AQ = OFF_HZ + 16 * MB;
constexpr size_t OFF_AK = OFF_AQ + 16 * MB;
constexpr size_t OFF_AV = OFF_AK + 16 * MB;
constexpr size_t OFF_AZ = OFF_AV + 16 * MB;
constexpr size_t OFF_ST = OFF_AZ + 16 * MB;
constexpr size_t OFF_DEC = OFF_ST + 32 * MB;
constexpr size_t OFF_AO2 = OFF_DEC + 512 * 1024;
constexpr size_t OFF_LSE = OFF_AO2 + 16 * MB;
constexpr size_t OFF_BAR = OFF_LSE + 3 * 16384 * 8 * 4;
constexpr size_t OFF_ROWSS = OFF_BAR + 16384;
constexpr size_t OFF_PCNT = OFF_ROWSS + 65536;
constexpr size_t OFF_END = OFF_PCNT + 1024;

struct P {
    const float* x; const float* norm_w; const float* w_in; const float* lbl; const float* hgw; const float* w_out; const float* fw;
    float* out; char* ws;
    DI u16* xb() const { return (u16*)(ws + OFF_XB); }
    DI float* rs() const { return (float*)(ws + OFF_RS); }
    DI u16* winT() const { return (u16*)(ws + OFF_WINT); }
    DI u16* woutT() const { return (u16*)(ws + OFF_WOUTT); }
    DI float* rope() const { return (float*)(ws + OFF_ROPE); }
    DI u16* hq() const { return (u16*)(ws + OFF_HQ); }
    DI h16* lf() const { return (h16*)(ws + OFF_LF); }
    DI u16* viT() const { return (u16*)(ws + OFF_VIT); }
    DI u16* hz() const { return (u16*)(ws + OFF_HZ); }
    DI u16* aq() const { return (u16*)(ws + OFF_AQ); }
    DI u16* ak() const { return (u16*)(ws + OFF_AK); }
    DI u16* av() const { return (u16*)(ws + OFF_AV); }
    DI u16* az() const { return (u16*)(ws + OFF_AZ); }
    DI u16* ST() const { return (u16*)(ws + OFF_ST); }
    DI float* dec() const { return (float*)(ws + OFF_DEC); }
    DI u16* ao0() const { return (u16*)(ws + OFF_XB); }
    DI u16* ao1() const { return (u16*)(ws + OFF_XB + 16 * MB); }
    DI u16* ao2() const { return (u16*)(ws + OFF_AO2); }
    DI float* lse() const { return (float*)(ws + OFF_LSE); }
    DI u16* mixed() const { return (u16*)(ws + OFF_AQ); }
    DI float* rowss() const { return (float*)(ws + OFF_ROWSS); }
    DI unsigned* pcnt() const { return (unsigned*)(ws + OFF_PCNT); }
    DI unsigned* bar() const { return (unsigned*)(ws + OFF_BAR); }
};

DI unsigned pack2(float a, float b) { f2_t v = {a, b}; return __builtin_bit_cast(unsigned, __builtin_convertvector(v, bf2_t)); }
DI u16 f2bf(float x) { return (u16)(pack2(x, 0.f) & 0xffffu); }
DI float bf2f(u16 v) { return __uint_as_float(((unsigned)v) << 16); }
DI float bflo(unsigned v) { return __uint_as_float(v << 16); }
DI float bfhi(unsigned v) { return __uint_as_float(v & 0xffff0000u); }
DI int crow(int reg, int h) { return (reg & 3) + 8 * (reg >> 2) + 4 * h; }
DI float silu(float v) { return v / (1.f + __expf(-v)); }
DI bf16x8 packB(const f32x16& x, int s) {
    u32x4 pk;
    pk[0] = pack2(x[8 * s + 0], x[8 * s + 1]); pk[1] = pack2(x[8 * s + 2], x[8 * s + 3]);
    pk[2] = pack2(x[8 * s + 4], x[8 * s + 5]); pk[3] = pack2(x[8 * s + 6], x[8 * s + 7]);
    return __builtin_bit_cast(bf16x8, pk);
}
DI float kfromlf(float v) { return (v > -0.02f) ? -v * (1.f + v * (0.5f + v * (1.f / 6.f))) : 1.f - __expf(v); }


#define XB_TMO      128
#define XB_XCNT(j)  (256  + 64 * (j))
#define XB_XSUB(j)  (1280 + 64 * (j))
#define XB_XGEN(j)  (2304 + 64 * (j))
#define XB_TOP      3328
#define XB_TOPGEN   3392
#define XCD_BAR_WORDS 3456
#define XB_SPIN_CAP (1u << 22)
#define LAS __attribute__((address_space(3)))
DI unsigned xb_ld(unsigned* p) { return __hip_atomic_load(p, __ATOMIC_RELAXED, __HIP_MEMORY_SCOPE_AGENT); }
DI unsigned xb_add(unsigned* p, unsigned v) { return __hip_atomic_fetch_add(p, v, __ATOMIC_RELAXED, __HIP_MEMORY_SCOPE_AGENT); }
DI unsigned xb_xcc_id() { return (unsigned)__builtin_amdgcn_s_getreg((3 << 11) | 20) & 0xFu; }
#define XB_SPIN(cond, bar) do { unsigned _sp = 0; while (cond) { __builtin_amdgcn_s_sleep(1); \
    if ((++_sp & 255u) == 0u) { if (xb_ld(&(bar)[XB_TMO])) break; if (_sp > XB_SPIN_CAP) { atomicAdd(&(bar)[XB_TMO], 1u); break; } } } } while (0)
struct XcdBarrier { unsigned* bar; unsigned x; volatile unsigned* st; };
DI XcdBarrier xcd_barrier_post(unsigned* bar, volatile unsigned* st) {
    XcdBarrier b; b.bar = bar; b.x = xb_xcc_id(); b.st = st;
    if (threadIdx.x == 0) (void)xb_add(&bar[XB_XCNT(b.x)], 1u);
    return b;
}
DI void xcd_barrier_complete(unsigned* bar, unsigned x, unsigned& nloc, unsigned& nx) {
    const unsigned G = gridDim.x * gridDim.y * gridDim.z;
    unsigned sum, cnt, mine, sp = 0u;
    for (;;) {
        sum = 0u; cnt = 0u; mine = 0u;
#pragma unroll
        for (unsigned j = 0; j < 16; ++j) { const unsigned c = xb_ld(&bar[XB_XCNT(j)]); sum += c; cnt += (c > 0u) ? 1u : 0u; mine = (j == x) ? c : mine; }
        if (sum == G) break;
        __builtin_amdgcn_s_sleep(1);
        if ((++sp & 255u) == 0u) { if (xb_ld(&bar[XB_TMO])) break; if (sp > XB_SPIN_CAP) { atomicAdd(&bar[XB_TMO], 1u); break; } }
    }
    nloc = mine > 0u ? mine : 1u; nx = cnt > 0u ? cnt : 1u;
}
DI void xcd_barrier(const XcdBarrier& b) {
    asm volatile("s_waitcnt vmcnt(0)" ::: "memory");
    __syncthreads();
    if (threadIdx.x == 0) {
        unsigned* bar = b.bar;
        __builtin_amdgcn_s_waitcnt(0);
        unsigned nloc = b.st[0], nx = b.st[1];
        if (nloc == 0u) { xcd_barrier_complete(bar, b.x, nloc, nx); b.st[0] = nloc; b.st[1] = nx; }
        const unsigned old = xb_add(&bar[XB_XSUB(b.x)], 1u);
        const unsigned gen = old / nloc;
        if (old + 1u == (gen + 1u) * nloc) {
            __builtin_amdgcn_fence(__ATOMIC_RELEASE, "agent");
            asm volatile("s_waitcnt vmcnt(0)" ::: "memory");
            const unsigned og = xb_add(&bar[XB_TOP], 1u);
            const unsigned tg = og / nx;
            if (og + 1u == (tg + 1u) * nx) xb_add(&bar[XB_TOPGEN], 1u);
            else XB_SPIN(xb_ld(&bar[XB_TOPGEN]) == tg, bar);
            __builtin_amdgcn_fence(__ATOMIC_ACQUIRE, "agent");
            xb_add(&bar[XB_XGEN(b.x)], 1u);
            asm volatile("s_waitcnt vmcnt(0)" ::: "memory");
        } else {
            XB_SPIN(xb_ld(&bar[XB_XGEN(b.x)]) == gen, bar);
            __builtin_amdgcn_fence(__ATOMIC_ACQUIRE, "agent");
            asm volatile("s_waitcnt vmcnt(0)" ::: "memory");
        }
    }
    __syncthreads();
}

constexpr int VSMEM_C = 4 * 128 * 144;
DI void vsync(char* smem, unsigned& gen) {
    __attribute__((address_space(3))) unsigned* ctr = (__attribute__((address_space(3))) unsigned*)(smem + VSMEM_C - 16);
    gen += 4u;
    __builtin_amdgcn_fence(__ATOMIC_RELEASE, "workgroup");
    if ((threadIdx.x & 63u) == 0u) (void)__hip_atomic_fetch_add(ctr, 1u, __ATOMIC_RELAXED, __HIP_MEMORY_SCOPE_WORKGROUP);
    unsigned sp = 0u;
    while (__hip_atomic_load(ctr, __ATOMIC_RELAXED, __HIP_MEMORY_SCOPE_WORKGROUP) < gen) { __builtin_amdgcn_s_sleep(1); if (++sp > (1u << 22)) break; }
    __builtin_amdgcn_fence(__ATOMIC_ACQUIRE, "workgroup");
}

DI void phase0(const P& p, char* smem) {
    int tid = VTID;
    asm volatile("" : "+v"(tid));
    const int lane = tid & 63, wid = tid >> 6;
    for (int row = VB * 4 + wid; row < NTOK; row += VGRID * 4) {
        const float4* xr = (const float4*)(p.x + (size_t)row * DM);
        float4 v[4]; float ss = 0.f;
#pragma unroll
        for (int i = 0; i < 4; ++i) { typedef float f4v __attribute__((ext_vector_type(4))); const f4v t4 = __builtin_nontemporal_load((const f4v*)(xr + lane + 64 * i)); v[i] = make_float4(t4[0], t4[1], t4[2], t4[3]); ss += v[i].x * v[i].x + v[i].y * v[i].y + v[i].z * v[i].z + v[i].w * v[i].w; }
#pragma unroll
        for (int o = 32; o >= 1; o >>= 1) ss += __shfl_xor(ss, o);
        uint2* xo = (uint2*)(p.xb() + (size_t)row * DM);
#pragma unroll
        for (int i = 0; i < 4; ++i) xo[lane + 64 * i] = make_uint2(pack2(v[i].x, v[i].y), pack2(v[i].z, v[i].w));
        if (lane == 0) p.rs()[row] = rsqrtf(ss * (1.f / 1024.f) + EPS);
    }
    float* tile = (float*)smem;
    for (int t = VB; t < 1024 + 256; t += VGRID) {
        const float* src; u16* dst; int ncols, td, tc; bool scale;
        if (t < 1024) { src = p.w_in; dst = p.winT(); ncols = 4096; td = t >> 6; tc = t & 63; scale = true; }
        else { const int t2 = t - 1024; src = p.w_out; dst = p.woutT(); ncols = 1024; td = t2 >> 4; tc = t2 & 15; scale = false; }
#pragma unroll
        for (int i = 0; i < 4; ++i) {
            const int r = (tid >> 4) + 16 * i, c4 = (tid & 15) * 4;
            float4 v = *(const float4*)(src + (size_t)(td * 64 + r) * ncols + tc * 64 + c4);
            const float s = scale ? p.norm_w[td * 64 + r] : 1.f;
            tile[r * 65 + c4 + 0] = v.x * s; tile[r * 65 + c4 + 1] = v.y * s; tile[r * 65 + c4 + 2] = v.z * s; tile[r * 65 + c4 + 3] = v.w * s;
        }
        __syncthreads();
#pragma unroll
        for (int u = 0; u < 2; ++u) {
            const int g = (tid & 3) + 4 * u, c = tid >> 2;
            float e[8];
#pragma unroll
            for (int j = 0; j < 8; ++j) e[j] = tile[(g * 8 + j) * 65 + c];
            u32x4 pk; pk[0] = pack2(e[0], e[1]); pk[1] = pack2(e[2], e[3]); pk[2] = pack2(e[4], e[5]); pk[3] = pack2(e[6], e[7]);
            int orow = tc * 64 + c;
            if (scale && orow >= 2048 && orow < 3072) { const int d = orow & 63; orow = (orow & ~63) + ((d & 31) << 1) + (d >> 5); }
            *(u32x4*)(dst + (size_t)orow * 1024 + td * 64 + g * 8) = pk;
        }
        __syncthreads();
    }
    for (int idx = VB * 256 + tid; idx < SEQ * 32; idx += VGRID * 256) {
        const int pos = idx >> 5, j = idx & 31;
        const float inv = (float)(1.0 / exp2((double)j * (13.287712379549449 / 32.0)));
        const float ang = (float)pos * inv;
        const double rev = (double)ang * 0.15915494309189535;
        const float fr = (float)(rev - floor(rev));
        p.rope()[idx] = __builtin_amdgcn_cosf(fr);
        p.rope()[SEQ * 32 + idx] = __builtin_amdgcn_sinf(fr);
    }
}

namespace pg8 {
#define PG8_LAS __attribute__((address_space(3)))
typedef unsigned short bf16_t;
typedef short bf16x8 __attribute__((ext_vector_type(8)));
typedef float f32x4 __attribute__((ext_vector_type(4)));
typedef unsigned u32x4 __attribute__((ext_vector_type(4)));
constexpr int BM = 256, BK = 64, HALF = 128, HTB = HALF * BK * 2  , STAGE_BYTES = 8 * HTB, NXCD = 8, WGM = 8;

__host__ __device__ __forceinline__ int lds_byte(int r, int c) { const int st = (r >> 4) * 2 + (c >> 5), rr = r & 15, cc = c & 31, ob = rr * 64 + cc * 2; return st * 1024 + (ob ^ (((ob >> 9) & 1) << 5)); }
__host__ __device__ __forceinline__ void stage_rc(int b, int& R, int& C) { const int st = b / 1024, sb = b % 1024, swz = sb ^ (((sb >> 9) & 1) << 5); R = (st >> 1) * 16 + swz / 64; C = (st & 1) * 32 + (swz % 64) / 2; }
__host__ __device__ __forceinline__ int perm32(int rho) { const int n = rho >> 4, i = rho & 15; return 8 * (i >> 2) + 4 * n + (i & 3); }

struct Unit { int pm, pn; };
struct Gemm { const bf16_t* A; const bf16_t* Bt; int M, N, K; };

struct StaticOrder {
    int nM, nN, nwg, G, c;
    __host__ __device__ void init(int M, int N, int G_, int c_) { nM = M / BM; nN = N / BM; nwg = nM * nN; G = G_; c = c_; }
    __host__ __device__ bool next(int i, Unit& u) const {
        const long L = (long)i * G + c; if (L >= nwg) return false;
        int wgid = (int)L; { const int q = nwg / NXCD, r = nwg % NXCD, xcd = wgid % NXCD, off = wgid / NXCD; wgid = (xcd < r ? xcd * (q + 1) : r * (q + 1) + (xcd - r) * q) + off; }
        const int nig = WGM * nN, gid = wgid / nig, fm = gid * WGM, gsz = (nM - fm) < WGM ? (nM - fm) : WGM;
        u.pm = fm + ((wgid % nig) % gsz); u.pn = (wgid % nig) / gsz; return true;
    }
    __device__ __forceinline__ void a_ready(const Unit&) const {}
    __device__ __forceinline__ void done(const Unit&) const {}
};
template <class Epi, class Sched, bool STAMP = false>
__device__ __forceinline__ void gemm_phase(PG8_LAS unsigned char* lds, const Gemm g, const Sched& S, const Epi& E, unsigned long long* stamps) {
    const int tid = threadIdx.x, wid = __builtin_amdgcn_readfirstlane(tid >> 6), lane = tid & 63, wr = wid >> 2, wc = wid & 3, fr = lane & 15, fq = lane >> 4;
    const int K = g.K, nt = K / BK;
    int ts_lo = 0, ts_hi = 0, nts = 0; const unsigned long long rt_entry = STAMP ? (unsigned long long)wall_clock64() : 0ull;
#define PG8_STAMP() do { if (STAMP && wid == 0 && nts < 64) { const unsigned long long _c = (unsigned long long)clock64(); \
        ts_lo = (lane == nts) ? (int)(unsigned)_c : ts_lo; ts_hi = (lane == nts) ? (int)(unsigned)(_c >> 32) : ts_hi; ++nts; } } while (0)
    PG8_STAMP();
    unsigned voffA[2], voffB[2];
#pragma unroll
    for (int i = 0; i < 2; ++i) { int R, C; stage_rc(tid * 16 + i * 8192, R, C); const int Rb = Epi::PERM ? ((R & ~31) + perm32(R & 31)) : R;
        voffA[i] = (unsigned)(R * K + C) * 2u; voffB[i] = (unsigned)(Rb * K + C) * 2u; }
    const size_t kstep = (size_t)(BK * 2);
    const size_t hstep = (size_t)HALF * K * 2;
    const size_t tstep = 2 * hstep;
    const unsigned ldsw = (unsigned)wid * 1024u;
    const int aoff = lds_byte(wr * 64 + fr, fq * 8), boff = lds_byte(wc * 32 + fr, fq * 8);
#define PG8_SA(b, h) (((b) * 2 + (h)) * HTB)
#define PG8_SB(b, h) ((4 + (b) * 2 + (h)) * HTB)
#define PG8_STAGE(bufoff, gbase, voff) do { _Pragma("unroll") for (int _i = 0; _i < 2; ++_i) \
        __builtin_amdgcn_global_load_lds((const unsigned*)((const char*)(gbase) + (voff)[_i]), (PG8_LAS unsigned*)(lds + (bufoff) + ldsw + _i * 8192), 16, 0, 0); } while (0)
#define PG8_LDA(dst, b, h) do { _Pragma("unroll") for (int m = 0; m < 4; ++m) _Pragma("unroll") for (int k = 0; k < 2; ++k) dst[m][k] = *(const PG8_LAS bf16x8*)(lds + PG8_SA(b, h) + aoff + m * 2048 + k * 1024); } while (0)
#define PG8_LDB(dst, b, h) do { _Pragma("unroll") for (int n = 0; n < 2; ++n) _Pragma("unroll") for (int k = 0; k < 2; ++k) dst[n][k] = *(const PG8_LAS bf16x8*)(lds + PG8_SB(b, h) + boff + n * 2048 + k * 1024); } while (0)
#define PG8_MMA(ai, bj, At, Bt) do { __builtin_amdgcn_s_setprio(1); _Pragma("unroll") for (int m = 0; m < 4; ++m) _Pragma("unroll") for (int n = 0; n < 2; ++n) _Pragma("unroll") for (int k = 0; k < 2; ++k) \
        acc[ai][bj][m][n] = __builtin_amdgcn_mfma_f32_16x16x32_bf16(Bt[n][k], At[m][k], acc[ai][bj][m][n], 0, 0, 0); __builtin_amdgcn_s_setprio(0); } while (0)
#define PG8_WAIT_V(n) asm volatile("s_waitcnt vmcnt(" #n ")" ::: "memory")
#define PG8_WAIT_L(n) asm volatile("s_waitcnt lgkmcnt(" #n ")" ::: "memory")
#define PG8_BAR __builtin_amdgcn_s_barrier()
#define PG8_SCHED __builtin_amdgcn_sched_barrier(0)
    Unit cur, nxt; int ui = 0;
    if (!S.next(0, cur)) return;
    f32x4 acc[2][2][4][2];
#pragma unroll
    for (int a = 0; a < 2; ++a)
#pragma unroll
        for (int b = 0; b < 2; ++b)
#pragma unroll
            for (int m = 0; m < 4; ++m)
#pragma unroll
                for (int n = 0; n < 2; ++n) acc[a][b][m][n] = (f32x4){0.f, 0.f, 0.f, 0.f};
    bf16x8 At[4][2], B0[2][2], B1[2][2];
    const char* cA = (const char*)g.A + (size_t)cur.pm * tstep; const char* cB = (const char*)g.Bt + (size_t)cur.pn * tstep;
    S.a_ready(cur);
    PG8_STAGE(PG8_SB(0, 0), cB, voffB); PG8_STAGE(PG8_SA(0, 0), cA, voffA); PG8_STAGE(PG8_SB(0, 1), cB + hstep, voffB); PG8_STAGE(PG8_SA(0, 1), cA + hstep, voffA);
    if (wr == 1) PG8_BAR;
    PG8_WAIT_V(4); PG8_BAR;
    PG8_STAGE(PG8_SB(1, 0), cB + kstep, voffB); PG8_STAGE(PG8_SA(1, 0), cA + kstep, voffA); PG8_STAGE(PG8_SB(1, 1), cB + hstep + kstep, voffB);
    PG8_WAIT_V(6); PG8_BAR;
    PG8_STAMP();
    for (;;) {
        const bool has_next = S.next(ui + 1, nxt);
        const char* nA = has_next ? (const char*)g.A + (size_t)nxt.pm * tstep : cA; const char* nB = has_next ? (const char*)g.Bt + (size_t)nxt.pn * tstep : cB;
        for (int t = 0; t < nt; t += 2) {
            const bool last = (t == nt - 2);
            const char* a1 = cA + (size_t)(t + 1) * kstep;
            const char* a2 = last ? nA : cA + (size_t)(t + 2) * kstep; const char* b2 = last ? nB : cB + (size_t)(t + 2) * kstep;
            const char* a3 = a2 + kstep; const char* b3 = b2 + kstep;
            if (last && has_next) S.a_ready(nxt);
            PG8_LDB(B0, 0, 0); PG8_SCHED; PG8_LDA(At, 0, 0); PG8_STAGE(PG8_SA(1, 1), a1 + hstep, voffA);
            PG8_WAIT_L(8); PG8_BAR; PG8_WAIT_L(0); PG8_MMA(0, 0, At, B0); PG8_BAR; PG8_SCHED;
            PG8_LDB(B1, 0, 1); PG8_STAGE(PG8_SB(0, 0), b2, voffB);
            PG8_BAR; PG8_WAIT_L(0); PG8_MMA(0, 1, At, B1); PG8_BAR;
            PG8_LDA(At, 0, 1); PG8_STAGE(PG8_SA(0, 0), a2, voffA);
            PG8_BAR; PG8_WAIT_L(0); PG8_MMA(1, 0, At, B0); PG8_BAR; PG8_SCHED;
            PG8_STAGE(PG8_SB(0, 1), b2 + hstep, voffB);
            PG8_WAIT_V(6); PG8_BAR; PG8_MMA(1, 1, At, B1); PG8_BAR;
            PG8_LDB(B0, 1, 0); PG8_SCHED; PG8_LDA(At, 1, 0); PG8_STAGE(PG8_SA(0, 1), a2 + hstep, voffA);
            PG8_WAIT_L(8); PG8_BAR; PG8_WAIT_L(0); PG8_MMA(0, 0, At, B0); PG8_BAR; PG8_SCHED;
            PG8_LDB(B1, 1, 1); PG8_STAGE(PG8_SB(1, 0), b3, voffB);
            PG8_BAR; PG8_WAIT_L(0); PG8_MMA(0, 1, At, B1); PG8_BAR;
            PG8_LDA(At, 1, 1); PG8_STAGE(PG8_SA(1, 0), a3, voffA);
            PG8_BAR; PG8_WAIT_L(0); PG8_MMA(1, 0, At, B0); PG8_BAR; PG8_SCHED;
            PG8_STAGE(PG8_SB(1, 1), b3 + hstep, voffB);
            PG8_WAIT_V(6); PG8_BAR; PG8_MMA(1, 1, At, B1); PG8_BAR;
        }
        PG8_STAMP();
        if constexpr (!Epi::AFTER_DRAIN) { E(acc, cur, wr, wc, fr, fq); S.done(cur); }
        PG8_STAMP();
        if (!has_next) break;
#pragma unroll
        for (int a = 0; a < 2; ++a)
#pragma unroll
            for (int b = 0; b < 2; ++b)
#pragma unroll
                for (int m = 0; m < 4; ++m)
#pragma unroll
                    for (int n = 0; n < 2; ++n) acc[a][b][m][n] = (f32x4){0.f, 0.f, 0.f, 0.f};
        cur = nxt; cA = nA; cB = nB; ++ui;
    }
    PG8_WAIT_V(0);
    if (wr == 0) PG8_BAR;
    PG8_BAR;
    if constexpr (Epi::AFTER_DRAIN) { E.fused(acc, cur, wr, wc, fr, fq, lds, wid, lane); S.done(cur); }
    PG8_STAMP();
    if (STAMP && wid == 0) { stamps[lane] = lane < nts ? (((unsigned long long)(unsigned)ts_hi << 32) | (unsigned)ts_lo) : 0ull;
        if (lane == 62) stamps[62] = rt_entry; if (lane == 63) stamps[63] = (unsigned long long)wall_clock64(); }
#undef PG8_STAMP
#undef PG8_SA
#undef PG8_SB
#undef PG8_STAGE
#undef PG8_LDA
#undef PG8_LDB
#undef PG8_MMA
#undef PG8_WAIT_V
#undef PG8_WAIT_L
#undef PG8_BAR
#undef PG8_SCHED
}
}


struct EpiIn {
    static constexpr bool PERM = true, AFTER_DRAIN = false;
    P p;
    template <int GRP> DI void run(const pg8::f32x4 (&acc)[2][2][4][2], const pg8::Unit& u, int wr, int wc, int fr, int fq) const {
        const int cg0 = (u.pn & 1) * 256 + wc * 32 + fq * 8;
        const int row0 = u.pm * 256 + wr * 64 + fr;
        float oml[2][8];
        if (GRP == 1) {
#pragma unroll
            for (int bj = 0; bj < 2; ++bj) {
                const float* l0 = p.lbl + cg0 + 128 * bj;
#pragma unroll
                for (int j = 0; j < 8; ++j) {
                    float lb = __builtin_amdgcn_rcpf(1.f + __builtin_amdgcn_exp2f((l0[512 + j] - l0[j]) * LOG2E));
                    lb = fminf(fmaxf(lb, 1e-6f), 1.f - 1e-6f);
                    oml[bj][j] = 1.f - lb;
                }
            }
        }
        float rsv[2][4];
#pragma unroll
        for (int ai = 0; ai < 2; ++ai)
#pragma unroll
            for (int m = 0; m < 4; ++m) rsv[ai][m] = p.rs()[row0 + 128 * ai + 16 * m];
#pragma unroll
        for (int ai = 0; ai < 2; ++ai)
#pragma unroll
            for (int m = 0; m < 4; ++m) {
                const int row = row0 + 128 * ai + 16 * m;
                const float rs = rsv[ai][m];
#pragma unroll
                for (int bj = 0; bj < 2; ++bj) {
                    const int cg = cg0 + 128 * bj;
                    float v[8];
#pragma unroll
                    for (int j = 0; j < 8; ++j) v[j] = acc[ai][bj][m][j >> 2][j & 3] * rs;
                    if (GRP == 2) {
                        const int b = row >> 13, t = row & 8191;
                        u16* dst = p.viT() + ((size_t)(b * 512 + cg)) * 8192 + t;
#pragma unroll
                        for (int j = 0; j < 8; ++j) dst[(size_t)j * 8192] = f2bf(v[j]);
                    } else if (GRP == 1) {
                        typedef _Float16 h16x8 __attribute__((ext_vector_type(8)));
                        h16x8 hv;
#pragma unroll
                        for (int j = 0; j < 8; ++j) hv[j] = (h16)(__builtin_amdgcn_logf(1.f - oml[bj][j] * __builtin_amdgcn_rcpf(1.f + __builtin_amdgcn_exp2f(v[j] * LOG2E))) * 0.6931471805599453f);
                        *(h16x8*)(p.lf() + ((size_t)((row >> 13) * 4 + (cg >> 7)) * 8192 + (row & 8191)) * 128 + (cg & 127)) = hv;
                    } else {
                        float o[8];
                        if (GRP == 0 || GRP == 3 || GRP == 7) {
#pragma unroll
                            for (int j = 0; j < 8; ++j) o[j] = v[j] * __builtin_amdgcn_rcpf(1.f + __builtin_amdgcn_exp2f(-v[j] * LOG2E));
                        } else if (GRP == 6) {
#pragma unroll
                            for (int j = 0; j < 8; ++j) o[j] = v[j];
                        } else {
                            const float sc = (GRP == 4) ? 0.125f : 1.f;
                            const int f0 = (cg & 63) >> 1, pos = row & 8191;
                            const float4 c4 = *(const float4*)(p.rope() + pos * 32 + f0), s4 = *(const float4*)(p.rope() + SEQ * 32 + pos * 32 + f0);
                            const float cs[4] = {c4.x, c4.y, c4.z, c4.w}, sn[4] = {s4.x, s4.y, s4.z, s4.w};
#pragma unroll
                            for (int i = 0; i < 4; ++i) {
                                o[2 * i] = (v[2 * i] * cs[i] - v[2 * i + 1] * sn[i]) * sc;
                                o[2 * i + 1] = (v[2 * i + 1] * cs[i] + v[2 * i] * sn[i]) * sc;
                            }
                        }
                        const size_t doff = (GRP == 4 || GRP == 5 || GRP == 6) ? ((size_t)((row >> 13) * 8 + (cg >> 6)) * 8192 + (row & 8191)) * 64 + (cg & 63)
                                                                                : ((size_t)((row >> 13) * 4 + (cg >> 7)) * 8192 + (row & 8191)) * 128 + (cg & 127);
                        u16* dst = ((GRP == 0) ? p.hq() : (GRP == 3) ? p.hz() : (GRP == 4) ? p.aq() : (GRP == 5) ? p.ak() : (GRP == 6) ? p.av() : p.az()) + doff;
                        u32x4 pk; pk[0] = pack2(o[0], o[1]); pk[1] = pack2(o[2], o[3]); pk[2] = pack2(o[4], o[5]); pk[3] = pack2(o[6], o[7]);
                        *(u32x4*)dst = pk;
                    }
                }
            }
    }
    DI void operator()(const pg8::f32x4 (&acc)[2][2][4][2], const pg8::Unit& u, int wr, int wc, int fr, int fq) const {
        switch (u.pn >> 1) {
            case 0: run<0>(acc, u, wr, wc, fr, fq); break;
            case 1: run<1>(acc, u, wr, wc, fr, fq); break;
            case 2: run<2>(acc, u, wr, wc, fr, fq); break;
            case 3: run<3>(acc, u, wr, wc, fr, fq); break;
            case 4: run<4>(acc, u, wr, wc, fr, fq); break;
            case 5: run<5>(acc, u, wr, wc, fr, fq); break;
            case 6: run<6>(acc, u, wr, wc, fr, fq); break;
            default: run<7>(acc, u, wr, wc, fr, fq); break;
        }
    }
};

DI void pass1(const P& p, char* smem, int item, unsigned& vgen) {
    int tid = VTID;
    asm volatile("" : "+v"(tid));
    const int lane = tid & 63, wid = tid >> 6, l31 = lane & 31, lh = lane >> 5;
    const int bh = item >> 7, c = item & 127, b = bh >> 2, h = bh & 3;
    const size_t m0 = (size_t)b * 8192 + c * 64;
    float* tot = (float*)smem;
    char* kdT = smem + 1024;
    const int k = tid & 127, half = tid >> 7;
    const h16* lfp = p.lf() + ((size_t)(b * 4 + h) * 8192 + c * 64 + half * 32) * 128 + k;
    float v[32]; float T = 0.f;
#pragma unroll
    for (int i = 0; i < 32; ++i) { v[i] = (float)lfp[(size_t)i * 128]; T += v[i]; }
    tot[half * 128 + k] = T;
    vsync(smem, vgen);
    const float other = tot[(half ^ 1) * 128 + k];
    float suf = (half == 0) ? other : 0.f;
    float kd[32];
#pragma unroll
    for (int i = 31; i >= 0; --i) { kd[i] = kfromlf(v[i]) * __expf(suf); suf += v[i]; }
#pragma unroll
    for (int q = 0; q < 4; ++q) {
        u32x4 pk;
        pk[0] = pack2(kd[8 * q + 0], kd[8 * q + 1]); pk[1] = pack2(kd[8 * q + 2], kd[8 * q + 3]);
        pk[2] = pack2(kd[8 * q + 4], kd[8 * q + 5]); pk[3] = pack2(kd[8 * q + 6], kd[8 * q + 7]);
        *(u32x4*)(kdT + k * 144 + half * 64 + q * 16) = pk;
    }
    if (half == 0) p.dec()[(size_t)item * 128 + k] = __expf(T + other);
    vsync(smem, vgen);
    const u16* vrow = p.viT() + ((size_t)(b * 512 + h * 128 + wid * 32 + l31)) * 8192 + c * 64;
    f32x16 acc[4];
#pragma unroll
    for (int n = 0; n < 4; ++n)
#pragma unroll
        for (int r = 0; r < 16; ++r) acc[n][r] = 0.f;
#pragma unroll
    for (int ks = 0; ks < 4; ++ks) {
        const bf16x8 a = *(const bf16x8*)(vrow + ks * 16 + lh * 8);
#pragma unroll
        for (int nt = 0; nt < 4; ++nt) {
            const bf16x8 bb = *(const bf16x8*)(kdT + (nt * 32 + l31) * 144 + (ks * 16 + lh * 8) * 2);
            acc[nt] = MFMA32(a, bb, acc[nt]);
        }
    }
    u16* so = p.ST() + (size_t)item * 16384;
#pragma unroll
    for (int nt = 0; nt < 4; ++nt)
#pragma unroll
        for (int r = 0; r < 16; ++r) so[(wid * 32 + crow(r, lh)) * 128 + nt * 32 + l31] = f2bf(acc[nt][r]);
    vsync(smem, vgen);
}

DI void pass2(const P& p) {
    int tid = VTID;
    asm volatile("" : "+v"(tid));
    if ((threadIdx.x >> 8) == 0u)
    for (int e = (int)blockIdx.x * 256 + tid; e < 65536; e += (int)gridDim.x * 256) {
        const int bh = e >> 13, rem = e & 8191, k2 = (rem & 63) * 2;
        unsigned* st = (unsigned*)p.ST() + (size_t)bh * 128 * 8192 + rem;
        const float2* dc = (const float2*)(p.dec() + (size_t)bh * 128 * 128 + k2);
        float r0 = 0.f, r1 = 0.f;
        for (int c0 = 0; c0 < 128; c0 += 8) {
            unsigned s[8]; float2 d[8];
#pragma unroll
            for (int j = 0; j < 8; ++j) { s[j] = st[(size_t)(c0 + j) * 8192]; d[j] = dc[(c0 + j) * 64]; }
#pragma unroll
            for (int j = 0; j < 8; ++j) {
                st[(size_t)(c0 + j) * 8192] = pack2(r0, r1);
                r0 = d[j].x * r0 + bflo(s[j]); r1 = d[j].y * r1 + bfhi(s[j]);
            }
        }
    }
}

DI void attn_item(const P& p, char* smem, int item, bool reuse, int par, unsigned& vgen) {
    int tid = VTID;
    asm volatile("" : "+v"(tid));
    const int lane = tid & 63, wid = tid >> 6, l31 = lane & 31, lh = lane >> 5;
    const int pat = item >> 10, idx = item & 1023;
    const int dl = pat * 2, d = 1 << dl, nblk = 64 >> dl;
    const int nb = idx & (nblk - 1);
    int rest = idx >> (6 - dl);
    const int r = rest & (d - 1); rest >>= dl;
    const int hh = rest & 7, b = rest >> 3;
    char* Ks = smem;
    char* VT = smem + 256 * 144;
    const size_t tokbase = ((size_t)b * 8 + hh) * 8192;
    {
        const int c8 = tid & 7, g4 = (tid >> 3) * 4;
#pragma unroll
        for (int hlf = 0; hlf < 2; ++hlf) {
            if (hlf == 0 && (reuse || nb == 0)) continue;
            const int pk0 = g4 + 128 * (hlf ^ par ^ 1);
            u32x4 vv[4];
#pragma unroll
            for (int i = 0; i < 4; ++i) {
                const size_t off = (tokbase + (size_t)(nb * 128 - 128 + hlf * 128 + g4 + i) * d + r) * 64 + c8 * 8;
                const u32x4 kv = *(const u32x4*)(p.ak() + off);
                vv[i] = *(const u32x4*)(p.av() + off);
                *(u32x4*)(Ks + (pk0 + i) * 144 + c8 * 16) = kv;
            }
#pragma unroll
            for (int q = 0; q < 4; ++q) {
                uint2 lo, hi;
                lo.x = (vv[0][q] & 0xffffu) | (vv[1][q] << 16); lo.y = (vv[2][q] & 0xffffu) | (vv[3][q] << 16);
                hi.x = (vv[0][q] >> 16) | (vv[1][q] & 0xffff0000u); hi.y = (vv[2][q] >> 16) | (vv[3][q] & 0xffff0000u);
                char* r0p = VT + (c8 * 8 + 2 * q) * 520 + pk0 * 2;
                *(uint2*)r0p = lo;
                *(uint2*)(r0p + 520) = hi;
            }
        }
    }
    const int jq = nb * 128 + wid * 32 + l31;
    const size_t mq = tokbase + (size_t)jq * d + r;
    bf16x8 qf[4];
#pragma unroll
    for (int ks = 0; ks < 4; ++ks) qf[ks] = *(const bf16x8*)(p.aq() + mq * 64 + ks * 16 + lh * 8);
    vsync(smem, vgen);
    const int kt_lo = (nb == 0) ? 4 : 0;
    f32x16 st[5];
    float mx = -INFINITY;
#pragma unroll
    for (int i = 0; i < 5; ++i) {
        const int kt = wid + i;
        const int pkt = (kt & 3) + 4 * ((kt >> 2) ^ par ^ 1);
        if (kt >= kt_lo) {
#pragma unroll
            for (int rr = 0; rr < 16; ++rr) st[i][rr] = 0.f;
#pragma unroll
            for (int ks = 0; ks < 4; ++ks) {
                const bf16x8 a = *(const bf16x8*)(Ks + (pkt * 32 + l31) * 144 + (ks * 16 + lh * 8) * 2);
                st[i] = MFMA32(a, qf[ks], st[i]);
            }
#pragma unroll
            for (int rr = 0; rr < 16; ++rr) {
                if (i == 0 && crow(rr, lh) < l31) st[i][rr] = -INFINITY;
                if (i == 4 && crow(rr, lh) > l31) st[i][rr] = -INFINITY;
                mx = fmaxf(mx, st[i][rr]);
            }
        } else {
#pragma unroll
            for (int rr = 0; rr < 16; ++rr) st[i][rr] = -INFINITY;
        }
    }
    mx = fmaxf(mx, __shfl_xor(mx, 32));
    const float mxs = mx * LOG2E;
#pragma unroll
    for (int i = 0; i < 5; ++i)
#pragma unroll
        for (int rr = 0; rr < 16; ++rr) st[i][rr] = __builtin_amdgcn_exp2f(st[i][rr] * LOG2E - mxs);
    f32x16 o[2], lsum;
#pragma unroll
    for (int rr = 0; rr < 16; ++rr) { o[0][rr] = 0.f; o[1][rr] = 0.f; lsum[rr] = 0.f; }
    u32x4 ones4; ones4[0] = ones4[1] = ones4[2] = ones4[3] = 0x3f803f80u;
    const bf16x8 ones = __builtin_bit_cast(bf16x8, ones4);
#pragma unroll
    for (int i = 0; i < 5; ++i) {
        const int kt = wid + i;
        const int pkt = (kt & 3) + 4 * ((kt >> 2) ^ par ^ 1);
        if (kt >= kt_lo) {
#pragma unroll
            for (int ks2 = 0; ks2 < 2; ++ks2) {
                const bf16x8 bq = packB(st[i], ks2);
                lsum = MFMA32(ones, bq, lsum);
#pragma unroll
                for (int dt = 0; dt < 2; ++dt) {
                    const char* ad = VT + (dt * 32 + l31) * 520 + (pkt * 32 + ks2 * 16 + lh * 4) * 2;
                    const uint2 lo = *(const uint2*)ad, hi = *(const uint2*)(ad + 16);
                    u32x4 av4; av4[0] = lo.x; av4[1] = lo.y; av4[2] = hi.x; av4[3] = hi.y;
                    o[dt] = MFMA32(__builtin_bit_cast(bf16x8, av4), bq, o[dt]);
                }
            }
        }
    }
    const float l = lsum[0];
    const float inv = __builtin_amdgcn_rcpf(l);
    u16* op = (pat == 0 ? p.ao0() : (pat == 1 ? p.ao1() : p.ao2())) + mq * 64;
#pragma unroll
    for (int dt = 0; dt < 2; ++dt)
#pragma unroll
        for (int g4 = 0; g4 < 4; ++g4)
            *(uint2*)(op + dt * 32 + g4 * 8 + lh * 4) = make_uint2(pack2(o[dt][g4 * 4] * inv, o[dt][g4 * 4 + 1] * inv), pack2(o[dt][g4 * 4 + 2] * inv, o[dt][g4 * 4 + 3] * inv));
    if (lh == 0) p.lse()[((size_t)pat * NTOK + (size_t)b * 8192 + (size_t)jq * d + r) * 8 + hh] = mx + __logf(l);
    vsync(smem, vgen);
}

DI void pass3(const P& p, char* smem, int item, unsigned& vgen) {
    int tid = VTID;
    asm volatile("" : "+v"(tid));
    const int lane = tid & 63, wid = tid >> 6, l31 = lane & 31, lh = lane >> 5;
    const int bh = item >> 7, c = item & 127, b = bh >> 2, h = bh & 3;
    const size_t m0 = (size_t)b * 8192 + c * 64;
    float* tot = (float*)smem;
    float* red = (float*)(smem + 1024);
    char* Qp = smem + 2048;
    char* Qpp = Qp + 64 * 272;
    char* Kp = Qpp + 64 * 272;
    u32x4 ca0[4], ca1[4], ca2[4], caz[4]; float cl0[4], cl1[4], cl2[4];
#pragma unroll
    for (int i = 0; i < 4; ++i) {
        const int e = tid + 256 * i, r = e >> 4, ch = (e & 15) + 16 * h;
        const size_t m = m0 + r; const int hh = ch >> 3;
        const size_t ho = (((size_t)b * 8 + hh) * 8192 + (size_t)c * 64 + r) * 64 + (ch & 7) * 8;
        ca0[i] = *(const u32x4*)(p.ao0() + ho); ca1[i] = *(const u32x4*)(p.ao1() + ho); ca2[i] = *(const u32x4*)(p.ao2() + ho);
        caz[i] = *(const u32x4*)(p.az() + ((size_t)(b * 4 + h) * 8192 + (size_t)c * 64 + r) * 128 + (e & 15) * 8);
        cl0[i] = p.lse()[m * 8 + hh]; cl1[i] = p.lse()[((size_t)NTOK + m) * 8 + hh]; cl2[i] = p.lse()[((size_t)2 * NTOK + m) * 8 + hh];
    }
    {
        const int k = tid & 127, half = tid >> 7;
        const h16* lfp = p.lf() + ((size_t)(b * 4 + h) * 8192 + c * 64 + half * 32) * 128 + k;
        const u16* qp = p.hq() + ((size_t)(b * 4 + h) * 8192 + c * 64 + half * 32) * 128 + k;
        float v[32]; float T = 0.f;
#pragma unroll
        for (int i = 0; i < 32; ++i) { v[i] = (float)lfp[(size_t)i * 128]; T += v[i]; }
        tot[half * 128 + k] = T;
        vsync(smem, vgen);
        const float other = tot[(half ^ 1) * 128 + k];
        const float bref = (half == 0) ? T : other;
        const float ebref = __expf(bref);
        const float sub = (half == 0) ? T : 0.f;
        float pre = 0.f;
#pragma unroll
        for (int i = 0; i < 32; ++i) {
            pre += v[i];
            const float xx = pre - sub;
            const float E1 = __builtin_amdgcn_exp2f(xx * LOG2E), Ei = __builtin_amdgcn_exp2f(-xx * LOG2E);
            const float q = bf2f(qp[(size_t)i * 128]);
            const float kk = kfromlf(v[i]);
            const int row = half * 32 + i;
            *(u16*)(Qp + row * 272 + k * 2) = f2bf(q * E1);
            *(u16*)(Qpp + row * 272 + k * 2) = f2bf(q * E1 * ebref);
            *(u16*)(Kp + row * 272 + k * 2) = f2bf(kk * Ei);
        }
    }
    vsync(smem, vgen);
    const int tt = wid & 1, vh = wid >> 1;
    f32x16 at[2];
#pragma unroll
    for (int st = 0; st < 2; ++st) {
#pragma unroll
        for (int rr = 0; rr < 16; ++rr) at[st][rr] = 0.f;
        if (st <= tt) {
#pragma unroll
            for (int ks = 0; ks < 8; ++ks) {
                const bf16x8 a = *(const bf16x8*)(Kp + (st * 32 + l31) * 272 + (ks * 16 + lh * 8) * 2);
                const bf16x8 bq = *(const bf16x8*)(Qp + (tt * 32 + l31) * 272 + (ks * 16 + lh * 8) * 2);
                at[st] = MFMA32(a, bq, at[st]);
            }
            if (st == tt) {
#pragma unroll
                for (int rr = 0; rr < 16; ++rr) if (crow(rr, lh) > l31) at[st][rr] = 0.f;
            }
        }
    }
    f32x16 o[2];
#pragma unroll
    for (int vt = 0; vt < 2; ++vt) {
#pragma unroll
        for (int rr = 0; rr < 16; ++rr) o[vt][rr] = 0.f;
        const int vrow = 64 * vh + 32 * vt + l31;
        const u16* srow = p.ST() + (size_t)item * 16384 + vrow * 128;
#pragma unroll
        for (int ks = 0; ks < 8; ++ks) {
            const bf16x8 a = *(const bf16x8*)(srow + ks * 16 + lh * 8);
            const bf16x8 bq = *(const bf16x8*)(Qpp + (tt * 32 + l31) * 272 + (ks * 16 + lh * 8) * 2);
            o[vt] = MFMA32(a, bq, o[vt]);
        }
        const u16* vr = p.viT() + ((size_t)(b * 512 + h * 128 + vrow)) * 8192 + c * 64;
#pragma unroll
        for (int st = 0; st < 2; ++st) {
            if (st <= tt) {
#pragma unroll
                for (int ks2 = 0; ks2 < 2; ++ks2) {
                    const uint2 lo = *(const uint2*)(vr + st * 32 + ks2 * 16 + lh * 4);
                    const uint2 hi = *(const uint2*)(vr + st * 32 + ks2 * 16 + 8 + lh * 4);
                    u32x4 av4; av4[0] = lo.x; av4[1] = lo.y; av4[2] = hi.x; av4[3] = hi.y;
                    o[vt] = MFMA32(__builtin_bit_cast(bf16x8, av4), packB(at[st], ks2), o[vt]);
                }
            }
        }
    }
    float ss = 0.f;
#pragma unroll
    for (int vt = 0; vt < 2; ++vt)
#pragma unroll
        for (int rr = 0; rr < 16; ++rr) ss += o[vt][rr] * o[vt][rr];
    ss += __shfl_xor(ss, 32);
    if (lh == 0) red[vh * 64 + tt * 32 + l31] = ss;
    vsync(smem, vgen);
    const float tot2 = red[tt * 32 + l31] + red[64 + tt * 32 + l31];
    const float rinv = rsqrtf(tot2 * (1.f / 128.f) + EPS);
    const size_t m = m0 + tt * 32 + l31;
#pragma unroll
    for (int vt = 0; vt < 2; ++vt)
#pragma unroll
        for (int g4 = 0; g4 < 4; ++g4) {
            const int vb = 64 * vh + 32 * vt + 8 * g4 + 4 * lh;
            const float4 gw = *(const float4*)(p.hgw + h * 128 + vb);
            const uint2 zz = *(const uint2*)(p.hz() + ((size_t)(b * 4 + h) * 8192 + (size_t)c * 64 + tt * 32 + l31) * 128 + vb);
            const float y0 = o[vt][g4 * 4 + 0] * rinv * gw.x * bflo(zz.x);
            const float y1 = o[vt][g4 * 4 + 1] * rinv * gw.y * bfhi(zz.x);
            const float y2 = o[vt][g4 * 4 + 2] * rinv * gw.z * bflo(zz.y);
            const float y3 = o[vt][g4 * 4 + 3] * rinv * gw.w * bfhi(zz.y);
            *(uint2*)(p.mixed() + m * 1024 + h * 128 + vb) = make_uint2(pack2(y0, y1), pack2(y2, y3));
        }
#pragma unroll
    for (int i = 0; i < 4; ++i) {
        const int e = tid + 256 * i, r = e >> 4, ch = (e & 15) + 16 * h;
        const float mx = fmaxf(cl0[i], fmaxf(cl1[i], cl2[i]));
        float w0 = __expf(cl0[i] - mx), w1 = __expf(cl1[i] - mx), w2 = __expf(cl2[i] - mx);
        const float inv = __builtin_amdgcn_rcpf(w0 + w1 + w2);
        w0 *= inv; w1 *= inv; w2 *= inv;
        u32x4 pk;
#pragma unroll
        for (int q = 0; q < 4; ++q) {
            const float y0 = (w0 * bflo(ca0[i][q]) + w1 * bflo(ca1[i][q]) + w2 * bflo(ca2[i][q])) * bflo(caz[i][q]);
            const float y1 = (w0 * bfhi(ca0[i][q]) + w1 * bfhi(ca1[i][q]) + w2 * bfhi(ca2[i][q])) * bfhi(caz[i][q]);
            pk[q] = pack2(y0, y1);
        }
        *(u32x4*)(p.mixed() + (m0 + r) * 1024 + 512 + ch * 8) = pk;
    }
    vsync(smem, vgen);
}

struct EpiOut {
    static constexpr bool PERM = false, AFTER_DRAIN = true;
    P p;
    DI void fused(pg8::f32x4 (&acc)[2][2][4][2], const pg8::Unit& u, int wr, int wc, int fr, int fq, PG8_LAS unsigned char* lds, int wid, int lane) const {
        PG8_LAS float* Pt = (PG8_LAS float*)lds;
        PG8_LAS float* Rt = (PG8_LAS float*)(lds + 4096);
        const int tid = threadIdx.x;
        const int rl0 = wr * 64 + fr, c0 = u.pn * 256 + wc * 32 + fq * 4;
#pragma unroll
        for (int ai = 0; ai < 2; ++ai)
#pragma unroll
            for (int m = 0; m < 4; ++m) {
                __builtin_amdgcn_sched_barrier(0);
                const int rl = rl0 + 128 * ai + 16 * m;
                const float* xr = p.x + ((size_t)u.pm * 256 + rl) * 1024 + c0;
                float ss = 0.f;
#pragma unroll
                for (int bj = 0; bj < 2; ++bj)
#pragma unroll
                    for (int n = 0; n < 2; ++n) {
                        const float4 xv = *(const float4*)(xr + 128 * bj + 16 * n);
                        pg8::f32x4& a = acc[ai][bj][m][n];
                        a[0] += xv.x; a[1] += xv.y; a[2] += xv.z; a[3] += xv.w;
                        ss = fmaf(a[0], a[0], ss); ss = fmaf(a[1], a[1], ss); ss = fmaf(a[2], a[2], ss); ss = fmaf(a[3], a[3], ss);
                    }
                ss += __shfl_xor(ss, 16); ss += __shfl_xor(ss, 32);
                if (fq == 0) Pt[rl * 4 + wc] = ss;
            }
        __syncthreads();
        if (tid < 256) (void)__hip_atomic_fetch_add(p.rowss() + u.pm * 256 + tid, (Pt[tid * 4] + Pt[tid * 4 + 1]) + (Pt[tid * 4 + 2] + Pt[tid * 4 + 3]), __ATOMIC_RELAXED, __HIP_MEMORY_SCOPE_AGENT);
        __threadfence();
        __syncthreads();
        if (tid == 0) {
            (void)__hip_atomic_fetch_add(p.pcnt() + u.pm, 1u, __ATOMIC_RELAXED, __HIP_MEMORY_SCOPE_AGENT);
            unsigned sp = 0;
            while (__hip_atomic_load(p.pcnt() + u.pm, __ATOMIC_RELAXED, __HIP_MEMORY_SCOPE_AGENT) < 4u) { __builtin_amdgcn_s_sleep(2); if (++sp > (1u << 22)) break; }
            __builtin_amdgcn_fence(__ATOMIC_ACQUIRE, "agent");
        }
        __syncthreads();
        if (tid < 256) Rt[tid] = rsqrtf(__hip_atomic_load(p.rowss() + u.pm * 256 + tid, __ATOMIC_RELAXED, __HIP_MEMORY_SCOPE_AGENT) * (1.f / 1024.f) + EPS);
        __syncthreads();
#pragma unroll
        for (int ai = 0; ai < 2; ++ai)
#pragma unroll
            for (int m = 0; m < 4; ++m) {
                __builtin_amdgcn_sched_barrier(0);
                const int rl = rl0 + 128 * ai + 16 * m;
                const float rinv = Rt[rl];
                float* orow = p.out + ((size_t)u.pm * 256 + rl) * 1024 + c0;
#pragma unroll
                for (int bj = 0; bj < 2; ++bj)
#pragma unroll
                    for (int n = 0; n < 2; ++n) {
                        const float4 fwv = *(const float4*)(p.fw + c0 + 128 * bj + 16 * n);
                        const pg8::f32x4& a = acc[ai][bj][m][n];
                        *(float4*)(orow + 128 * bj + 16 * n) = make_float4(a[0] * rinv * fwv.x, a[1] * rinv * fwv.y, a[2] * rinv * fwv.z, a[3] * rinv * fwv.w);
                    }
            }
    }
};

constexpr int VSMEM = 4 * 128 * 144;
constexpr int LDS_BYTES = 163840;

__global__ void __launch_bounds__(512, 2) fwd_kernel(P p) {
    extern __shared__ __attribute__((aligned(16))) unsigned char dynlds[];
    volatile unsigned* xbw = (volatile unsigned*)(dynlds + LDS_BYTES - 16);
    if (threadIdx.x < 4) xbw[threadIdx.x] = 0u;
    __syncthreads();
    const XcdBarrier gb = xcd_barrier_post(p.bar(), xbw);
    char* smem = (char*)dynlds + (threadIdx.x >> 8) * VSMEM;
    phase0(p, smem);
    xcd_barrier(gb);
    {
        pg8::Gemm g; g.A = p.xb(); g.Bt = p.winT(); g.M = NTOK; g.N = 4096; g.K = 1024;
        pg8::StaticOrder S; S.init(NTOK, 4096, gridDim.x, blockIdx.x);
        EpiIn E; E.p = p;
        pg8::gemm_phase<EpiIn, pg8::StaticOrder, false>((PG8_LAS unsigned char*)dynlds, g, S, E, nullptr);
    }
    xcd_barrier(gb);
    unsigned vgen = 0u;
    if (VTID == 0) *(volatile unsigned*)(smem + VSMEM - 16) = 0u;
    __syncthreads();
    for (int it = VB; it < 1024; it += VGRID) pass1(p, smem, it, vgen);
    xcd_barrier(gb);
    pass2(p);
    if (VGRID == 512) {
        const int bi = VB;
        const int hb = (int)(threadIdx.x >> 8), wg = (int)blockIdx.x;
        const int first = (hb == 0) ? wg * 5 : 1280 + wg * 7, cnt = (hb == 0) ? 5 : 7;
        int par = 1;
        for (int i = 0; i < cnt; ++i) {
            const int item = first + i, nbi = (item & 1023) & ((64 >> ((item >> 10) * 2)) - 1);
            const bool reuse = (i > 0) && (nbi > 0);
            par = reuse ? (par ^ 1) : 1;
            attn_item(p, smem, item, reuse, par, vgen);
        }
    } else {
        for (int it = VB; it < 3072; it += VGRID) attn_item(p, smem, it, false, 1, vgen);
    }
    xcd_barrier(gb);
    for (int it = VB; it < 1024; it += VGRID) pass3(p, smem, it, vgen);
    xcd_barrier(gb);
    {
        pg8::Gemm g; g.A = p.mixed(); g.Bt = p.woutT(); g.M = NTOK; g.N = 1024; g.K = 1024;
        pg8::StaticOrder S; S.init(NTOK, 1024, gridDim.x, blockIdx.x);
        EpiOut E; E.p = p;
        pg8::gemm_phase<EpiOut, pg8::StaticOrder, false>((PG8_LAS unsigned char*)dynlds, g, S, E, nullptr);
    }
}

extern "C" void kernel_launch(void* const* d_in, const int* in_sizes, int n_in, void* d_out, int out_size, void* d_ws, size_t ws_size, hipStream_t stream) {
    static int grid_blocks = 0;
    if (!grid_blocks) {
        int per_cu = 0;
        (void)hipFuncSetAttribute((const void*)fwd_kernel, hipFuncAttributeMaxDynamicSharedMemorySize, LDS_BYTES);
        (void)hipOccupancyMaxActiveBlocksPerMultiprocessor(&per_cu, fwd_kernel, 512, LDS_BYTES);
        grid_blocks = 256;
    }
    char* ws = (char*)d_ws;
    P p{};
    p.x = (const float*)d_in[0]; p.norm_w = (const float*)d_in[1]; p.w_in = (const float*)d_in[2]; p.lbl = (const float*)d_in[3];
    p.hgw = (const float*)d_in[4]; p.w_out = (const float*)d_in[5]; p.fw = (const float*)d_in[6];
    p.out = (float*)d_out;
    p.ws = ws;
    (void)hipMemsetAsync(ws + OFF_BAR, 0, OFF_END - OFF_BAR, stream);
    void* args[] = {&p};
    hipError_t e = hipLaunchCooperativeKernel((void*)fwd_kernel, dim3(grid_blocks), dim3(512), args, LDS_BYTES, stream);
    if (e != hipSuccess) fprintf(stderr, "cooperative launch failed: %s (grid %d)\n", hipGetErrorString(e), grid_blocks);
}
```

```cpp
#include <hip/hip_runtime.h>
#include <cstdio>

typedef short bf16x8 __attribute__((ext_vector_type(8)));
typedef float f32x16 __attribute__((ext_vector_type(16)));
typedef __bf16 bf2_t __attribute__((ext_vector_type(2)));
typedef float f2_t __attribute__((ext_vector_type(2)));
typedef unsigned u32x4 __attribute__((ext_vector_type(4)));
typedef unsigned short u16;
typedef _Float16 h16;
typedef _Float16 h16x4 __attribute__((ext_vector_type(4)));

#define DI __device__ __forceinline__
#define VTID ((int)(threadIdx.x & 255u))
#define VB ((int)(blockIdx.x * 2u + (threadIdx.x >> 8)))
#define VGRID ((int)(gridDim.x * 2u))
#define MFMA32(a, b, c) __builtin_amdgcn_mfma_f32_32x32x16_bf16((a), (b), (c), 0, 0, 0)

constexpr int NTOK = 16384, DM = 1024, SEQ = 8192;
constexpr float EPS = 1e-6f;
constexpr float LOG2E = 1.4426950408889634f;

constexpr size_t MB = 1024 * 1024;
constexpr size_t OFF_XB = 0;
constexpr size_t OFF_RS = OFF_XB + 32 * MB;
constexpr size_t OFF_WINT = OFF_RS + 65536;
constexpr size_t OFF_WOUTT = OFF_WINT + 8 * MB;
constexpr size_t OFF_ROPE = OFF_WOUTT + 2 * MB;
constexpr size_t OFF_HQ = OFF_ROPE + 2 * MB;
constexpr size_t OFF_LF = OFF_HQ + 16 * MB;
constexpr size_t OFF_VIT = OFF_LF + 32 * MB;
constexpr size_t OFF_HZ = OFF_VIT + 16 * MB;
constexpr size_t OFF_AQ = OFF_HZ + 16 * MB;
constexpr size_t OFF_AK = OFF_AQ + 16 * MB;
constexpr size_t OFF_AV = OFF_AK + 16 * MB;
constexpr size_t OFF_AZ = OFF_AV + 16 * MB;
constexpr size_t OFF_ST = OFF_AZ + 16 * MB;
constexpr size_t OFF_DEC = OFF_ST + 32 * MB;
constexpr size_t OFF_AO2 = OFF_DEC + 512 * 1024;
constexpr size_t OFF_LSE = OFF_AO2 + 16 * MB;
constexpr size_t OFF_BAR = OFF_LSE + 3 * 16384 * 8 * 4;
constexpr size_t OFF_ROWSS = OFF_BAR + 16384;
constexpr size_t OFF_PCNT = OFF_ROWSS + 65536;
constexpr size_t OFF_END = OFF_PCNT + 1024;

struct P {
    const float* x; const float* norm_w; const float* w_in; const float* lbl; const float* hgw; const float* w_out; const float* fw;
    float* out; char* ws;
    DI u16* xb() const { return (u16*)(ws + OFF_XB); }
    DI float* rs() const { return (float*)(ws + OFF_RS); }
    DI u16* winT() const { return (u16*)(ws + OFF_WINT); }
    DI u16* woutT() const { return (u16*)(ws + OFF_WOUTT); }
    DI float* rope() const { return (float*)(ws + OFF_ROPE); }
    DI u16* hq() const { return (u16*)(ws + OFF_HQ); }
    DI h16* lf() const { return (h16*)(ws + OFF_LF); }
    DI u16* viT() const { return (u16*)(ws + OFF_VIT); }
    DI u16* hz() const { return (u16*)(ws + OFF_HZ); }
    DI u16* aq() const { return (u16*)(ws + OFF_AQ); }
    DI u16* ak() const { return (u16*)(ws + OFF_AK); }
    DI u16* av() const { return (u16*)(ws + OFF_AV); }
    DI u16* az() const { return (u16*)(ws + OFF_AZ); }
    DI u16* ST() const { return (u16*)(ws + OFF_ST); }
    DI float* dec() const { return (float*)(ws + OFF_DEC); }
    DI u16* ao0() const { return (u16*)(ws + OFF_XB); }
    DI u16* ao1() const { return (u16*)(ws + OFF_XB + 16 * MB); }
    DI u16* ao2() const { return (u16*)(ws + OFF_AO2); }
    DI float* lse() const { return (float*)(ws + OFF_LSE); }
    DI u16* mixed() const { return (u16*)(ws + OFF_AQ); }
    DI float* rowss() const { return (float*)(ws + OFF_ROWSS); }
    DI unsigned* pcnt() const { return (unsigned*)(ws + OFF_PCNT); }
    DI unsigned* bar() const { return (unsigned*)(ws + OFF_BAR); }
};

DI unsigned pack2(float a, float b) { f2_t v = {a, b}; return __builtin_bit_cast(unsigned, __builtin_convertvector(v, bf2_t)); }
DI u16 f2bf(float x) { return (u16)(pack2(x, 0.f) & 0xffffu); }
DI float bf2f(u16 v) { return __uint_as_float(((unsigned)v) << 16); }
DI float bflo(unsigned v) { return __uint_as_float(v << 16); }
DI float bfhi(unsigned v) { return __uint_as_float(v & 0xffff0000u); }
DI int crow(int reg, int h) { return (reg & 3) + 8 * (reg >> 2) + 4 * h; }
DI float silu(float v) { return v / (1.f + __expf(-v)); }
DI bf16x8 packB(const f32x16& x, int s) {
    u32x4 pk;
    pk[0] = pack2(x[8 * s + 0], x[8 * s + 1]); pk[1] = pack2(x[8 * s + 2], x[8 * s + 3]);
    pk[2] = pack2(x[8 * s + 4], x[8 * s + 5]); pk[3] = pack2(x[8 * s + 6], x[8 * s + 7]);
    return __builtin_bit_cast(bf16x8, pk);
}
DI float kfromlf(float v) { return (v > -0.02f) ? -v * (1.f + v * (0.5f + v * (1.f / 6.f))) : 1.f - __expf(v); }


#define XB_TMO      128
#define XB_XCNT(j)  (256  + 64 * (j))
#define XB_XSUB(j)  (1280 + 64 * (j))
#define XB_XGEN(j)  (2304 + 64 * (j))
#define XB_TOP      3328
#define XB_TOPGEN   3392
#define XCD_BAR_WORDS 3456
#define XB_SPIN_CAP (1u << 22)
#define LAS __attribute__((address_space(3)))
DI unsigned xb_ld(unsigned* p) { return __hip_atomic_load(p, __ATOMIC_RELAXED, __HIP_MEMORY_SCOPE_AGENT); }
DI unsigned xb_add(unsigned* p, unsigned v) { return __hip_atomic_fetch_add(p, v, __ATOMIC_RELAXED, __HIP_MEMORY_SCOPE_AGENT); }
DI unsigned xb_xcc_id() { return (unsigned)__builtin_amdgcn_s_getreg((3 << 11) | 20) & 0xFu; }
#define XB_SPIN(cond, bar) do { unsigned _sp = 0; while (cond) { __builtin_amdgcn_s_sleep(1); \
    if ((++_sp & 255u) == 0u) { if (xb_ld(&(bar)[XB_TMO])) break; if (_sp > XB_SPIN_CAP) { atomicAdd(&(bar)[XB_TMO], 1u); break; } } } } while (0)
struct XcdBarrier { unsigned* bar; unsigned x; volatile unsigned* st; };
DI XcdBarrier xcd_barrier_post(unsigned* bar, volatile unsigned* st) {
    XcdBarrier b; b.bar = bar; b.x = xb_xcc_id(); b.st = st;
    if (threadIdx.x == 0) (void)xb_add(&bar[XB_XCNT(b.x)], 1u);
    return b;
}
DI void xcd_barrier_complete(unsigned* bar, unsigned x, unsigned& nloc, unsigned& nx) {
    const unsigned G = gridDim.x * gridDim.y * gridDim.z;
    unsigned sum, cnt, mine, sp = 0u;
    for (;;) {
        sum = 0u; cnt = 0u; mine = 0u;
#pragma unroll
        for (unsigned j = 0; j < 16; ++j) { const unsigned c = xb_ld(&bar[XB_XCNT(j)]); sum += c; cnt += (c > 0u) ? 1u : 0u; mine = (j == x) ? c : mine; }
        if (sum == G) break;
        __builtin_amdgcn_s_sleep(1);
        if ((++sp & 255u) == 0u) { if (xb_ld(&bar[XB_TMO])) break; if (sp > XB_SPIN_CAP) { atomicAdd(&bar[XB_TMO], 1u); break; } }
    }
    nloc = mine > 0u ? mine : 1u; nx = cnt > 0u ? cnt : 1u;
}
DI void xcd_barrier(const XcdBarrier& b) {
    asm volatile("s_waitcnt vmcnt(0)" ::: "memory");
    __syncthreads();
    if (threadIdx.x == 0) {
        unsigned* bar = b.bar;
        __builtin_amdgcn_s_waitcnt(0);
        unsigned nloc = b.st[0], nx = b.st[1];
        if (nloc == 0u) { xcd_barrier_complete(bar, b.x, nloc, nx); b.st[0] = nloc; b.st[1] = nx; }
        const unsigned old = xb_add(&bar[XB_XSUB(b.x)], 1u);
        const unsigned gen = old / nloc;
        if (old + 1u == (gen + 1u) * nloc) {
            __builtin_amdgcn_fence(__ATOMIC_RELEASE, "agent");
            asm volatile("s_waitcnt vmcnt(0)" ::: "memory");
            const unsigned og = xb_add(&bar[XB_TOP], 1u);
            const unsigned tg = og / nx;
            if (og + 1u == (tg + 1u) * nx) xb_add(&bar[XB_TOPGEN], 1u);
            else XB_SPIN(xb_ld(&bar[XB_TOPGEN]) == tg, bar);
            __builtin_amdgcn_fence(__ATOMIC_ACQUIRE, "agent");
            xb_add(&bar[XB_XGEN(b.x)], 1u);
            asm volatile("s_waitcnt vmcnt(0)" ::: "memory");
        } else {
            XB_SPIN(xb_ld(&bar[XB_XGEN(b.x)]) == gen, bar);
            __builtin_amdgcn_fence(__ATOMIC_ACQUIRE, "agent");
            asm volatile("s_waitcnt vmcnt(0)" ::: "memory");
        }
    }
    __syncthreads();
}

constexpr int VSMEM_C = 4 * 128 * 144;
DI void vsync(char* smem, unsigned& gen) {
    __attribute__((address_space(3))) unsigned* ctr = (__attribute__((address_space(3))) unsigned*)(smem + VSMEM_C - 16);
    gen += 4u;
    __builtin_amdgcn_fence(__ATOMIC_RELEASE, "workgroup");
    if ((threadIdx.x & 63u) == 0u) (void)__hip_atomic_fetch_add(ctr, 1u, __ATOMIC_RELAXED, __HIP_MEMORY_SCOPE_WORKGROUP);
    unsigned sp = 0u;
    while (__hip_atomic_load(ctr, __ATOMIC_RELAXED, __HIP_MEMORY_SCOPE_WORKGROUP) < gen) { __builtin_amdgcn_s_sleep(1); if (++sp > (1u << 22)) break; }
    __builtin_amdgcn_fence(__ATOMIC_ACQUIRE, "workgroup");
}

DI void phase0(const P& p, char* smem) {
    int tid = VTID;
    asm volatile("" : "+v"(tid));
    const int lane = tid & 63, wid = tid >> 6;
    for (int row = VB * 4 + wid; row < NTOK; row += VGRID * 4) {
        const float4* xr = (const float4*)(p.x + (size_t)row * DM);
        float4 v[4]; float ss = 0.f;
#pragma unroll
        for (int i = 0; i < 4; ++i) { typedef float f4v __attribute__((ext_vector_type(4))); const f4v t4 = __builtin_nontemporal_load((const f4v*)(xr + lane + 64 * i)); v[i] = make_float4(t4[0], t4[1], t4[2], t4[3]); ss += v[i].x * v[i].x + v[i].y * v[i].y + v[i].z * v[i].z + v[i].w * v[i].w; }
#pragma unroll
        for (int o = 32; o >= 1; o >>= 1) ss += __shfl_xor(ss, o);
        uint2* xo = (uint2*)(p.xb() + (size_t)row * DM);
#pragma unroll
        for (int i = 0; i < 4; ++i) xo[lane + 64 * i] = make_uint2(pack2(v[i].x, v[i].y), pack2(v[i].z, v[i].w));
        if (lane == 0) p.rs()[row] = rsqrtf(ss * (1.f / 1024.f) + EPS);
    }
    float* tile = (float*)smem;
    for (int t = VB; t < 1024 + 256; t += VGRID) {
        const float* src; u16* dst; int ncols, td, tc; bool scale;
        if (t < 1024) { src = p.w_in; dst = p.winT(); ncols = 4096; td = t >> 6; tc = t & 63; scale = true; }
        else { const int t2 = t - 1024; src = p.w_out; dst = p.woutT(); ncols = 1024; td = t2 >> 4; tc = t2 & 15; scale = false; }
#pragma unroll
        for (int i = 0; i < 4; ++i) {
            const int r = (tid >> 4) + 16 * i, c4 = (tid & 15) * 4;
            float4 v = *(const float4*)(src + (size_t)(td * 64 + r) * ncols + tc * 64 + c4);
            const float s = scale ? p.norm_w[td * 64 + r] : 1.f;
            tile[r * 65 + c4 + 0] = v.x * s; tile[r * 65 + c4 + 1] = v.y * s; tile[r * 65 + c4 + 2] = v.z * s; tile[r * 65 + c4 + 3] = v.w * s;
        }
        __syncthreads();
#pragma unroll
        for (int u = 0; u < 2; ++u) {
            const int g = (tid & 3) + 4 * u, c = tid >> 2;
            float e[8];
#pragma unroll
            for (int j = 0; j < 8; ++j) e[j] = tile[(g * 8 + j) * 65 + c];
            u32x4 pk; pk[0] = pack2(e[0], e[1]); pk[1] = pack2(e[2], e[3]); pk[2] = pack2(e[4], e[5]); pk[3] = pack2(e[6], e[7]);
            int orow = tc * 64 + c;
            if (scale && orow >= 2048 && orow < 3072) { const int d = orow & 63; orow = (orow & ~63) + ((d & 31) << 1) + (d >> 5); }
            *(u32x4*)(dst + (size_t)orow * 1024 + td * 64 + g * 8) = pk;
        }
        __syncthreads();
    }
    for (int idx = VB * 256 + tid; idx < SEQ * 32; idx += VGRID * 256) {
        const int pos = idx >> 5, j = idx & 31;
        const float inv = (float)(1.0 / exp2((double)j * (13.287712379549449 / 32.0)));
        const float ang = (float)pos * inv;
        const double rev = (double)ang * 0.15915494309189535;
        const float fr = (float)(rev - floor(rev));
        p.rope()[idx] = __builtin_amdgcn_cosf(fr);
        p.rope()[SEQ * 32 + idx] = __builtin_amdgcn_sinf(fr);
    }
}

namespace pg8 {
#define PG8_LAS __attribute__((address_space(3)))
typedef unsigned short bf16_t;
typedef short bf16x8 __attribute__((ext_vector_type(8)));
typedef float f32x4 __attribute__((ext_vector_type(4)));
typedef unsigned u32x4 __attribute__((ext_vector_type(4)));
constexpr int BM = 256, BK = 64, HALF = 128, HTB = HALF * BK * 2  , STAGE_BYTES = 8 * HTB, NXCD = 8, WGM = 8;

__host__ __device__ __forceinline__ int lds_byte(int r, int c) { const int st = (r >> 4) * 2 + (c >> 5), rr = r & 15, cc = c & 31, ob = rr * 64 + cc * 2; return st * 1024 + (ob ^ (((ob >> 9) & 1) << 5)); }
__host__ __device__ __forceinline__ void stage_rc(int b, int& R, int& C) { const int st = b / 1024, sb = b % 1024, swz = sb ^ (((sb >> 9) & 1) << 5); R = (st >> 1) * 16 + swz / 64; C = (st & 1) * 32 + (swz % 64) / 2; }
__host__ __device__ __forceinline__ int perm32(int rho) { const int n = rho >> 4, i = rho & 15; return 8 * (i >> 2) + 4 * n + (i & 3); }

struct Unit { int pm, pn; };
struct Gemm { const bf16_t* A; const bf16_t* Bt; int M, N, K; };

struct StaticOrder {
    int nM, nN, nwg, G, c;
    __host__ __device__ void init(int M, int N, int G_, int c_) { nM = M / BM; nN = N / BM; nwg = nM * nN; G = G_; c = c_; }
    __host__ __device__ bool next(int i, Unit& u) const {
        const long L = (long)i * G + c; if (L >= nwg) return false;
        int wgid = (int)L; { const int q = nwg / NXCD, r = nwg % NXCD, xcd = wgid % NXCD, off = wgid / NXCD; wgid = (xcd < r ? xcd * (q + 1) : r * (q + 1) + (xcd - r) * q) + off; }
        const int nig = WGM * nN, gid = wgid / nig, fm = gid * WGM, gsz = (nM - fm) < WGM ? (nM - fm) : WGM;
        u.pm = fm + ((wgid % nig) % gsz); u.pn = (wgid % nig) / gsz; return true;
    }
    __device__ __forceinline__ void a_ready(const Unit&) const {}
    __device__ __forceinline__ void done(const Unit&) const {}
};
template <class Epi, class Sched, bool STAMP = false>
__device__ __forceinline__ void gemm_phase(PG8_LAS unsigned char* lds, const Gemm g, const Sched& S, const Epi& E, unsigned long long* stamps) {
    const int tid = threadIdx.x, wid = __builtin_amdgcn_readfirstlane(tid >> 6), lane = tid & 63, wr = wid >> 2, wc = wid & 3, fr = lane & 15, fq = lane >> 4;
    const int K = g.K, nt = K / BK;
    int ts_lo = 0, ts_hi = 0, nts = 0; const unsigned long long rt_entry = STAMP ? (unsigned long long)wall_clock64() : 0ull;
#define PG8_STAMP() do { if (STAMP && wid == 0 && nts < 64) { const unsigned long long _c = (unsigned long long)clock64(); \
        ts_lo = (lane == nts) ? (int)(unsigned)_c : ts_lo; ts_hi = (lane == nts) ? (int)(unsigned)(_c >> 32) : ts_hi; ++nts; } } while (0)
    PG8_STAMP();
    unsigned voffA[2], voffB[2];
#pragma unroll
    for (int i = 0; i < 2; ++i) { int R, C; stage_rc(tid * 16 + i * 8192, R, C); const int Rb = Epi::PERM ? ((R & ~31) + perm32(R & 31)) : R;
        voffA[i] = (unsigned)(R * K + C) * 2u; voffB[i] = (unsigned)(Rb * K + C) * 2u; }
    const size_t kstep = (size_t)(BK * 2);
    const size_t hstep = (size_t)HALF * K * 2;
    const size_t tstep = 2 * hstep;
    const unsigned ldsw = (unsigned)wid * 1024u;
    const int aoff = lds_byte(wr * 64 + fr, fq * 8), boff = lds_byte(wc * 32 + fr, fq * 8);
#define PG8_SA(b, h) (((b) * 2 + (h)) * HTB)
#define PG8_SB(b, h) ((4 + (b) * 2 + (h)) * HTB)
#define PG8_STAGE(bufoff, gbase, voff) do { _Pragma("unroll") for (int _i = 0; _i < 2; ++_i) \
        __builtin_amdgcn_global_load_lds((const unsigned*)((const char*)(gbase) + (voff)[_i]), (PG8_LAS unsigned*)(lds + (bufoff) + ldsw + _i * 8192), 16, 0, 0); } while (0)
#define PG8_LDA(dst, b, h) do { _Pragma("unroll") for (int m = 0; m < 4; ++m) _Pragma("unroll") for (int k = 0; k < 2; ++k) dst[m][k] = *(const PG8_LAS bf16x8*)(lds + PG8_SA(b, h) + aoff + m * 2048 + k * 1024); } while (0)
#define PG8_LDB(dst, b, h) do { _Pragma("unroll") for (int n = 0; n < 2; ++n) _Pragma("unroll") for (int k = 0; k < 2; ++k) dst[n][k] = *(const PG8_LAS bf16x8*)(lds + PG8_SB(b, h) + boff + n * 2048 + k * 1024); } while (0)
#define PG8_MMA(ai, bj, At, Bt) do { __builtin_amdgcn_s_setprio(1); _Pragma("unroll") for (int m = 0; m < 4; ++m) _Pragma("unroll") for (int n = 0; n < 2; ++n) _Pragma("unroll") for (int k = 0; k < 2; ++k) \
        acc[ai][bj][m][n] = __builtin_amdgcn_mfma_f32_16x16x32_bf16(Bt[n][k], At[m][k], acc[ai][bj][m][n], 0, 0, 0); __builtin_amdgcn_s_setprio(0); } while (0)
#define PG8_WAIT_V(n) asm volatile("s_waitcnt vmcnt(" #n ")" ::: "memory")
#define PG8_WAIT_L(n) asm volatile("s_waitcnt lgkmcnt(" #n ")" ::: "memory")
#define PG8_BAR __builtin_amdgcn_s_barrier()
#define PG8_SCHED __builtin_amdgcn_sched_barrier(0)
    Unit cur, nxt; int ui = 0;
    if (!S.next(0, cur)) return;
    f32x4 acc[2][2][4][2];
#pragma unroll
    for (int a = 0; a < 2; ++a)
#pragma unroll
        for (int b = 0; b < 2; ++b)
#pragma unroll
            for (int m = 0; m < 4; ++m)
#pragma unroll
                for (int n = 0; n < 2; ++n) acc[a][b][m][n] = (f32x4){0.f, 0.f, 0.f, 0.f};
    bf16x8 At[4][2], B0[2][2], B1[2][2];
    const char* cA = (const char*)g.A + (size_t)cur.pm * tstep; const char* cB = (const char*)g.Bt + (size_t)cur.pn * tstep;
    S.a_ready(cur);
    PG8_STAGE(PG8_SB(0, 0), cB, voffB); PG8_STAGE(PG8_SA(0, 0), cA, voffA); PG8_STAGE(PG8_SB(0, 1), cB + hstep, voffB); PG8_STAGE(PG8_SA(0, 1), cA + hstep, voffA);
    if (wr == 1) PG8_BAR;
    PG8_WAIT_V(4); PG8_BAR;
    PG8_STAGE(PG8_SB(1, 0), cB + kstep, voffB); PG8_STAGE(PG8_SA(1, 0), cA + kstep, voffA); PG8_STAGE(PG8_SB(1, 1), cB + hstep + kstep, voffB);
    PG8_WAIT_V(6); PG8_BAR;
    PG8_STAMP();
    for (;;) {
        const bool has_next = S.next(ui + 1, nxt);
        const char* nA = has_next ? (const char*)g.A + (size_t)nxt.pm * tstep : cA; const char* nB = has_next ? (const char*)g.Bt + (size_t)nxt.pn * tstep : cB;
        for (int t = 0; t < nt; t += 2) {
            const bool last = (t == nt - 2);
            const char* a1 = cA + (size_t)(t + 1) * kstep;
            const char* a2 = last ? nA : cA + (size_t)(t + 2) * kstep; const char* b2 = last ? nB : cB + (size_t)(t + 2) * kstep;
            const char* a3 = a2 + kstep; const char* b3 = b2 + kstep;
            if (last && has_next) S.a_ready(nxt);
            PG8_LDB(B0, 0, 0); PG8_SCHED; PG8_LDA(At, 0, 0); PG8_STAGE(PG8_SA(1, 1), a1 + hstep, voffA);
            PG8_WAIT_L(8); PG8_BAR; PG8_WAIT_L(0); PG8_MMA(0, 0, At, B0); PG8_BAR; PG8_SCHED;
            PG8_LDB(B1, 0, 1); PG8_STAGE(PG8_SB(0, 0), b2, voffB);
            PG8_BAR; PG8_WAIT_L(0); PG8_MMA(0, 1, At, B1); PG8_BAR;
            PG8_LDA(At, 0, 1); PG8_STAGE(PG8_SA(0, 0), a2, voffA);
            PG8_BAR; PG8_WAIT_L(0); PG8_MMA(1, 0, At, B0); PG8_BAR; PG8_SCHED;
            PG8_STAGE(PG8_SB(0, 1), b2 + hstep, voffB);
            PG8_WAIT_V(6); PG8_BAR; PG8_MMA(1, 1, At, B1); PG8_BAR;
            PG8_LDB(B0, 1, 0); PG8_SCHED; PG8_LDA(At, 1, 0); PG8_STAGE(PG8_SA(0, 1), a2 + hstep, voffA);
            PG8_WAIT_L(8); PG8_BAR; PG8_WAIT_L(0); PG8_MMA(0, 0, At, B0); PG8_BAR; PG8_SCHED;
            PG8_LDB(B1, 1, 1); PG8_STAGE(PG8_SB(1, 0), b3, voffB);
            PG8_BAR; PG8_WAIT_L(0); PG8_MMA(0, 1, At, B1); PG8_BAR;
            PG8_LDA(At, 1, 1); PG8_STAGE(PG8_SA(1, 0), a3, voffA);
            PG8_BAR; PG8_WAIT_L(0); PG8_MMA(1, 0, At, B0); PG8_BAR; PG8_SCHED;
            PG8_STAGE(PG8_SB(1, 1), b3 + hstep, voffB);
            PG8_WAIT_V(6); PG8_BAR; PG8_MMA(1, 1, At, B1); PG8_BAR;
        }
        PG8_STAMP();
        if constexpr (!Epi::AFTER_DRAIN) { E(acc, cur, wr, wc, fr, fq); S.done(cur); }
        PG8_STAMP();
        if (!has_next) break;
#pragma unroll
        for (int a = 0; a < 2; ++a)
#pragma unroll
            for (int b = 0; b < 2; ++b)
#pragma unroll
                for (int m = 0; m < 4; ++m)
#pragma unroll
                    for (int n = 0; n < 2; ++n) acc[a][b][m][n] = (f32x4){0.f, 0.f, 0.f, 0.f};
        cur = nxt; cA = nA; cB = nB; ++ui;
    }
    PG8_WAIT_V(0);
    if (wr == 0) PG8_BAR;
    PG8_BAR;
    if constexpr (Epi::AFTER_DRAIN) { E.fused(acc, cur, wr, wc, fr, fq, lds, wid, lane); S.done(cur); }
    PG8_STAMP();
    if (STAMP && wid == 0) { stamps[lane] = lane < nts ? (((unsigned long long)(unsigned)ts_hi << 32) | (unsigned)ts_lo) : 0ull;
        if (lane == 62) stamps[62] = rt_entry; if (lane == 63) stamps[63] = (unsigned long long)wall_clock64(); }
#undef PG8_STAMP
#undef PG8_SA
#undef PG8_SB
#undef PG8_STAGE
#undef PG8_LDA
#undef PG8_LDB
#undef PG8_MMA
#undef PG8_WAIT_V
#undef PG8_WAIT_L
#undef PG8_BAR
#undef PG8_SCHED
}
}


struct EpiIn {
    static constexpr bool PERM = true, AFTER_DRAIN = false;
    P p;
    template <int GRP> DI void run(const pg8::f32x4 (&acc)[2][2][4][2], const pg8::Unit& u, int wr, int wc, int fr, int fq) const {
        const int cg0 = (u.pn & 1) * 256 + wc * 32 + fq * 8;
        const int row0 = u.pm * 256 + wr * 64 + fr;
        float oml[2][8];
        if (GRP == 1) {
#pragma unroll
            for (int bj = 0; bj < 2; ++bj) {
                const float* l0 = p.lbl + cg0 + 128 * bj;
#pragma unroll
                for (int j = 0; j < 8; ++j) {
                    float lb = __builtin_amdgcn_rcpf(1.f + __builtin_amdgcn_exp2f((l0[512 + j] - l0[j]) * LOG2E));
                    lb = fminf(fmaxf(lb, 1e-6f), 1.f - 1e-6f);
                    oml[bj][j] = 1.f - lb;
                }
            }
        }
        float rsv[2][4];
#pragma unroll
        for (int ai = 0; ai < 2; ++ai)
#pragma unroll
            for (int m = 0; m < 4; ++m) rsv[ai][m] = p.rs()[row0 + 128 * ai + 16 * m];
#pragma unroll
        for (int ai = 0; ai < 2; ++ai)
#pragma unroll
            for (int m = 0; m < 4; ++m) {
                const int row = row0 + 128 * ai + 16 * m;
                const float rs = rsv[ai][m];
#pragma unroll
                for (int bj = 0; bj < 2; ++bj) {
                    const int cg = cg0 + 128 * bj;
                    float v[8];
#pragma unroll
                    for (int j = 0; j < 8; ++j) v[j] = acc[ai][bj][m][j >> 2][j & 3] * rs;
                    if (GRP == 2) {
                        const int b = row >> 13, t = row & 8191;
                        u16* dst = p.viT() + ((size_t)(b * 512 + cg)) * 8192 + t;
#pragma unroll
                        for (int j = 0; j < 8; ++j) dst[(size_t)j * 8192] = f2bf(v[j]);
                    } else if (GRP == 1) {
                        typedef _Float16 h16x8 __attribute__((ext_vector_type(8)));
                        h16x8 hv;
#pragma unroll
                        for (int j = 0; j < 8; ++j) hv[j] = (h16)(__builtin_amdgcn_logf(1.f - oml[bj][j] * __builtin_amdgcn_rcpf(1.f + __builtin_amdgcn_exp2f(v[j] * LOG2E))) * 0.6931471805599453f);
                        *(h16x8*)(p.lf() + ((size_t)((row >> 13) * 4 + (cg >> 7)) * 8192 + (row & 8191)) * 128 + (cg & 127)) = hv;
                    } else {
                        float o[8];
                        if (GRP == 0 || GRP == 3 || GRP == 7) {
#pragma unroll
                            for (int j = 0; j < 8; ++j) o[j] = v[j] * __builtin_amdgcn_rcpf(1.f + __builtin_amdgcn_exp2f(-v[j] * LOG2E));
                        } else if (GRP == 6) {
#pragma unroll
                            for (int j = 0; j < 8; ++j) o[j] = v[j];
                        } else {
                            const float sc = (GRP == 4) ? 0.125f : 1.f;
                            const int f0 = (cg & 63) >> 1, pos = row & 8191;
                            const float4 c4 = *(const float4*)(p.rope() + pos * 32 + f0), s4 = *(const float4*)(p.rope() + SEQ * 32 + pos * 32 + f0);
                            const float cs[4] = {c4.x, c4.y, c4.z, c4.w}, sn[4] = {s4.x, s4.y, s4.z, s4.w};
#pragma unroll
                            for (int i = 0; i < 4; ++i) {
                                o[2 * i] = (v[2 * i] * cs[i] - v[2 * i + 1] * sn[i]) * sc;
                                o[2 * i + 1] = (v[2 * i + 1] * cs[i] + v[2 * i] * sn[i]) * sc;
                            }
                        }
                        const size_t doff = (GRP == 4 || GRP == 5 || GRP == 6) ? ((size_t)((row >> 13) * 8 + (cg >> 6)) * 8192 + (row & 8191)) * 64 + (cg & 63)
                                                                                : ((size_t)((row >> 13) * 4 + (cg >> 7)) * 8192 + (row & 8191)) * 128 + (cg & 127);
                        u16* dst = ((GRP == 0) ? p.hq() : (GRP == 3) ? p.hz() : (GRP == 4) ? p.aq() : (GRP == 5) ? p.ak() : (GRP == 6) ? p.av() : p.az()) + doff;
                        u32x4 pk; pk[0] = pack2(o[0], o[1]); pk[1] = pack2(o[2], o[3]); pk[2] = pack2(o[4], o[5]); pk[3] = pack2(o[6], o[7]);
                        *(u32x4*)dst = pk;
                    }
                }
            }
    }
    DI void operator()(const pg8::f32x4 (&acc)[2][2][4][2], const pg8::Unit& u, int wr, int wc, int fr, int fq) const {
        switch (u.pn >> 1) {
            case 0: run<0>(acc, u, wr, wc, fr, fq); break;
            case 1: run<1>(acc, u, wr, wc, fr, fq); break;
            case 2: run<2>(acc, u, wr, wc, fr, fq); break;
            case 3: run<3>(acc, u, wr, wc, fr, fq); break;
            case 4: run<4>(acc, u, wr, wc, fr, fq); break;
            case 5: run<5>(acc, u, wr, wc, fr, fq); break;
            case 6: run<6>(acc, u, wr, wc, fr, fq); break;
            default: run<7>(acc, u, wr, wc, fr, fq); break;
        }
    }
};

DI void pass1(const P& p, char* smem, int item, unsigned& vgen) {
    int tid = VTID;
    asm volatile("" : "+v"(tid));
    const int lane = tid & 63, wid = tid >> 6, l31 = lane & 31, lh = lane >> 5;
    const int bh = item >> 7, c = item & 127, b = bh >> 2, h = bh & 3;
    const size_t m0 = (size_t)b * 8192 + c * 64;
    float* tot = (float*)smem;
    char* kdT = smem + 1024;
    const int k = tid & 127, half = tid >> 7;
    const h16* lfp = p.lf() + ((size_t)(b * 4 + h) * 8192 + c * 64 + half * 32) * 128 + k;
    float v[32]; float T = 0.f;
#pragma unroll
    for (int i = 0; i < 32; ++i) { v[i] = (float)lfp[(size_t)i * 128]; T += v[i]; }
    tot[half * 128 + k] = T;
    vsync(smem, vgen);
    const float other = tot[(half ^ 1) * 128 + k];
    float suf = (half == 0) ? other : 0.f;
    float kd[32];
#pragma unroll
    for (int i = 31; i >= 0; --i) { kd[i] = kfromlf(v[i]) * __expf(suf); suf += v[i]; }
#pragma unroll
    for (int q = 0; q < 4; ++q) {
        u32x4 pk;
        pk[0] = pack2(kd[8 * q + 0], kd[8 * q + 1]); pk[1] = pack2(kd[8 * q + 2], kd[8 * q + 3]);
        pk[2] = pack2(kd[8 * q + 4], kd[8 * q + 5]); pk[3] = pack2(kd[8 * q + 6], kd[8 * q + 7]);
        *(u32x4*)(kdT + k * 144 + half * 64 + q * 16) = pk;
    }
    if (half == 0) p.dec()[(size_t)item * 128 + k] = __expf(T + other);
    vsync(smem, vgen);
    const u16* vrow = p.viT() + ((size_t)(b * 512 + h * 128 + wid * 32 + l31)) * 8192 + c * 64;
    f32x16 acc[4];
#pragma unroll
    for (int n = 0; n < 4; ++n)
#pragma unroll
        for (int r = 0; r < 16; ++r) acc[n][r] = 0.f;
#pragma unroll
    for (int ks = 0; ks < 4; ++ks) {
        const bf16x8 a = *(const bf16x8*)(vrow + ks * 16 + lh * 8);
#pragma unroll
        for (int nt = 0; nt < 4; ++nt) {
            const bf16x8 bb = *(const bf16x8*)(kdT + (nt * 32 + l31) * 144 + (ks * 16 + lh * 8) * 2);
            acc[nt] = MFMA32(a, bb, acc[nt]);
        }
    }
    u16* so = p.ST() + (size_t)item * 16384;
#pragma unroll
    for (int nt = 0; nt < 4; ++nt)
#pragma unroll
        for (int r = 0; r < 16; ++r) so[(wid * 32 + crow(r, lh)) * 128 + nt * 32 + l31] = f2bf(acc[nt][r]);
    vsync(smem, vgen);
}

DI void pass2(const P& p) {
    int tid = VTID;
    asm volatile("" : "+v"(tid));
    if ((threadIdx.x >> 8) == 0u)
    for (int e = (int)blockIdx.x * 256 + tid; e < 65536; e += (int)gridDim.x * 256) {
        const int bh = e >> 13, rem = e & 8191, k2 = (rem & 63) * 2;
        unsigned* st = (unsigned*)p.ST() + (size_t)bh * 128 * 8192 + rem;
        const float2* dc = (const float2*)(p.dec() + (size_t)bh * 128 * 128 + k2);
        float r0 = 0.f, r1 = 0.f;
        for (int c0 = 0; c0 < 128; c0 += 8) {
            unsigned s[8]; float2 d[8];
#pragma unroll
            for (int j = 0; j < 8; ++j) { s[j] = st[(size_t)(c0 + j) * 8192]; d[j] = dc[(c0 + j) * 64]; }
#pragma unroll
            for (int j = 0; j < 8; ++j) {
                st[(size_t)(c0 + j) * 8192] = pack2(r0, r1);
                r0 = d[j].x * r0 + bflo(s[j]); r1 = d[j].y * r1 + bfhi(s[j]);
            }
        }
    }
}

DI void attn_item(const P& p, char* smem, int item, bool reuse, int par, unsigned& vgen) {
    int tid = VTID;
    asm volatile("" : "+v"(tid));
    const int lane = tid & 63, wid = tid >> 6, l31 = lane & 31, lh = lane >> 5;
    const int pat = item >> 10, idx = item & 1023;
    const int dl = pat * 2, d = 1 << dl, nblk = 64 >> dl;
    const int nb = idx & (nblk - 1);
    int rest = idx >> (6 - dl);
    const int r = rest & (d - 1); rest >>= dl;
    const int hh = rest & 7, b = rest >> 3;
    char* Ks = smem;
    char* VT = smem + 256 * 144;
    const size_t tokbase = ((size_t)b * 8 + hh) * 8192;
    {
        const int c8 = tid & 7, g4 = (tid >> 3) * 4;
#pragma unroll
        for (int hlf = 0; hlf < 2; ++hlf) {
            if (hlf == 0 && (reuse || nb == 0)) continue;
            const int pk0 = g4 + 128 * (hlf ^ par ^ 1);
            u32x4 vv[4];
#pragma unroll
            for (int i = 0; i < 4; ++i) {
                const size_t off = (tokbase + (size_t)(nb * 128 - 128 + hlf * 128 + g4 + i) * d + r) * 64 + c8 * 8;
                const u32x4 kv = *(const u32x4*)(p.ak() + off);
                vv[i] = *(const u32x4*)(p.av() + off);
                *(u32x4*)(Ks + (pk0 + i) * 144 + c8 * 16) = kv;
            }
#pragma unroll
            for (int q = 0; q < 4; ++q) {
                uint2 lo, hi;
                lo.x = (vv[0][q] & 0xffffu) | (vv[1][q] << 16); lo.y = (vv[2][q] & 0xffffu) | (vv[3][q] << 16);
                hi.x = (vv[0][q] >> 16) | (vv[1][q] & 0xffff0000u); hi.y = (vv[2][q] >> 16) | (vv[3][q] & 0xffff0000u);
                char* r0p = VT + (c8 * 8 + 2 * q) * 520 + pk0 * 2;
                *(uint2*)r0p = lo;
                *(uint2*)(r0p + 520) = hi;
            }
        }
    }
    const int jq = nb * 128 + wid * 32 + l31;
    const size_t mq = tokbase + (size_t)jq * d + r;
    bf16x8 qf[4];
#pragma unroll
    for (int ks = 0; ks < 4; ++ks) qf[ks] = *(const bf16x8*)(p.aq() + mq * 64 + ks * 16 + lh * 8);
    vsync(smem, vgen);
    const int kt_lo = (nb == 0) ? 4 : 0;
    f32x16 st[5];
    float mx = -INFINITY;
#pragma unroll
    for (int i = 0; i < 5; ++i) {
        const int kt = wid + i;
        const int pkt = (kt & 3) + 4 * ((kt >> 2) ^ par ^ 1);
        if (kt >= kt_lo) {
#pragma unroll
            for (int rr = 0; rr < 16; ++rr) st[i][rr] = 0.f;
#pragma unroll
            for (int ks = 0; ks < 4; ++ks) {
                const bf16x8 a = *(const bf16x8*)(Ks + (pkt * 32 + l31) * 144 + (ks * 16 + lh * 8) * 2);
                st[i] = MFMA32(a, qf[ks], st[i]);
            }
#pragma unroll
            for (int rr = 0; rr < 16; ++rr) {
                if (i == 0 && crow(rr, lh) < l31) st[i][rr] = -INFINITY;
                if (i == 4 && crow(rr, lh) > l31) st[i][rr] = -INFINITY;
                mx = fmaxf(mx, st[i][rr]);
            }
        } else {
#pragma unroll
            for (int rr = 0; rr < 16; ++rr) st[i][rr] = -INFINITY;
        }
    }
    mx = fmaxf(mx, __shfl_xor(mx, 32));
    const float mxs = mx * LOG2E;
#pragma unroll
    for (int i = 0; i < 5; ++i)
#pragma unroll
        for (int rr = 0; rr < 16; ++rr) st[i][rr] = __builtin_amdgcn_exp2f(st[i][rr] * LOG2E - mxs);
    f32x16 o[2], lsum;
#pragma unroll
    for (int rr = 0; rr < 16; ++rr) { o[0][rr] = 0.f; o[1][rr] = 0.f; lsum[rr] = 0.f; }
    u32x4 ones4; ones4[0] = ones4[1] = ones4[2] = ones4[3] = 0x3f803f80u;
    const bf16x8 ones = __builtin_bit_cast(bf16x8, ones4);
#pragma unroll
    for (int i = 0; i < 5; ++i) {
        const int kt = wid + i;
        const int pkt = (kt & 3) + 4 * ((kt >> 2) ^ par ^ 1);
        if (kt >= kt_lo) {
#pragma unroll
            for (int ks2 = 0; ks2 < 2; ++ks2) {
                const bf16x8 bq = packB(st[i], ks2);
                lsum = MFMA32(ones, bq, lsum);
#pragma unroll
                for (int dt = 0; dt < 2; ++dt) {
                    const char* ad = VT + (dt * 32 + l31) * 520 + (pkt * 32 + ks2 * 16 + lh * 4) * 2;
                    const uint2 lo = *(const uint2*)ad, hi = *(const uint2*)(ad + 16);
                    u32x4 av4; av4[0] = lo.x; av4[1] = lo.y; av4[2] = hi.x; av4[3] = hi.y;
                    o[dt] = MFMA32(__builtin_bit_cast(bf16x8, av4), bq, o[dt]);
                }
            }
        }
    }
    const float l = lsum[0];
    const float inv = __builtin_amdgcn_rcpf(l);
    u16* op = (pat == 0 ? p.ao0() : (pat == 1 ? p.ao1() : p.ao2())) + mq * 64;
#pragma unroll
    for (int dt = 0; dt < 2; ++dt)
#pragma unroll
        for (int g4 = 0; g4 < 4; ++g4)
            *(uint2*)(op + dt * 32 + g4 * 8 + lh * 4) = make_uint2(pack2(o[dt][g4 * 4] * inv, o[dt][g4 * 4 + 1] * inv), pack2(o[dt][g4 * 4 + 2] * inv, o[dt][g4 * 4 + 3] * inv));
    if (lh == 0) p.lse()[((size_t)pat * NTOK + (size_t)b * 8192 + (size_t)jq * d + r) * 8 + hh] = mx + __logf(l);
    vsync(smem, vgen);
}

DI void pass3(const P& p, char* smem, int item, unsigned& vgen) {
    int tid = VTID;
    asm volatile("" : "+v"(tid));
    const int lane = tid & 63, wid = tid >> 6, l31 = lane & 31, lh = lane >> 5;
    const int bh = item >> 7, c = item & 127, b = bh >> 2, h = bh & 3;
    const size_t m0 = (size_t)b * 8192 + c * 64;
    float* tot = (float*)smem;
    float* red = (float*)(smem + 1024);
    char* Qp = smem + 2048;
    char* Qpp = Qp + 64 * 272;
    char* Kp = Qpp + 64 * 272;
    const int tt = wid & 1, vh = wid >> 1;
    bf16x8 sfr0[8];
    {
        const u16* srow = p.ST() + (size_t)item * 16384 + (64 * vh + l31) * 128;
#pragma unroll
        for (int ks = 0; ks < 8; ++ks) sfr0[ks] = *(const bf16x8*)(srow + ks * 16 + lh * 8);
    }
    u32x4 ca0[4], ca1[4], ca2[4], caz[4]; float cl0[4], cl1[4], cl2[4];
#pragma unroll
    for (int i = 0; i < 4; ++i) {
        const int e = tid + 256 * i, r = e >> 4, ch = (e & 15) + 16 * h;
        const size_t m = m0 + r; const int hh = ch >> 3;
        const size_t ho = (((size_t)b * 8 + hh) * 8192 + (size_t)c * 64 + r) * 64 + (ch & 7) * 8;
        ca0[i] = *(const u32x4*)(p.ao0() + ho); ca1[i] = *(const u32x4*)(p.ao1() + ho); ca2[i] = *(const u32x4*)(p.ao2() + ho);
        caz[i] = *(const u32x4*)(p.az() + ((size_t)(b * 4 + h) * 8192 + (size_t)c * 64 + r) * 128 + (e & 15) * 8);
        cl0[i] = p.lse()[m * 8 + hh]; cl1[i] = p.lse()[((size_t)NTOK + m) * 8 + hh]; cl2[i] = p.lse()[((size_t)2 * NTOK + m) * 8 + hh];
    }
    {
        const int k = tid & 127, half = tid >> 7;
        const h16* lfp = p.lf() + ((size_t)(b * 4 + h) * 8192 + c * 64 + half * 32) * 128 + k;
        const u16* qp = p.hq() + ((size_t)(b * 4 + h) * 8192 + c * 64 + half * 32) * 128 + k;
        float v[32]; float T = 0.f;
#pragma unroll
        for (int i = 0; i < 32; ++i) { v[i] = (float)lfp[(size_t)i * 128]; T += v[i]; }
        tot[half * 128 + k] = T;
        vsync(smem, vgen);
        const float other = tot[(half ^ 1) * 128 + k];
        const float bref = (half == 0) ? T : other;
        const float ebref = __expf(bref);
        const float sub = (half == 0) ? T : 0.f;
        float pre = 0.f;
#pragma unroll
        for (int i = 0; i < 32; ++i) {
            pre += v[i];
            const float xx = pre - sub;
            const float E1 = __builtin_amdgcn_exp2f(xx * LOG2E), Ei = __builtin_amdgcn_exp2f(-xx * LOG2E);
            const float q = bf2f(qp[(size_t)i * 128]);
            const float kk = kfromlf(v[i]);
            const int row = half * 32 + i;
            *(u16*)(Qp + row * 272 + k * 2) = f2bf(q * E1);
            *(u16*)(Qpp + row * 272 + k * 2) = f2bf(q * E1 * ebref);
            *(u16*)(Kp + row * 272 + k * 2) = f2bf(kk * Ei);
        }
    }
    vsync(smem, vgen);
    f32x16 at[2];
#pragma unroll
    for (int st = 0; st < 2; ++st) {
#pragma unroll
        for (int rr = 0; rr < 16; ++rr) at[st][rr] = 0.f;
        if (st <= tt) {
#pragma unroll
            for (int ks = 0; ks < 8; ++ks) {
                const bf16x8 a = *(const bf16x8*)(Kp + (st * 32 + l31) * 272 + (ks * 16 + lh * 8) * 2);
                const bf16x8 bq = *(const bf16x8*)(Qp + (tt * 32 + l31) * 272 + (ks * 16 + lh * 8) * 2);
                at[st] = MFMA32(a, bq, at[st]);
            }
            if (st == tt) {
#pragma unroll
                for (int rr = 0; rr < 16; ++rr) if (crow(rr, lh) > l31) at[st][rr] = 0.f;
            }
        }
    }
    f32x16 o[2];
#pragma unroll
    for (int vt = 0; vt < 2; ++vt) {
#pragma unroll
        for (int rr = 0; rr < 16; ++rr) o[vt][rr] = 0.f;
        const int vrow = 64 * vh + 32 * vt + l31;
        const u16* srow = p.ST() + (size_t)item * 16384 + vrow * 128;
#pragma unroll
        for (int ks = 0; ks < 8; ++ks) {
            const bf16x8 a = (vt == 0) ? sfr0[ks] : *(const bf16x8*)(srow + ks * 16 + lh * 8);
            const bf16x8 bq = *(const bf16x8*)(Qpp + (tt * 32 + l31) * 272 + (ks * 16 + lh * 8) * 2);
            o[vt] = MFMA32(a, bq, o[vt]);
        }
        const u16* vr = p.viT() + ((size_t)(b * 512 + h * 128 + vrow)) * 8192 + c * 64;
#pragma unroll
        for (int st = 0; st < 2; ++st) {
            if (st <= tt) {
#pragma unroll
                for (int ks2 = 0; ks2 < 2; ++ks2) {
                    const uint2 lo = *(const uint2*)(vr + st * 32 + ks2 * 16 + lh * 4);
                    const uint2 hi = *(const uint2*)(vr + st * 32 + ks2 * 16 + 8 + lh * 4);
                    u32x4 av4; av4[0] = lo.x; av4[1] = lo.y; av4[2] = hi.x; av4[3] = hi.y;
                    o[vt] = MFMA32(__builtin_bit_cast(bf16x8, av4), packB(at[st], ks2), o[vt]);
                }
            }
        }
    }
    float ss = 0.f;
#pragma unroll
    for (int vt = 0; vt < 2; ++vt)
#pragma unroll
        for (int rr = 0; rr < 16; ++rr) ss += o[vt][rr] * o[vt][rr];
    ss += __shfl_xor(ss, 32);
    if (lh == 0) red[vh * 64 + tt * 32 + l31] = ss;
    vsync(smem, vgen);
    const float tot2 = red[tt * 32 + l31] + red[64 + tt * 32 + l31];
    const float rinv = rsqrtf(tot2 * (1.f / 128.f) + EPS);
    const size_t m = m0 + tt * 32 + l31;
#pragma unroll
    for (int vt = 0; vt < 2; ++vt)
#pragma unroll
        for (int g4 = 0; g4 < 4; ++g4) {
            const int vb = 64 * vh + 32 * vt + 8 * g4 + 4 * lh;
            const float4 gw = *(const float4*)(p.hgw + h * 128 + vb);
            const uint2 zz = *(const uint2*)(p.hz() + ((size_t)(b * 4 + h) * 8192 + (size_t)c * 64 + tt * 32 + l31) * 128 + vb);
            const float y0 = o[vt][g4 * 4 + 0] * rinv * gw.x * bflo(zz.x);
            const float y1 = o[vt][g4 * 4 + 1] * rinv * gw.y * bfhi(zz.x);
            const float y2 = o[vt][g4 * 4 + 2] * rinv * gw.z * bflo(zz.y);
            const float y3 = o[vt][g4 * 4 + 3] * rinv * gw.w * bfhi(zz.y);
            *(uint2*)(p.mixed() + m * 1024 + h * 128 + vb) = make_uint2(pack2(y0, y1), pack2(y2, y3));
        }
#pragma unroll
    for (int i = 0; i < 4; ++i) {
        const int e = tid + 256 * i, r = e >> 4, ch = (e & 15) + 16 * h;
        const float mx = fmaxf(cl0[i], fmaxf(cl1[i], cl2[i]));
        float w0 = __expf(cl0[i] - mx), w1 = __expf(cl1[i] - mx), w2 = __expf(cl2[i] - mx);
        const float inv = __builtin_amdgcn_rcpf(w0 + w1 + w2);
        w0 *= inv; w1 *= inv; w2 *= inv;
        u32x4 pk;
#pragma unroll
        for (int q = 0; q < 4; ++q) {
            const float y0 = (w0 * bflo(ca0[i][q]) + w1 * bflo(ca1[i][q]) + w2 * bflo(ca2[i][q])) * bflo(caz[i][q]);
            const float y1 = (w0 * bfhi(ca0[i][q]) + w1 * bfhi(ca1[i][q]) + w2 * bfhi(ca2[i][q])) * bfhi(caz[i][q]);
            pk[q] = pack2(y0, y1);
        }
        *(u32x4*)(p.mixed() + (m0 + r) * 1024 + 512 + ch * 8) = pk;
    }
    vsync(smem, vgen);
}

struct EpiOut {
    static constexpr bool PERM = false, AFTER_DRAIN = true;
    P p;
    DI void fused(pg8::f32x4 (&acc)[2][2][4][2], const pg8::Unit& u, int wr, int wc, int fr, int fq, PG8_LAS unsigned char* lds, int wid, int lane) const {
        PG8_LAS float* Pt = (PG8_LAS float*)lds;
        PG8_LAS float* Rt = (PG8_LAS float*)(lds + 4096);
        const int tid = threadIdx.x;
        const int rl0 = wr * 64 + fr, c0 = u.pn * 256 + wc * 32 + fq * 4;
#pragma unroll
        for (int ai = 0; ai < 2; ++ai)
#pragma unroll
            for (int m = 0; m < 4; ++m) {
                __builtin_amdgcn_sched_barrier(0);
                const int rl = rl0 + 128 * ai + 16 * m;
                const float* xr = p.x + ((size_t)u.pm * 256 + rl) * 1024 + c0;
                float ss = 0.f;
#pragma unroll
                for (int bj = 0; bj < 2; ++bj)
#pragma unroll
                    for (int n = 0; n < 2; ++n) {
                        const float4 xv = *(const float4*)(xr + 128 * bj + 16 * n);
                        pg8::f32x4& a = acc[ai][bj][m][n];
                        a[0] += xv.x; a[1] += xv.y; a[2] += xv.z; a[3] += xv.w;
                        ss = fmaf(a[0], a[0], ss); ss = fmaf(a[1], a[1], ss); ss = fmaf(a[2], a[2], ss); ss = fmaf(a[3], a[3], ss);
                    }
                ss += __shfl_xor(ss, 16); ss += __shfl_xor(ss, 32);
                if (fq == 0) Pt[rl * 4 + wc] = ss;
            }
        __syncthreads();
        if (tid < 256) (void)__hip_atomic_fetch_add(p.rowss() + u.pm * 256 + tid, (Pt[tid * 4] + Pt[tid * 4 + 1]) + (Pt[tid * 4 + 2] + Pt[tid * 4 + 3]), __ATOMIC_RELAXED, __HIP_MEMORY_SCOPE_AGENT);
        __threadfence();
        __syncthreads();
        if (tid == 0) {
            (void)__hip_atomic_fetch_add(p.pcnt() + u.pm, 1u, __ATOMIC_RELAXED, __HIP_MEMORY_SCOPE_AGENT);
            unsigned sp = 0;
            while (__hip_atomic_load(p.pcnt() + u.pm, __ATOMIC_RELAXED, __HIP_MEMORY_SCOPE_AGENT) < 4u) { __builtin_amdgcn_s_sleep(2); if (++sp > (1u << 22)) break; }
            __builtin_amdgcn_fence(__ATOMIC_ACQUIRE, "agent");
        }
        __syncthreads();
        if (tid < 256) Rt[tid] = rsqrtf(__hip_atomic_load(p.rowss() + u.pm * 256 + tid, __ATOMIC_RELAXED, __HIP_MEMORY_SCOPE_AGENT) * (1.f / 1024.f) + EPS);
        __syncthreads();
#pragma unroll
        for (int ai = 0; ai < 2; ++ai)
#pragma unroll
            for (int m = 0; m < 4; ++m) {
                __builtin_amdgcn_sched_barrier(0);
                const int rl = rl0 + 128 * ai + 16 * m;
                const float rinv = Rt[rl];
                float* orow = p.out + ((size_t)u.pm * 256 + rl) * 1024 + c0;
#pragma unroll
                for (int bj = 0; bj < 2; ++bj)
#pragma unroll
                    for (int n = 0; n < 2; ++n) {
                        const float4 fwv = *(const float4*)(p.fw + c0 + 128 * bj + 16 * n);
                        const pg8::f32x4& a = acc[ai][bj][m][n];
                        *(float4*)(orow + 128 * bj + 16 * n) = make_float4(a[0] * rinv * fwv.x, a[1] * rinv * fwv.y, a[2] * rinv * fwv.z, a[3] * rinv * fwv.w);
                    }
            }
    }
};

constexpr int VSMEM = 4 * 128 * 144;
constexpr int LDS_BYTES = 163840;

__global__ void __launch_bounds__(512, 2) fwd_kernel(P p) {
    extern __shared__ __attribute__((aligned(16))) unsigned char dynlds[];
    volatile unsigned* xbw = (volatile unsigned*)(dynlds + LDS_BYTES - 16);
    if (threadIdx.x < 4) xbw[threadIdx.x] = 0u;
    __syncthreads();
    const XcdBarrier gb = xcd_barrier_post(p.bar(), xbw);
    char* smem = (char*)dynlds + (threadIdx.x >> 8) * VSMEM;
    phase0(p, smem);
    xcd_barrier(gb);
    {
        pg8::Gemm g; g.A = p.xb(); g.Bt = p.winT(); g.M = NTOK; g.N = 4096; g.K = 1024;
        pg8::StaticOrder S; S.init(NTOK, 4096, gridDim.x, blockIdx.x);
        EpiIn E; E.p = p;
        pg8::gemm_phase<EpiIn, pg8::StaticOrder, false>((PG8_LAS unsigned char*)dynlds, g, S, E, nullptr);
    }
    xcd_barrier(gb);
    unsigned vgen = 0u;
    if (VTID == 0) *(volatile unsigned*)(smem + VSMEM - 16) = 0u;
    __syncthreads();
    for (int it = VB; it < 1024; it += VGRID) pass1(p, smem, it, vgen);
    xcd_barrier(gb);
    pass2(p);
    if (VGRID == 512) {
        const int bi = VB;
        const int hb = (int)(threadIdx.x >> 8), wg = (int)blockIdx.x;
        const int first = (hb == 0) ? wg * 5 : 1280 + wg * 7, cnt = (hb == 0) ? 5 : 7;
        int par = 1;
        for (int i = 0; i < cnt; ++i) {
            const int item = first + i, nbi = (item & 1023) & ((64 >> ((item >> 10) * 2)) - 1);
            const bool reuse = (i > 0) && (nbi > 0);
            par = reuse ? (par ^ 1) : 1;
            attn_item(p, smem, item, reuse, par, vgen);
        }
    } else {
        for (int it = VB; it < 3072; it += VGRID) attn_item(p, smem, it, false, 1, vgen);
    }
    xcd_barrier(gb);
    for (int it = VB; it < 1024; it += VGRID) pass3(p, smem, it, vgen);
    xcd_barrier(gb);
    {
        pg8::Gemm g; g.A = p.mixed(); g.Bt = p.woutT(); g.M = NTOK; g.N = 1024; g.K = 1024;
        pg8::StaticOrder S; S.init(NTOK, 1024, gridDim.x, blockIdx.x);
        EpiOut E; E.p = p;
        pg8::gemm_phase<EpiOut, pg8::StaticOrder, false>((PG8_LAS unsigned char*)dynlds, g, S, E, nullptr);
    }
}

extern "C" void kernel_launch(void* const* d_in, const int* in_sizes, int n_in, void* d_out, int out_size, void* d_ws, size_t ws_size, hipStream_t stream) {
    static int grid_blocks = 0;
    if (!grid_blocks) {
        int per_cu = 0;
        (void)hipFuncSetAttribute((const void*)fwd_kernel, hipFuncAttributeMaxDynamicSharedMemorySize, LDS_BYTES);
        (void)hipOccupancyMaxActiveBlocksPerMultiprocessor(&per_cu, fwd_kernel, 512, LDS_BYTES);
        grid_blocks = 256;
    }
    char* ws = (char*)d_ws;
    P p{};
    p.x = (const float*)d_in[0]; p.norm_w = (const float*)d_in[1]; p.w_in = (const float*)d_in[2]; p.lbl = (const float*)d_in[3];
    p.hgw = (const float*)d_in[4]; p.w_out = (const float*)d_in[5]; p.fw = (const float*)d_in[6];
    p.out = (float*)d_out;
    p.ws = ws;
    (void)hipMemsetAsync(ws + OFF_BAR, 0, OFF_END - OFF_BAR, stream);
    void* args[] = {&p};
    hipError_t e = hipLaunchCooperativeKernel((void*)fwd_kernel, dim3(grid_blocks), dim3(512), args, LDS_BYTES, stream);
    if (e != hipSuccess) fprintf(stderr, "cooperative launch failed: %s (grid %d)\n", hipGetErrorString(e), grid_blocks);
}
```
